# Optimizing an MI355X kernel written in HIP

```python
import jax, jax.numpy as jnp
from jax import lax
import numpy as np

D_MODEL = 1024
BATCH = 4
SEQ = 8192
DEPTH = 1

HEAD_DIM = 64
N_SWA_HEADS = 8
N_SWA_KV = 2
WINDOW = 128
BLOCK = 128
N_DSA_HEADS = 4
N_IDX_HEADS = 4
IDX_DIM = 64
TOPK_MAX = 256
N_MEM_HEADS = 4
MEM_LEN = 256
N_BRANCH = 3
D_FF = 4 * D_MODEL
ROPE_THETA = 10000.0
EPS = 1e-6

SWA_WIDTH = N_SWA_HEADS * HEAD_DIM
SWA_KV_WIDTH = N_SWA_KV * HEAD_DIM
DSA_WIDTH = N_DSA_HEADS * HEAD_DIM
MEM_WIDTH = N_MEM_HEADS * HEAD_DIM
IN_SPLITS = (SWA_WIDTH, SWA_KV_WIDTH, SWA_KV_WIDTH,
             DSA_WIDTH, HEAD_DIM, HEAD_DIM,
             N_IDX_HEADS * IDX_DIM, IDX_DIM, N_IDX_HEADS,
             MEM_WIDTH, N_BRANCH * D_MODEL)
D_IN = sum(IN_SPLITS)

kernel_name = "hybrid_swa_dsa_memory_gated_block"


def rmsnorm(x, g):
    xf = x.astype(jnp.float32)
    y = xf * lax.rsqrt(jnp.mean(xf * xf, axis=-1, keepdims=True) + EPS)
    return (y * g.astype(jnp.float32)).astype(x.dtype)


def rope(x, pos):
    half = x.shape[-1] // 2
    inv_freq = jnp.power(ROPE_THETA, -jnp.arange(half, dtype=jnp.float32) / half)
    ang = pos.astype(jnp.float32)[..., None] * inv_freq
    cos = jnp.cos(ang)[:, :, None, :].astype(x.dtype)
    sin = jnp.sin(ang)[:, :, None, :].astype(x.dtype)
    x1, x2 = x[..., :half], x[..., half:]
    return jnp.concatenate([x1 * cos - x2 * sin, x2 * cos + x1 * sin], axis=-1)


def sliding_window_attention(q, k, v, sinks):
    B, S, Hq, D = q.shape
    Hkv = k.shape[2]
    G = Hq // Hkv
    nb = S // BLOCK
    qb = q.reshape(B, nb, BLOCK, Hkv, G, D)

    def with_prev(t):
        tb = t.reshape(B, nb, BLOCK, Hkv, D)
        prev = jnp.concatenate([jnp.zeros_like(tb[:, :1]), tb[:, :-1]], axis=1)
        return jnp.concatenate([prev, tb], axis=2)

    kw, vw = with_prev(k), with_prev(v)
    scores = jnp.einsum("bnqkgd,bnskd->bnkgqs", qb, kw).astype(jnp.float32) * (D ** -0.5)
    qi = jnp.arange(BLOCK)[:, None]
    sj = jnp.arange(2 * BLOCK)[None, :]
    dist = qi + BLOCK - sj
    blk = jnp.arange(nb)[:, None, None]
    valid = (dist >= 0) & (dist < WINDOW) & ((blk > 0) | (sj >= BLOCK))
    scores = jnp.where(valid[None, :, None, None], scores, -jnp.inf)
    sink = jnp.broadcast_to(
        sinks.reshape(Hkv, G)[None, None, :, :, None, None].astype(jnp.float32),
        scores.shape[:-1] + (1,))
    probs = jax.nn.softmax(jnp.concatenate([scores, sink], axis=-1), axis=-1)[..., :-1]
    out = jnp.einsum("bnkgqs,bnskd->bnqkgd", probs.astype(vw.dtype), vw)
    return out.reshape(B, S, Hq * D)


def dsa_attention(q, k, v, q_idx, k_idx, w_idx):
    B, S = q.shape[:2]
    nb = S // BLOCK
    top_k = min(TOPK_MAX, S // 4)
    key_pos = jnp.arange(S)
    gather = jax.vmap(lambda t, i: t[i])

    def to_blocks(t):
        return jnp.moveaxis(t.reshape((B, nb, BLOCK) + t.shape[2:]), 1, 0)

    def block_fn(args):
        qb, qib, wb, blk = args
        qpos = blk * BLOCK + jnp.arange(BLOCK)
        rel = jax.nn.relu(jnp.einsum("bqhd,bsd->bqhs", qib, k_idx).astype(jnp.float32))
        iscore = jnp.einsum("bqhs,bqh->bqs", rel, wb.astype(jnp.float32))
        iscore = jnp.where(key_pos[None, None, :] <= qpos[None, :, None], iscore, -jnp.inf)
        _, sel = lax.top_k(iscore, top_k)
        kg = gather(k, sel)
        vg = gather(v, sel)
        s = jnp.einsum("bqhd,bqkd->bhqk", qb, kg).astype(jnp.float32) * (HEAD_DIM ** -0.5)
        s = jnp.where((sel <= qpos[None, :, None])[:, None], s, -jnp.inf)
        p = jax.nn.softmax(s, axis=-1)
        return jnp.einsum("bhqk,bqkd->bqhd", p.astype(vg.dtype), vg)

    out = lax.map(block_fn, (to_blocks(q), to_blocks(q_idx), to_blocks(w_idx), jnp.arange(nb)))
    return jnp.moveaxis(out, 0, 1).reshape(B, S, -1)


def memory_cross_attention(q, mem_k, mem_v):
    B, S = q.shape[:2]
    s = jnp.einsum("bqhd,bmhd->bhqm", q, mem_k).astype(jnp.float32) * (HEAD_DIM ** -0.5)
    p = jax.nn.softmax(s, axis=-1)
    return jnp.einsum("bhqm,bmhd->bqhd", p.astype(mem_v.dtype), mem_v).reshape(B, S, -1)


def setup_inputs(seed: int = 0) -> dict:
    key = jax.random.key(seed)
    ks = jax.random.split(key, 20)
    f32 = jnp.float32

    def nrm(k, shape, scale):
        return jax.random.normal(k, shape, f32) * scale

    def gain(k, shape):
        return 1.0 + 0.02 * jax.random.normal(k, shape, f32)

    return {
        "x": nrm(ks[0], (BATCH, SEQ, D_MODEL), 1.0),
        "mem": nrm(ks[1], (BATCH, MEM_LEN, D_MODEL), 1.0),
        "positions": jnp.broadcast_to(jnp.arange(SEQ, dtype=jnp.int32)[None], (BATCH, SEQ)),
        "g_mix": gain(ks[2], (DEPTH, D_MODEL)),
        "w_in": nrm(ks[3], (DEPTH, D_MODEL, D_IN), D_MODEL ** -0.5),
        "b_gate": nrm(ks[4], (DEPTH, N_BRANCH * D_MODEL), 0.01),
        "sinks": nrm(ks[5], (DEPTH, N_SWA_HEADS), 0.5),
        "g_mem": gain(ks[6], (DEPTH, D_MODEL)),
        "w_mem_kv": nrm(ks[7], (DEPTH, D_MODEL, 2 * MEM_WIDTH), D_MODEL ** -0.5),
        "w_proj_swa": nrm(ks[8], (DEPTH, SWA_WIDTH, D_MODEL), SWA_WIDTH ** -0.5),
        "w_proj_dsa": nrm(ks[9], (DEPTH, DSA_WIDTH, D_MODEL), DSA_WIDTH ** -0.5),
        "w_proj_mem": nrm(ks[10], (DEPTH, MEM_WIDTH, D_MODEL), MEM_WIDTH ** -0.5),
        "w_out": nrm(ks[11], (DEPTH, D_MODEL, D_MODEL), D_MODEL ** -0.5),
        "g_mlp": gain(ks[12], (DEPTH, D_MODEL)),
        "w_mlp_in": nrm(ks[13], (DEPTH, D_MODEL, D_FF), D_MODEL ** -0.5),
        "w_mlp_out": nrm(ks[14], (DEPTH, D_FF, D_MODEL), D_FF ** -0.5),
        "g_final": gain(ks[15], (D_MODEL,)),
    }


def reference(x, mem, positions, g_mix, w_in, b_gate, sinks, g_mem, w_mem_kv,
              w_proj_swa, w_proj_dsa, w_proj_mem, w_out, g_mlp, w_mlp_in, w_mlp_out,
              g_final):
    B, S, _ = x.shape
    M = mem.shape[1]
    split_points = np.cumsum(IN_SPLITS)[:-1].tolist()
    idx_scale = (N_IDX_HEADS ** -0.5) * (IDX_DIM ** -0.5)
    for l in range(DEPTH):
        h = rmsnorm(x, g_mix[l])
        proj = jnp.einsum("bsd,de->bse", h, w_in[l])
        (q_s, k_s, v_s, q_d, k_d, v_d, q_i, k_i, w_i, q_m, gate_logits) = jnp.split(
            proj, split_points, axis=-1)

        q_s = rope(q_s.reshape(B, S, N_SWA_HEADS, HEAD_DIM), positions)
        k_s = rope(k_s.reshape(B, S, N_SWA_KV, HEAD_DIM), positions)
        v_s = v_s.reshape(B, S, N_SWA_KV, HEAD_DIM)
        o_swa = sliding_window_attention(q_s, k_s, v_s, sinks[l])

        q_d = rope(q_d.reshape(B, S, N_DSA_HEADS, HEAD_DIM), positions)
        k_d = rope(k_d[:, :, None, :], positions)[:, :, 0]
        q_i = rope(q_i.reshape(B, S, N_IDX_HEADS, IDX_DIM), positions)
        k_i = rope(k_i[:, :, None, :], positions)[:, :, 0]
        o_dsa = dsa_attention(q_d, k_d, v_d, q_i, k_i, w_i * idx_scale)

        m = rmsnorm(mem, g_mem[l])
        mkv = jnp.einsum("bmd,de->bme", m, w_mem_kv[l]).reshape(B, M, 2, N_MEM_HEADS, HEAD_DIM)
        o_mem = memory_cross_attention(q_m.reshape(B, S, N_MEM_HEADS, HEAD_DIM),
                                       mkv[:, :, 0], mkv[:, :, 1])

        gates = jax.nn.sigmoid(gate_logits + b_gate[l]).reshape(B, S, N_BRANCH, D_MODEL)
        merged = (gates[:, :, 0] * jnp.einsum("bse,ed->bsd", o_swa, w_proj_swa[l])
                  + gates[:, :, 1] * jnp.einsum("bse,ed->bsd", o_dsa, w_proj_dsa[l])
                  + gates[:, :, 2] * jnp.einsum("bse,ed->bsd", o_mem, w_proj_mem[l]))
        x = x + jnp.einsum("bsd,de->bse", merged, w_out[l])

        h = rmsnorm(x, g_mlp[l])
        hid = jnp.square(jax.nn.relu(jnp.einsum("bsd,df->bsf", h, w_mlp_in[l])))
        x = x + jnp.einsum("bsf,fd->bsd", hid, w_mlp_out[l])
    return rmsnorm(x, g_final)
```

```cpp
#include <hip/hip_runtime.h>
#include <cstdio>
#include <cstdint>

#define LAS __attribute__((address_space(3)))
#define GAS __attribute__((address_space(1)))
typedef unsigned short bf16_t;
typedef short bf16x8 __attribute__((ext_vector_type(8)));
typedef float f32x2 __attribute__((ext_vector_type(2)));
typedef float f32x4 __attribute__((ext_vector_type(4)));
typedef float f32x16 __attribute__((ext_vector_type(16)));
typedef unsigned u32x2 __attribute__((ext_vector_type(2)));
typedef unsigned u32x4 __attribute__((ext_vector_type(4)));
typedef __bf16 bf16x2_t __attribute__((ext_vector_type(2)));

constexpr int NB = 4, SEQ = 8192, T = NB * SEQ, DM = 1024, DFF = 4096, DIN = 4804, NPOS = 4864, MEMLEN = 256, MROWS = NB * MEMLEN;
constexpr float EPS = 1e-6f;
constexpr float LOG2E = 1.4426950408889634f;
constexpr float QSCALE = 0.125f * LOG2E;
constexpr float IDX_SCALE = 0.0625f;
constexpr int TOPK = 256;
constexpr int P_QS = 0, P_KS = 512, P_VS = 640, P_QD = 768, P_KD = 1024, P_VD = 1088, P_QI = 1152, P_KI = 1408, P_QM = 1472, P_GATE = 1728, P_WI = 4800, P_END = 4804;

constexpr size_t MiB = 1u << 20;
constexpr size_t WS_CTL = 0, CTL_ZERO_BYTES = 1 * MiB;
constexpr size_t WS_WIN = 1 * MiB, WS_WMEM = 11 * MiB, WS_WPROJ = 12 * MiB, WS_WOUT = 14 * MiB, WS_W1 = 16 * MiB, WS_W2 = 24 * MiB;
constexpr size_t WS_INVRMS0 = 32 * MiB, WS_INVRMSM = 32 * MiB + 128 * 1024, WS_WI = 32 * MiB + 256 * 1024;
constexpr size_t WS_SSQ1 = 33 * MiB, WS_SSQ2 = 35 * MiB, WS_CS = 37 * MiB, WS_MEMB = 45 * MiB, WS_MK = 47 * MiB, WS_MV = 47 * MiB + 512 * 1024;
constexpr size_t WS_XB = 48 * MiB;
constexpr size_t WS_OCAT = 112 * MiB;
constexpr size_t WS_QS = 176 * MiB, WS_KS = 208 * MiB, WS_VS = 216 * MiB, WS_QD = 224 * MiB, WS_KD = 240 * MiB, WS_VD = 244 * MiB, WS_QI = 248 * MiB, WS_KI = 264 * MiB, WS_QM = 268 * MiB;
constexpr size_t WS_GATES = 284 * MiB;
constexpr size_t WS_MERGED = 176 * MiB;
constexpr size_t WS_HID = 176 * MiB;
constexpr size_t WS_END = 476 * MiB;
static_assert(WS_WIN + (size_t)NPOS * DM * 2 <= WS_WMEM && WS_GATES + (size_t)T * 3072 * 2 <= WS_END && WS_HID + (size_t)T * DFF * 2 <= WS_END, "d_ws map");
constexpr int CW_TMO = 0, CW_CODE = 1, CW_BAR = 4096;

constexpr int RING_OFF = 0, RING_BYTES = 131072;
constexpr int LDSCTL_OFF = RING_BYTES, MISC_OFF = LDSCTL_OFF + 320;
constexpr int LDS_BYTES = 147456;
constexpr int NWAVES = 8;

#define LDS_WAIT() asm volatile("s_waitcnt lgkmcnt(0)" ::: "memory")
#define VM_WAIT() asm volatile("s_waitcnt vmcnt(0)" ::: "memory")
#define RLX_AGENT __ATOMIC_RELAXED, __HIP_MEMORY_SCOPE_AGENT

__device__ __forceinline__ unsigned cvtpk(float lo, float hi) { f32x2 v = {lo, hi}; bf16x2_t b = __builtin_convertvector(v, bf16x2_t); return __builtin_bit_cast(unsigned, b); }
__device__ __forceinline__ float bf_lo(unsigned w) { return __uint_as_float(w << 16); }
__device__ __forceinline__ float bf_hi(unsigned w) { return __uint_as_float(w & 0xffff0000u); }
__device__ __forceinline__ float wave_sum(float v) {
#pragma unroll
    for (int o = 1; o < 64; o <<= 1) v += __shfl_xor(v, o);
    return v;
}
__device__ __forceinline__ float wave_max(float v) {
#pragma unroll
    for (int o = 1; o < 64; o <<= 1) v = fmaxf(v, __shfl_xor(v, o));
    return v;
}

namespace pg8 {
constexpr int BM = 256, BK = 64, HALF = 128, HTB = HALF * BK * 2  , STAGE_BYTES = 8 * HTB, NXCD = 8, WGM = 8;
__host__ __device__ __forceinline__ int lds_byte(int r, int c) { const int st = (r >> 4) * 2 + (c >> 5), rr = r & 15, cc = c & 31, ob = rr * 64 + cc * 2; return st * 1024 + (ob ^ (((ob >> 9) & 1) << 5)); }
__host__ __device__ __forceinline__ void stage_rc(int b, int& R, int& C) { const int st = b / 1024, sb = b % 1024, swz = sb ^ (((sb >> 9) & 1) << 5); R = (st >> 1) * 16 + swz / 64; C = (st & 1) * 32 + (swz % 64) / 2; }
__host__ __device__ __forceinline__ int perm32(int rho) { const int n = rho >> 4, i = rho & 15; return 8 * (i >> 2) + 4 * n + (i & 3); }

struct Unit { int pm, pn, kind, nt; const char* A; const char* B; };

__device__ __forceinline__ void map_tile(int L, int nM, int nN, int& pm, int& pn) {
    const int nwg = nM * nN;
    int wgid = L; { const int q = nwg / NXCD, r = nwg % NXCD, xcd = wgid % NXCD, off = wgid / NXCD; wgid = (xcd < r ? xcd * (q + 1) : r * (q + 1) + (xcd - r) * q) + off; }
    const int nig = WGM * nN, gid = wgid / nig, fm = gid * WGM, gsz = (nM - fm) < WGM ? (nM - fm) : WGM;
    pm = fm + ((wgid % nig) % gsz); pn = (wgid % nig) / gsz;
}

template <class Epi, class Sched, bool ALIGN_EPI>
__device__ __forceinline__ void gemm_phase(LAS unsigned char* lds, const int lda, const int ldb, const Sched& S, const Epi& E) {
    const int tid = threadIdx.x, wid = __builtin_amdgcn_readfirstlane(tid >> 6), lane = tid & 63, wr = wid >> 2, wc = wid & 3, fr = lane & 15, fq = lane >> 4;
    unsigned voffA[2], voffB[2];
#pragma unroll
    for (int i = 0; i < 2; ++i) { int R, C; stage_rc(tid * 16 + i * 8192, R, C); const int Rb = Epi::PERM ? ((R & ~31) + perm32(R & 31)) : R;
        voffA[i] = (unsigned)(R * lda + C) * 2u; voffB[i] = (unsigned)(Rb * ldb + C) * 2u; }
    const size_t kstep = (size_t)(BK * 2);
    const size_t hstepA = (size_t)HALF * lda * 2, hstepB = (size_t)HALF * ldb * 2;
    const unsigned ldsw = (unsigned)wid * 1024u;
    const int aoff = lds_byte(wr * 64 + fr, fq * 8), boff = lds_byte(wc * 32 + fr, fq * 8);
#define PG8_SA(b, h) (((b) * 2 + (h)) * HTB)
#define PG8_SB(b, h) ((4 + (b) * 2 + (h)) * HTB)
#define PG8_STAGE(bufoff, gbase, voff) do { _Pragma("unroll") for (int _i = 0; _i < 2; ++_i) \
        __builtin_amdgcn_global_load_lds((const unsigned*)((const char*)(gbase) + (voff)[_i]), (LAS unsigned*)(lds + (bufoff) + ldsw + _i * 8192), 16, 0, 0); } while (0)
#define PG8_LDA(dst, b, h) do { _Pragma("unroll") for (int m = 0; m < 4; ++m) _Pragma("unroll") for (int k = 0; k < 2; ++k) dst[m][k] = *(const LAS bf16x8*)(lds + PG8_SA(b, h) + aoff + m * 2048 + k * 1024); } while (0)
#define PG8_LDB(dst, b, h) do { _Pragma("unroll") for (int n = 0; n < 2; ++n) _Pragma("unroll") for (int k = 0; k < 2; ++k) dst[n][k] = *(const LAS bf16x8*)(lds + PG8_SB(b, h) + boff + n * 2048 + k * 1024); } while (0)
#define PG8_MMA(ai, bj, At, Bt) do { __builtin_amdgcn_s_setprio(1); _Pragma("unroll") for (int m = 0; m < 4; ++m) _Pragma("unroll") for (int n = 0; n < 2; ++n) _Pragma("unroll") for (int k = 0; k < 2; ++k) \
        acc[ai][bj][m][n] = __builtin_amdgcn_mfma_f32_16x16x32_bf16(Bt[n][k], At[m][k], acc[ai][bj][m][n], 0, 0, 0); __builtin_amdgcn_s_setprio(0); } while (0)
#define PG8_WAIT_V(n) asm volatile("s_waitcnt vmcnt(" #n ")" ::: "memory")
#define PG8_WAIT_L(n) asm volatile("s_waitcnt lgkmcnt(" #n ")" ::: "memory")
#define PG8_BAR __builtin_amdgcn_s_barrier()
#define PG8_SCHED __builtin_amdgcn_sched_barrier(0)
    Unit cur, nxt; int ui = 0;
    if (!S.next(0, cur)) return;
    f32x4 acc[2][2][4][2];
#pragma unroll
    for (int a = 0; a < 2; ++a)
#pragma unroll
        for (int b = 0; b < 2; ++b)
#pragma unroll
            for (int m = 0; m < 4; ++m)
#pragma unroll
                for (int n = 0; n < 2; ++n) acc[a][b][m][n] = (f32x4){0.f, 0.f, 0.f, 0.f};
    bf16x8 At[4][2], B0[2][2], B1[2][2];
    const char* cA = cur.A; const char* cB = cur.B;
    PG8_STAGE(PG8_SB(0, 0), cB, voffB); PG8_STAGE(PG8_SB(0, 1), cB + hstepB, voffB); PG8_STAGE(PG8_SA(0, 0), cA, voffA); PG8_STAGE(PG8_SA(0, 1), cA + hstepA, voffA);
    if (wr == 1) PG8_BAR;
    PG8_WAIT_V(2); PG8_BAR;
    PG8_STAGE(PG8_SB(1, 0), cB + kstep, voffB); PG8_STAGE(PG8_SA(1, 0), cA + kstep, voffA); PG8_STAGE(PG8_SB(1, 1), cB + hstepB + kstep, voffB);
    PG8_WAIT_V(6); PG8_BAR;
    for (;;) {
        const bool has_next = S.next(ui + 1, nxt);
        const char* nA = has_next ? nxt.A : cA; const char* nB = has_next ? nxt.B : cB;
        const int nt = cur.nt;
        for (int t = 0; t < nt; t += 2) {
            const bool last = (t == nt - 2);
            const char* a1 = cA + (size_t)(t + 1) * kstep;
            const char* a2 = last ? nA : cA + (size_t)(t + 2) * kstep; const char* b2 = last ? nB : cB + (size_t)(t + 2) * kstep;
            const char* a3 = a2 + kstep; const char* b3 = b2 + kstep;
            PG8_LDB(B0, 0, 0); PG8_LDB(B1, 0, 1); PG8_SCHED; PG8_LDA(At, 0, 0); PG8_STAGE(PG8_SA(1, 1), a1 + hstepA, voffA);
            PG8_WAIT_V(8); PG8_WAIT_L(0); PG8_BAR; PG8_MMA(0, 0, At, B0); PG8_MMA(0, 1, At, B1); PG8_BAR; PG8_SCHED;
            PG8_LDA(At, 0, 1); PG8_STAGE(PG8_SB(0, 0), b2, voffB); PG8_STAGE(PG8_SB(0, 1), b2 + hstepB, voffB); PG8_STAGE(PG8_SA(0, 0), a2, voffA);
            PG8_WAIT_V(8); PG8_WAIT_L(0); PG8_BAR; PG8_MMA(1, 0, At, B0); PG8_MMA(1, 1, At, B1); PG8_BAR; PG8_SCHED;
            PG8_LDB(B0, 1, 0); PG8_LDB(B1, 1, 1); PG8_SCHED; PG8_LDA(At, 1, 0); PG8_STAGE(PG8_SA(0, 1), a2 + hstepA, voffA);
            PG8_WAIT_V(8); PG8_WAIT_L(0); PG8_BAR; PG8_MMA(0, 0, At, B0); PG8_MMA(0, 1, At, B1); PG8_BAR; PG8_SCHED;
            PG8_LDA(At, 1, 1); PG8_STAGE(PG8_SB(1, 0), b3, voffB); PG8_STAGE(PG8_SB(1, 1), b3 + hstepB, voffB); PG8_STAGE(PG8_SA(1, 0), a3, voffA);
            PG8_WAIT_V(8); PG8_WAIT_L(0); PG8_BAR; PG8_MMA(1, 0, At, B0); PG8_MMA(1, 1, At, B1); PG8_BAR; PG8_SCHED;
        }
        if constexpr (ALIGN_EPI) { if (wr == 0) PG8_BAR; }
        E(acc, cur, wr, wc, fr, fq);
        if (!has_next) break;
#pragma unroll
        for (int a = 0; a < 2; ++a)
#pragma unroll
            for (int b = 0; b < 2; ++b)
#pragma unroll
                for (int m = 0; m < 4; ++m)
#pragma unroll
                    for (int n = 0; n < 2; ++n) acc[a][b][m][n] = (f32x4){0.f, 0.f, 0.f, 0.f};
        cur = nxt; cA = nA; cB = nB; ++ui;
        if constexpr (ALIGN_EPI) { if (wr == 1) PG8_BAR; }
    }
    PG8_WAIT_V(0);
    if constexpr (!ALIGN_EPI) { if (wr == 0) PG8_BAR; }
    PG8_BAR;
#undef PG8_SA
#undef PG8_SB
#undef PG8_STAGE
#undef PG8_LDA
#undef PG8_LDB
#undef PG8_MMA
#undef PG8_WAIT_V
#undef PG8_WAIT_L
#undef PG8_BAR
#undef PG8_SCHED
}
}

struct SchedGrid {
    int nM, nN, nwg, G, c, nt; const char* Ab; const char* Bb; size_t tA, tB;
    __device__ __forceinline__ bool next(int i, pg8::Unit& u) const {
        const long L = (long)i * G + c; if (L >= nwg) return false;
        pg8::map_tile((int)L, nM, nN, u.pm, u.pn); u.kind = 0; u.nt = nt; u.A = Ab + (size_t)u.pm * tA; u.B = Bb + (size_t)u.pn * tB; return true;
    }
};
struct SchedInProj {
    int nM, nN, nwg, G, c; const char* Ab; const char* Bb; const char* Am; const char* Bm;
    __device__ __forceinline__ bool next(int i, pg8::Unit& u) const {
        const long L = (long)i * G + c; if (L >= nwg + 8) return false;
        u.nt = DM / 64;
        if (L < nwg) { pg8::map_tile((int)L, nM, nN, u.pm, u.pn); u.kind = 0; u.A = Ab + (size_t)u.pm * (256 * DM * 2); u.B = Bb + (size_t)u.pn * (256 * DM * 2); }
        else { const int e = (int)(L - nwg); u.pm = e >> 1; u.pn = e & 1; u.kind = 1; u.A = Am + (size_t)u.pm * (256 * DM * 2); u.B = Bm + (size_t)u.pn * (256 * DM * 2); }
        return true;
    }
};
struct SchedMerge {
    int G, c; const char* Ab; const char* Bb;
    __device__ __forceinline__ bool next(int i, pg8::Unit& u) const {
        const int round = i / 3, br = i - 3 * round; const long L = (long)round * G + c; if (L >= 512) return false;
        pg8::map_tile((int)L, 128, 4, u.pm, u.pn); u.kind = br; u.nt = br == 0 ? 8 : 4;
        const int koff = br == 0 ? 0 : (br == 1 ? 512 : 768);
        u.A = Ab + (size_t)u.pm * (256 * DM * 2) + koff * 2; u.B = Bb + (size_t)u.pn * (256 * DM * 2) + koff * 2; return true;
    }
};

__device__ __forceinline__ float sigmoidf_fast(float x) { return __builtin_amdgcn_rcpf(1.0f + __builtin_amdgcn_exp2f(-x * LOG2E)); }

struct EpiInProj {
    static constexpr bool PERM = true;
    const float* inv_rms; const float* inv_rms_mem; const float* cs; const float* b_gate;
    bf16_t *q_s, *k_s, *v_s, *q_d, *k_d, *v_d, *q_i, *k_i, *q_m, *gates, *mk, *mv; float* w_i;
    __device__ __forceinline__ void operator()(const f32x4 (&acc)[2][2][4][2], const pg8::Unit& u, int wr, int wc, int fr, int fq) const {
        if (u.kind == 1) {
            bf16_t* dst = u.pn == 0 ? mk : mv;
#pragma unroll
            for (int ai = 0; ai < 2; ++ai)
#pragma unroll
                for (int m = 0; m < 4; ++m) { const int row = u.pm * 256 + ai * 128 + wr * 64 + m * 16 + fr; const float s = inv_rms_mem[row];
#pragma unroll
                    for (int bj = 0; bj < 2; ++bj) { const f32x4 v0 = acc[ai][bj][m][0] * s, v1 = acc[ai][bj][m][1] * s;
                        u32x4 w; w.x = cvtpk(v0[0], v0[1]); w.y = cvtpk(v0[2], v0[3]); w.z = cvtpk(v1[0], v1[1]); w.w = cvtpk(v1[2], v1[3]);
                        *(u32x4*)(dst + (size_t)row * 256 + bj * 128 + wc * 32 + 8 * fq) = w; } }
            return;
        }
#pragma unroll
        for (int bj = 0; bj < 2; ++bj) {
            const int pos0 = u.pn * 256 + bj * 128 + wc * 32;
            const int p = pos0 + 8 * fq;
            int kind; bf16_t* dst; int ld, sec0; float scl = 1.f;
            if (pos0 < P_KS)        { kind = 0; dst = q_s; ld = 512; sec0 = P_QS; scl = QSCALE; }
            else if (pos0 < P_VS)   { kind = 0; dst = k_s; ld = 128; sec0 = P_KS; }
            else if (pos0 < P_QD)   { kind = 1; dst = v_s; ld = 128; sec0 = P_VS; }
            else if (pos0 < P_KD)   { kind = 0; dst = q_d; ld = 256; sec0 = P_QD; scl = QSCALE; }
            else if (pos0 < P_VD)   { kind = 0; dst = k_d; ld = 64;  sec0 = P_KD; }
            else if (pos0 < P_QI)   { kind = 1; dst = v_d; ld = 64;  sec0 = P_VD; }
            else if (pos0 < P_KI)   { kind = 0; dst = q_i; ld = 256; sec0 = P_QI; }
            else if (pos0 < P_QM)   { kind = 0; dst = k_i; ld = 64;  sec0 = P_KI; }
            else if (pos0 < P_GATE) { kind = 1; dst = q_m; ld = 256; sec0 = P_QM; scl = QSCALE; }
            else if (pos0 < P_WI)   { kind = 2; dst = gates; ld = 3072; sec0 = P_GATE; }
            else                    { kind = 3; dst = nullptr; ld = 0; sec0 = P_WI; }
            const int lp = p - sec0;
            if (kind == 0) {
                const int head = lp >> 6, i0 = (lp & 63) >> 1;
#pragma unroll
                for (int ai = 0; ai < 2; ++ai)
#pragma unroll
                    for (int m = 0; m < 4; ++m) { const int row = u.pm * 256 + ai * 128 + wr * 64 + m * 16 + fr; const float s = inv_rms[row] * scl;
                        const f32x4 v0 = acc[ai][bj][m][0] * s, v1 = acc[ai][bj][m][1] * s;
                        const f32x4 ca = *(const f32x4*)(cs + (size_t)row * 64 + 2 * i0), cb = *(const f32x4*)(cs + (size_t)row * 64 + 2 * i0 + 4);
                        const float a0 = v0[0] * ca[0] - v0[1] * ca[1], b0 = v0[1] * ca[0] + v0[0] * ca[1];
                        const float a1 = v0[2] * ca[2] - v0[3] * ca[3], b1 = v0[3] * ca[2] + v0[2] * ca[3];
                        const float a2 = v1[0] * cb[0] - v1[1] * cb[1], b2 = v1[1] * cb[0] + v1[0] * cb[1];
                        const float a3 = v1[2] * cb[2] - v1[3] * cb[3], b3 = v1[3] * cb[2] + v1[2] * cb[3];
                        bf16_t* o = dst + (size_t)row * ld + head * 64 + i0;
                        u32x2 wa, wb; wa.x = cvtpk(a0, a1); wa.y = cvtpk(a2, a3); wb.x = cvtpk(b0, b1); wb.y = cvtpk(b2, b3);
                        *(u32x2*)o = wa; *(u32x2*)(o + 32) = wb; }
            } else if (kind == 1) {
#pragma unroll
                for (int ai = 0; ai < 2; ++ai)
#pragma unroll
                    for (int m = 0; m < 4; ++m) { const int row = u.pm * 256 + ai * 128 + wr * 64 + m * 16 + fr; const float s = inv_rms[row] * scl;
                        const f32x4 v0 = acc[ai][bj][m][0] * s, v1 = acc[ai][bj][m][1] * s;
                        u32x4 w; w.x = cvtpk(v0[0], v0[1]); w.y = cvtpk(v0[2], v0[3]); w.z = cvtpk(v1[0], v1[1]); w.w = cvtpk(v1[2], v1[3]);
                        *(u32x4*)(dst + (size_t)row * ld + lp) = w; }
            } else if (kind == 2) {
                const f32x4 g0 = *(const f32x4*)(b_gate + lp), g1 = *(const f32x4*)(b_gate + lp + 4);
#pragma unroll
                for (int ai = 0; ai < 2; ++ai)
#pragma unroll
                    for (int m = 0; m < 4; ++m) { const int row = u.pm * 256 + ai * 128 + wr * 64 + m * 16 + fr; const float s = inv_rms[row];
                        const f32x4 v0 = acc[ai][bj][m][0] * s + g0, v1 = acc[ai][bj][m][1] * s + g1;
                        u32x4 w; w.x = cvtpk(sigmoidf_fast(v0[0]), sigmoidf_fast(v0[1])); w.y = cvtpk(sigmoidf_fast(v0[2]), sigmoidf_fast(v0[3]));
                        w.z = cvtpk(sigmoidf_fast(v1[0]), sigmoidf_fast(v1[1])); w.w = cvtpk(sigmoidf_fast(v1[2]), sigmoidf_fast(v1[3]));
                        *(u32x4*)(dst + (size_t)row * ld + lp) = w; }
            } else {
                if (pos0 == P_WI && fq == 0) {
#pragma unroll
                    for (int ai = 0; ai < 2; ++ai)
#pragma unroll
                        for (int m = 0; m < 4; ++m) { const int row = u.pm * 256 + ai * 128 + wr * 64 + m * 16 + fr; const float s = inv_rms[row] * IDX_SCALE;
                            *(f32x4*)(w_i + (size_t)row * 4) = acc[ai][bj][m][0] * s; }
                }
            }
        }
    }
};

struct EpiMerge {
    static constexpr bool PERM = true;
    const bf16_t* gates; bf16_t* merged;
    __device__ __forceinline__ void operator()(const f32x4 (&acc)[2][2][4][2], const pg8::Unit& u, int wr, int wc, int fr, int fq) const {
        const int br = u.kind;
#pragma unroll
        for (int ai = 0; ai < 2; ++ai)
#pragma unroll
            for (int m = 0; m < 4; ++m) { const int row = u.pm * 256 + ai * 128 + wr * 64 + m * 16 + fr;
#pragma unroll
                for (int bj = 0; bj < 2; ++bj) { const int col = u.pn * 256 + bj * 128 + wc * 32 + 8 * fq;
                    const u32x4 g = *(const u32x4*)(gates + (size_t)row * 3072 + br * 1024 + col);
                    f32x4 v0 = acc[ai][bj][m][0], v1 = acc[ai][bj][m][1];
                    v0[0] *= bf_lo(g.x); v0[1] *= bf_hi(g.x); v0[2] *= bf_lo(g.y); v0[3] *= bf_hi(g.y); v1[0] *= bf_lo(g.z); v1[1] *= bf_hi(g.z); v1[2] *= bf_lo(g.w); v1[3] *= bf_hi(g.w);
                    bf16_t* o = merged + (size_t)row * 1024 + col;
                    if (br > 0) { const u32x4 pv = *(const u32x4*)o;
                        v0[0] += bf_lo(pv.x); v0[1] += bf_hi(pv.x); v0[2] += bf_lo(pv.y); v0[3] += bf_hi(pv.y); v1[0] += bf_lo(pv.z); v1[1] += bf_hi(pv.z); v1[2] += bf_lo(pv.w); v1[3] += bf_hi(pv.w); }
                    u32x4 w; w.x = cvtpk(v0[0], v0[1]); w.y = cvtpk(v0[2], v0[3]); w.z = cvtpk(v1[0], v1[1]); w.w = cvtpk(v1[2], v1[3]);
                    *(u32x4*)o = w; } }
    }
};

template <bool WRITE_BF> struct EpiResid {
    static constexpr bool PERM = false;
    const float* base; float* out; bf16_t* outb; float* ssq;
    __device__ __forceinline__ void operator()(const f32x4 (&acc)[2][2][4][2], const pg8::Unit& u, int wr, int wc, int fr, int fq) const {
#pragma unroll
        for (int ai = 0; ai < 2; ++ai)
#pragma unroll
            for (int m = 0; m < 4; ++m) { const int row = u.pm * 256 + ai * 128 + wr * 64 + m * 16 + fr; float q = 0.f;
#pragma unroll
                for (int bj = 0; bj < 2; ++bj)
#pragma unroll
                    for (int n = 0; n < 2; ++n) { const size_t off = (size_t)row * DM + u.pn * 256 + bj * 128 + wc * 32 + n * 16 + 4 * fq;
                        const f32x4 o = *(const f32x4*)(base + off) + acc[ai][bj][m][n];
                        *(f32x4*)(out + off) = o; q += (o[0] * o[0] + o[1] * o[1]) + (o[2] * o[2] + o[3] * o[3]);
                        if (WRITE_BF) { u32x2 w; w.x = cvtpk(o[0], o[1]); w.y = cvtpk(o[2], o[3]); *(u32x2*)(outb + off) = w; } }
                q += __shfl_xor(q, 16); q += __shfl_xor(q, 32);
                if (fq == 0) ssq[(size_t)row * 16 + u.pn * 4 + wc] = q; }
    }
};

struct EpiMlpIn {
    static constexpr bool PERM = true;
    const float* ssq; bf16_t* hid;
    __device__ __forceinline__ void operator()(const f32x4 (&acc)[2][2][4][2], const pg8::Unit& u, int wr, int wc, int fr, int fq) const {
#pragma unroll
        for (int ai = 0; ai < 2; ++ai)
#pragma unroll
            for (int m = 0; m < 4; ++m) { const int row = u.pm * 256 + ai * 128 + wr * 64 + m * 16 + fr;
                const f32x4* sp = (const f32x4*)(ssq + (size_t)row * 16); const f32x4 s0 = sp[0], s1 = sp[1], s2 = sp[2], s3 = sp[3];
                const float tot = ((s0[0] + s0[1]) + (s0[2] + s0[3])) + ((s1[0] + s1[1]) + (s1[2] + s1[3])) + ((s2[0] + s2[1]) + (s2[2] + s2[3])) + ((s3[0] + s3[1]) + (s3[2] + s3[3]));
                const float s = 1.0f / sqrtf(tot * (1.0f / DM) + EPS);
#pragma unroll
                for (int bj = 0; bj < 2; ++bj) { f32x4 v0 = acc[ai][bj][m][0] * s, v1 = acc[ai][bj][m][1] * s;
#pragma unroll
                    for (int e = 0; e < 4; ++e) { const float a = fmaxf(v0[e], 0.f), b = fmaxf(v1[e], 0.f); v0[e] = a * a; v1[e] = b * b; }
                    u32x4 w; w.x = cvtpk(v0[0], v0[1]); w.y = cvtpk(v0[2], v0[3]); w.z = cvtpk(v1[0], v1[1]); w.w = cvtpk(v1[2], v1[3]);
                    *(u32x4*)(hid + (size_t)row * DFF + u.pn * 256 + bj * 128 + wc * 32 + 8 * fq) = w; } }
    }
};

#define XB_TMO      128
#define XB_XCNT(j)  (256  + 64 * (j))
#define XB_XSUB(j)  (1280 + 64 * (j))
#define XB_XGEN(j)  (2304 + 64 * (j))
#define XB_TOP      3328
#define XB_TOPGEN   3392
#define XCD_BAR_WORDS 3456
#define XB_SPIN_CAP (1u << 20)
__device__ __forceinline__ unsigned xb_ld(unsigned* p)              { return __hip_atomic_load(p, __ATOMIC_RELAXED, __HIP_MEMORY_SCOPE_AGENT); }
__device__ __forceinline__ unsigned xb_add(unsigned* p, unsigned v) { return __hip_atomic_fetch_add(p, v, __ATOMIC_RELAXED, __HIP_MEMORY_SCOPE_AGENT); }
__device__ __forceinline__ unsigned xb_xcc_id() { return (unsigned)__builtin_amdgcn_s_getreg((3 << 11) | 20) & 0xFu; }
#define XB_SPIN(cond, bar) do { unsigned _sp = 0; while (cond) { __builtin_amdgcn_s_sleep(1); \
    if ((++_sp & 255u) == 0u) { if (xb_ld(&(bar)[XB_TMO])) break; if (_sp > XB_SPIN_CAP) { atomicAdd(&(bar)[XB_TMO], 1u); break; } } } } while (0)
struct XcdBarrier { unsigned* bar; unsigned x; volatile LAS unsigned* st; };
__device__ __forceinline__ XcdBarrier xcd_barrier_post(unsigned* bar, volatile LAS unsigned* st) {
    XcdBarrier b; b.bar = bar; b.x = xb_xcc_id(); b.st = st;
    if (threadIdx.x == 0) (void)xb_add(&bar[XB_XCNT(b.x)], 1u);
    return b;
}
__device__ __forceinline__ void xcd_barrier_complete(unsigned* bar, unsigned x, unsigned& nloc, unsigned& nx) {
    const unsigned G = gridDim.x * gridDim.y * gridDim.z;
    unsigned sum, cnt, mine, sp = 0u;
    for (;;) {
        sum = 0u; cnt = 0u; mine = 0u;
#pragma unroll
        for (unsigned j = 0; j < 16; ++j) { const unsigned c = xb_ld(&bar[XB_XCNT(j)]); sum += c; cnt += (c > 0u) ? 1u : 0u; mine = (j == x) ? c : mine; }
        if (sum == G) break;
        __builtin_amdgcn_s_sleep(1);
        if ((++sp & 255u) == 0u) { if (xb_ld(&bar[XB_TMO])) break; if (sp > XB_SPIN_CAP) { atomicAdd(&bar[XB_TMO], 1u); break; } }
    }
    nloc = mine > 0u ? mine : 1u; nx = cnt > 0u ? cnt : 1u;
}
__device__ __forceinline__ void xcd_barrier(const XcdBarrier& b) {
    asm volatile("s_waitcnt vmcnt(0)" ::: "memory");
    __syncthreads();
    if (threadIdx.x == 0) {
        unsigned* bar = b.bar;
        __builtin_amdgcn_s_waitcnt(0);
        unsigned nloc = b.st[0], nx = b.st[1];
        if (nloc == 0u) { xcd_barrier_complete(bar, b.x, nloc, nx); b.st[0] = nloc; b.st[1] = nx; }
        const unsigned old = xb_add(&bar[XB_XSUB(b.x)], 1u);
        const unsigned gen = old / nloc;
        if (old + 1u == (gen + 1u) * nloc) {
            __builtin_amdgcn_fence(__ATOMIC_RELEASE, "agent");
            asm volatile("s_waitcnt vmcnt(0)" ::: "memory");
            const unsigned og = xb_add(&bar[XB_TOP], 1u);
            const unsigned tg = og / nx;
            if (og + 1u == (tg + 1u) * nx) xb_add(&bar[XB_TOPGEN], 1u);
            else XB_SPIN(xb_ld(&bar[XB_TOPGEN]) == tg, bar);
            __builtin_amdgcn_fence(__ATOMIC_ACQUIRE, "agent");
            xb_add(&bar[XB_XGEN(b.x)], 1u);
            asm volatile("s_waitcnt vmcnt(0)" ::: "memory");
        } else {
            XB_SPIN(xb_ld(&bar[XB_XGEN(b.x)]) == gen, bar);
            __builtin_amdgcn_fence(__ATOMIC_ACQUIRE, "agent");
            asm volatile("s_waitcnt vmcnt(0)" ::: "memory");
        }
    }
    __syncthreads();
}

struct Frame {
    LAS unsigned char* lds;
    volatile LAS unsigned* MISC;
    unsigned* ctl;
    int tid, lane, wave, vcu, G;
    unsigned char* ws;
    const float *x, *mem; const int* positions; const float *g_mix, *w_in, *b_gate, *sinks, *g_mem, *w_mem_kv, *w_proj_swa, *w_proj_dsa, *w_proj_mem, *w_out, *g_mlp, *w_mlp_in, *w_mlp_out, *g_final;
    float* out;
};
#define WSP(T_, off) ((T_*)(F.ws + (off)))

__device__ __forceinline__ int rope_src(int base, int lp) { return base + (lp & ~63) + ((lp & 1) ? 32 + ((lp & 63) >> 1) : ((lp & 63) >> 1)); }
__device__ __forceinline__ int win_src(int pos) {
    if (pos < P_KS) return rope_src(0, pos);
    if (pos < P_VS) return rope_src(512, pos - P_KS);
    if (pos < P_QD) return pos;
    if (pos < P_KD) return rope_src(768, pos - P_QD);
    if (pos < P_VD) return rope_src(1024, pos - P_KD);
    if (pos < P_QI) return pos;
    if (pos < P_KI) return rope_src(1152, pos - P_QI);
    if (pos < P_QM) return rope_src(1408, pos - P_KI);
    if (pos < P_GATE) return 1476 + (pos - P_QM);
    if (pos < P_WI) return 1732 + (pos - P_GATE);
    if (pos < P_END) return 1472 + (pos - P_WI);
    return -1;
}
template <bool MAP> __device__ __forceinline__ void p0_transpose_item(const float* W, int ldw, int k0, int n0, const float* gk, bf16_t* WT, int ldwt, LAS float* scr, int lane) {
    const int j = lane & 31; const int sc = MAP ? win_src(n0 + j) : n0 + j;
#pragma unroll 8
    for (int i = 0; i < 32; ++i) { const int kk = 2 * i + (lane >> 5); float v = sc >= 0 ? W[(size_t)(k0 + kk) * ldw + sc] : 0.f; if (gk) v *= gk[k0 + kk]; scr[kk * 33 + j] = v; }
    LDS_WAIT(); asm volatile("" ::: "memory");
    const int c = lane & 7;
#pragma unroll
    for (int jj = 0; jj < 4; ++jj) { const int n = (lane >> 3) + 8 * jj; const LAS float* s = scr + (8 * c) * 33 + n;
        u32x4 o; o.x = cvtpk(s[0 * 33], s[1 * 33]); o.y = cvtpk(s[2 * 33], s[3 * 33]); o.z = cvtpk(s[4 * 33], s[5 * 33]); o.w = cvtpk(s[6 * 33], s[7 * 33]);
        *(u32x4*)(WT + (size_t)(n0 + n) * ldwt + k0 + 8 * c) = o; }
    LDS_WAIT(); asm volatile("" ::: "memory");
}
__device__ __forceinline__ void row_to_bf16(const float* xrow, bf16_t* orow, float* inv, int lane) {
    const f32x4* xr = (const f32x4*)xrow + lane;
    f32x4 v[4]; float s = 0.f;
#pragma unroll
    for (int j = 0; j < 4; ++j) { v[j] = xr[64 * j]; s += (v[j][0] * v[j][0] + v[j][1] * v[j][1]) + (v[j][2] * v[j][2] + v[j][3] * v[j][3]); }
    s = wave_sum(s);
    if (lane == 0) *inv = 1.0f / sqrtf(s * (1.0f / DM) + EPS);
    u32x2* o8 = (u32x2*)orow + lane;
#pragma unroll
    for (int j = 0; j < 4; ++j) { u32x2 w; w.x = cvtpk(v[j][0], v[j][1]); w.y = cvtpk(v[j][2], v[j][3]); o8[64 * j] = w; }
}
__device__ __forceinline__ void p0_prologue(Frame& F) {
    LAS float* scr = (LAS float*)(F.lds + RING_OFF + F.wave * 16384);
    const int gw = F.vcu * NWAVES + F.wave, NGW = F.G * NWAVES;
    constexpr int I_IN = 16 * (NPOS / 32), I_MEM = 16 * 16, I_PS = 8 * 32, I_PD = 4 * 32, I_PM = 4 * 32, I_OUT = 16 * 32, I_1 = 16 * 128, I_2 = 64 * 32;
    constexpr int NITEMS = I_IN + I_MEM + I_PS + I_PD + I_PM + I_OUT + I_1 + I_2;
    for (int it = gw; it < NITEMS; it += NGW) {
        int r = it;
        if (r < I_IN) { const int nb = NPOS / 32; p0_transpose_item<true>(F.w_in, DIN, 64 * (r / nb), 32 * (r % nb), F.g_mix, WSP(bf16_t, WS_WIN), DM, scr, F.lane); continue; } r -= I_IN;
        if (r < I_MEM) { p0_transpose_item<false>(F.w_mem_kv, 512, 64 * (r / 16), 32 * (r % 16), F.g_mem, WSP(bf16_t, WS_WMEM), DM, scr, F.lane); continue; } r -= I_MEM;
        if (r < I_PS) { p0_transpose_item<false>(F.w_proj_swa, DM, 64 * (r / 32), 32 * (r % 32), nullptr, WSP(bf16_t, WS_WPROJ), DM, scr, F.lane); continue; } r -= I_PS;
        if (r < I_PD) { p0_transpose_item<false>(F.w_proj_dsa, DM, 64 * (r / 32), 32 * (r % 32), nullptr, WSP(bf16_t, WS_WPROJ) + 512, DM, scr, F.lane); continue; } r -= I_PD;
        if (r < I_PM) { p0_transpose_item<false>(F.w_proj_mem, DM, 64 * (r / 32), 32 * (r % 32), nullptr, WSP(bf16_t, WS_WPROJ) + 768, DM, scr, F.lane); continue; } r -= I_PM;
        if (r < I_OUT) { p0_transpose_item<false>(F.w_out, DM, 64 * (r / 32), 32 * (r % 32), nullptr, WSP(bf16_t, WS_WOUT), DM, scr, F.lane); continue; } r -= I_OUT;
        if (r < I_1) { p0_transpose_item<false>(F.w_mlp_in, DFF, 64 * (r / 128), 32 * (r % 128), F.g_mlp, WSP(bf16_t, WS_W1), DM, scr, F.lane); continue; } r -= I_1;
        p0_transpose_item<false>(F.w_mlp_out, DM, 64 * (r / 32), 32 * (r % 32), nullptr, WSP(bf16_t, WS_W2), DFF, scr, F.lane);
    }
    for (int m = gw; m < T; m += NGW) row_to_bf16(F.x + (size_t)m * DM, WSP(bf16_t, WS_XB) + (size_t)m * DM, WSP(float, WS_INVRMS0) + m, F.lane);
    for (int m = gw; m < MROWS; m += NGW) row_to_bf16(F.mem + (size_t)m * DM, WSP(bf16_t, WS_MEMB) + (size_t)m * DM, WSP(float, WS_INVRMSM) + m, F.lane);
    { const int gt = gw * 64 + F.lane, NGT = NGW * 64; const int i = gt & 31;
      const float invf = (float)exp2((double)(-i) * (13.287712379549449 / 32.0));
      float* cs = WSP(float, WS_CS);
      for (int idx = gt; idx < T * 32; idx += NGT) { const float ang = (float)F.positions[idx >> 5] * invf; float s, c; sincosf(ang, &s, &c); *(f32x2*)(cs + (size_t)idx * 2) = (f32x2){c, s}; } }
}

__device__ __forceinline__ void p7_final_norm(Frame& F) {
    const int gw = F.vcu * NWAVES + F.wave, NGW = F.G * NWAVES;
    const float* ssq = WSP(float, WS_SSQ2);
    f32x4 g[4];
#pragma unroll
    for (int j = 0; j < 4; ++j) g[j] = ((const f32x4*)F.g_final)[F.lane + 64 * j];
    for (int m = gw; m < T; m += NGW) {
        float p = F.lane < 16 ? ssq[(size_t)m * 16 + F.lane] : 0.f;
        p = wave_sum(p);
        const float s = 1.0f / sqrtf(p * (1.0f / DM) + EPS);
        f32x4* o = (f32x4*)(F.out + (size_t)m * DM) + F.lane;
#pragma unroll
        for (int j = 0; j < 4; ++j) { const f32x4 v = o[64 * j]; o[64 * j] = v * s * g[j]; }
    }
}

__device__ __forceinline__ int crow(int r, int hi) { return (r & 3) + 8 * (r >> 2) + 4 * hi; }
__device__ __forceinline__ float xor32f(float v) { return __shfl_xor(v, 32); }

template <int MODE> __device__ __forceinline__ void attn32(const bf16_t* Qp, int ldq, const bf16_t* Kp, int ldk, const bf16_t* Vp, int ldv, int jlo, int jhi, int qpos0, float sink_l2, bf16_t* Op, int ldo, int lane) {
    const int r32 = lane & 31, hi = lane >> 5;
    bf16x8 qf[4];
#pragma unroll
    for (int s = 0; s < 4; ++s) qf[s] = *(const bf16x8*)(Qp + (size_t)r32 * ldq + 16 * s + 8 * hi);
    float m = MODE == 1 ? sink_l2 : -INFINITY, l = MODE == 1 ? 1.0f : 0.0f;
    f32x16 o0 = {}, o1 = {};
    const int qp = qpos0 + r32;
    for (int j = jlo; j < jhi; ++j) {
        const bf16_t* kr = Kp + (size_t)(32 * j + r32) * ldk + 8 * hi;
        f32x16 sc = {};
#pragma unroll
        for (int s = 0; s < 4; ++s) { const bf16x8 kf = *(const bf16x8*)(kr + 16 * s); sc = __builtin_amdgcn_mfma_f32_32x32x16_bf16(kf, qf[s], sc, 0, 0, 0); }
        if (MODE == 1) {
#pragma unroll
            for (int i = 0; i < 16; ++i) { const int kp = 32 * j + crow(i, hi); if (kp > qp || qp - kp >= 128) sc[i] = -INFINITY; }
        }
        float tm = sc[0];
#pragma unroll
        for (int i = 1; i < 16; ++i) tm = fmaxf(tm, sc[i]);
        tm = fmaxf(tm, xor32f(tm));
        const float mn = fmaxf(m, tm);
        const float alpha = (mn == -INFINITY) ? 1.0f : __builtin_amdgcn_exp2f(m - mn);
        const float msub = (mn == -INFINITY) ? 0.0f : mn;
        float rs = 0.f;
#pragma unroll
        for (int i = 0; i < 16; ++i) { sc[i] = __builtin_amdgcn_exp2f(sc[i] - msub); rs += sc[i]; }
        rs += xor32f(rs);
        l = l * alpha + rs; m = mn;
#pragma unroll
        for (int i = 0; i < 16; ++i) { o0[i] *= alpha; o1[i] *= alpha; }
        u32x4 pw[2];
#pragma unroll
        for (int s = 0; s < 2; ++s) { pw[s].x = cvtpk(sc[8 * s + 0], sc[8 * s + 1]); pw[s].y = cvtpk(sc[8 * s + 2], sc[8 * s + 3]); pw[s].z = cvtpk(sc[8 * s + 4], sc[8 * s + 5]); pw[s].w = cvtpk(sc[8 * s + 6], sc[8 * s + 7]); }
#pragma unroll
        for (int s = 0; s < 2; ++s) {
            bf16x8 a0, a1;
#pragma unroll
            for (int jj = 0; jj < 8; ++jj) { const bf16_t* vr = Vp + (size_t)(32 * j + 16 * s + 8 * (jj >> 2) + 4 * hi + (jj & 3)) * ldv + r32; a0[jj] = (short)vr[0]; a1[jj] = (short)vr[32]; }
            const bf16x8 pb = __builtin_bit_cast(bf16x8, pw[s]);
            o0 = __builtin_amdgcn_mfma_f32_32x32x16_bf16(a0, pb, o0, 0, 0, 0);
            o1 = __builtin_amdgcn_mfma_f32_32x32x16_bf16(a1, pb, o1, 0, 0, 0);
        }
    }
    const float rl = 1.0f / l;
    bf16_t* orow = Op + (size_t)r32 * ldo;
#pragma unroll
    for (int g = 0; g < 4; ++g) {
        u32x2 w0, w1; w0.x = cvtpk(o0[4 * g] * rl, o0[4 * g + 1] * rl); w0.y = cvtpk(o0[4 * g + 2] * rl, o0[4 * g + 3] * rl);
        w1.x = cvtpk(o1[4 * g] * rl, o1[4 * g + 1] * rl); w1.y = cvtpk(o1[4 * g + 2] * rl, o1[4 * g + 3] * rl);
        *(u32x2*)(orow + 8 * g + 4 * hi) = w0; *(u32x2*)(orow + 32 + 8 * g + 4 * hi) = w1;
    }
}

__device__ __forceinline__ void swa_item(Frame& F, int b, int qb) {
    const int h = F.wave, kvh = h >> 2;
    const float sink = F.sinks[h] * LOG2E;
    const bf16_t* Kp = WSP(const bf16_t, WS_KS) + (size_t)b * SEQ * 128 + kvh * 64;
    const bf16_t* Vp = WSP(const bf16_t, WS_VS) + (size_t)b * SEQ * 128 + kvh * 64;
    for (int sub = 0; sub < 4; ++sub) {
        const int q0 = qb * 128 + 32 * sub; const int jhi = q0 / 32 + 1; int jlo = jhi - 5; if (jlo < 0) jlo = 0;
        attn32<1>(WSP(const bf16_t, WS_QS) + ((size_t)b * SEQ + q0) * 512 + h * 64, 512, Kp, 128, Vp, 128, jlo, jhi, q0, sink, WSP(bf16_t, WS_OCAT) + ((size_t)b * SEQ + q0) * DM + h * 64, DM, F.lane);
    }
}
__device__ __forceinline__ void mem_item(Frame& F, int b, int qb) {
    const int h = F.wave & 3, half = F.wave >> 2;
    const bf16_t* Kp = WSP(const bf16_t, WS_MK) + (size_t)b * MEMLEN * 256 + h * 64;
    const bf16_t* Vp = WSP(const bf16_t, WS_MV) + (size_t)b * MEMLEN * 256 + h * 64;
    for (int sub = 0; sub < 2; ++sub) {
        const int q0 = qb * 128 + 64 * half + 32 * sub;
        attn32<0>(WSP(const bf16_t, WS_QM) + ((size_t)b * SEQ + q0) * 256 + h * 64, 256, Kp, 256, Vp, 256, 0, MEMLEN / 32, 0, 0.f, WSP(bf16_t, WS_OCAT) + ((size_t)b * SEQ + q0) * DM + 768 + h * 64, DM, F.lane);
    }
}

constexpr int DSA_CAP = 512;
constexpr int DL_MAX = 0;
constexpr int DL_CKEY = 0;
constexpr int DL_CIDX = 65536;
constexpr int DL_CNT = 98304;
constexpr int DL_BM = 99328;
constexpr int DL_SEL = 107520;
constexpr int DL_WSCR = 0;
__device__ __forceinline__ unsigned fkey(float f) { const unsigned u = __float_as_uint(f); return (u & 0x80000000u) ? ~u : (u | 0x80000000u); }

__device__ __forceinline__ void dsa_item(Frame& F, int b, int t0) {
    const int lane = F.lane, wid = F.wave, r32 = lane & 31, hi = lane >> 5;
    LAS unsigned short* maxbuf = (LAS unsigned short*)(F.lds + DL_MAX);
    LAS unsigned* ckey = (LAS unsigned*)(F.lds + DL_CKEY);
    LAS unsigned short* cidx = (LAS unsigned short*)(F.lds + DL_CIDX);
    LAS unsigned* ccnt = (LAS unsigned*)(F.lds + DL_CNT);
    LAS unsigned* ctau = ccnt + 32;
    LAS unsigned* bm = (LAS unsigned*)(F.lds + DL_BM) + wid * 256;
    LAS unsigned short* sel = (LAS unsigned short*)(F.lds + DL_SEL);
    const size_t rowb = (size_t)b * SEQ;
    __syncthreads();
    if (t0 >= TOPK) {
        const int nkt = t0 / 32 + 1, nmax = t0 + 32;
        int lg = 0; while ((1024 << lg) < nmax) ++lg;
        const int npl = 16 >> lg;
        bf16x8 qf[4][4]; float wq[4];
        { const bf16_t* qrow = WSP(const bf16_t, WS_QI) + (rowb + t0 + r32) * 256 + 8 * hi;
#pragma unroll
          for (int h = 0; h < 4; ++h)
#pragma unroll
              for (int s = 0; s < 4; ++s) qf[h][s] = *(const bf16x8*)(qrow + h * 64 + 16 * s);
          const f32x4 w4 = *(const f32x4*)(WSP(const float, WS_WI) + (rowb + t0 + r32) * 4); wq[0] = w4[0]; wq[1] = w4[1]; wq[2] = w4[2]; wq[3] = w4[3]; }
        if (F.tid < 32) ccnt[F.tid] = 0u;
        unsigned tk = 0u;
        for (int pass = 0; pass < 2; ++pass) {
            if (pass == 1) tk = ctau[r32];
            for (int j = wid; j < nkt; j += NWAVES) {
                const bf16_t* kr = WSP(const bf16_t, WS_KI) + (rowb + 32 * j + r32) * 64 + 8 * hi;
                bf16x8 kf[4];
#pragma unroll
                for (int s = 0; s < 4; ++s) kf[s] = *(const bf16x8*)(kr + 16 * s);
                float sc[16];
#pragma unroll
                for (int i = 0; i < 16; ++i) sc[i] = 0.f;
#pragma unroll
                for (int h = 0; h < 4; ++h) { f32x16 d = {};
#pragma unroll
                    for (int s = 0; s < 4; ++s) d = __builtin_amdgcn_mfma_f32_32x32x16_bf16(kf[s], qf[h][s], d, 0, 0, 0);
#pragma unroll
                    for (int i = 0; i < 16; ++i) sc[i] = fmaf(fmaxf(d[i], 0.f), wq[h], sc[i]); }
                unsigned key[16];
#pragma unroll
                for (int i = 0; i < 16; ++i) { float v = sc[i]; if (j == nkt - 1 && crow(i, hi) > r32) v = -INFINITY; key[i] = fkey(v); }
                if (pass == 0) {
                    LAS unsigned short* mb = maxbuf + r32 * 1024 + (j * 2 + hi) * npl;
                    if (lg == 0) {
#pragma unroll
                        for (int i = 0; i < 16; ++i) mb[i] = (unsigned short)(key[i] >> 16);
                    } else {
                        unsigned m2[8];
#pragma unroll
                        for (int i = 0; i < 8; ++i) m2[i] = key[2 * i] > key[2 * i + 1] ? key[2 * i] : key[2 * i + 1];
                        if (lg == 1) {
#pragma unroll
                            for (int i = 0; i < 8; ++i) mb[i] = (unsigned short)(m2[i] >> 16);
                        } else {
                            unsigned m4[4];
#pragma unroll
                            for (int i = 0; i < 4; ++i) m4[i] = m2[2 * i] > m2[2 * i + 1] ? m2[2 * i] : m2[2 * i + 1];
                            if (lg == 2) {
#pragma unroll
                                for (int i = 0; i < 4; ++i) mb[i] = (unsigned short)(m4[i] >> 16);
                            } else {
                                const unsigned a = m4[0] > m4[1] ? m4[0] : m4[1], c = m4[2] > m4[3] ? m4[2] : m4[3];
                                mb[0] = (unsigned short)(a >> 16); mb[1] = (unsigned short)(c >> 16);
                            }
                        }
                    }
                } else {
#pragma unroll
                    for (int i = 0; i < 16; ++i) {
                        if ((key[i] >> 16) >= tk) {
                            const unsigned slot = __hip_atomic_fetch_add(ccnt + r32, 1u, __ATOMIC_RELAXED, __HIP_MEMORY_SCOPE_WORKGROUP);
                            if (slot < (unsigned)DSA_CAP) { ckey[r32 * DSA_CAP + slot] = key[i]; cidx[r32 * DSA_CAP + slot] = (unsigned short)(32 * j + crow(i, hi)); }
                        }
                    }
                }
            }
            __syncthreads();
            if (pass == 0) {
                const int G = nmax >> lg;
                for (int jq = 0; jq < 4; ++jq) { const int q = wid * 4 + jq;
                    unsigned v[16];
#pragma unroll
                    for (int i = 0; i < 16; ++i) { const int e = lane + 64 * i; v[i] = e < G ? (unsigned)maxbuf[q * 1024 + e] : 0u; }
                    unsigned prefix = 0u; int k = TOPK;
                    for (int bit = 15; bit >= 0; --bit) { const unsigned test = (prefix | (1u << bit)) >> bit; int cnt = 0;
#pragma unroll
                        for (int i = 0; i < 16; ++i) cnt += __popcll(__ballot((v[i] >> bit) == test));
                        if (cnt >= k) prefix |= (1u << bit); else k -= cnt; }
                    if (lane == 0) ctau[q] = prefix;
                }
                __syncthreads();
            }
        }
        for (int jq = 0; jq < 4; ++jq) { const int q = wid * 4 + jq;
            unsigned c = ccnt[q]; if (c > (unsigned)DSA_CAP) c = DSA_CAP;
            unsigned kv[8], ix[8];
#pragma unroll
            for (int i = 0; i < 8; ++i) { const unsigned e = lane + 64 * i; kv[i] = e < c ? ckey[q * DSA_CAP + e] : 0u; ix[i] = e < c ? (unsigned)cidx[q * DSA_CAP + e] : 0xffffu; }
            unsigned prefix = 0u; int k = TOPK;
            for (int bit = 31; bit >= 0; --bit) { const unsigned test = (prefix | (1u << bit)) >> bit; int cnt = 0;
#pragma unroll
                for (int i = 0; i < 8; ++i) cnt += __popcll(__ballot((kv[i] >> bit) == test));
                if (cnt >= k) prefix |= (1u << bit); else k -= cnt; }
            int ceq = 0;
#pragma unroll
            for (int i = 0; i < 8; ++i) ceq += __popcll(__ballot(kv[i] == prefix));
            unsigned ti = 0xffffu;
            if (ceq > k) {
                unsigned pi = 0u; int kk = k;
                for (int bit = 15; bit >= 0; --bit) { const unsigned test = pi >> bit; int cnt = 0;
#pragma unroll
                    for (int i = 0; i < 8; ++i) cnt += __popcll(__ballot(kv[i] == prefix && (ix[i] >> bit) == test));
                    if (cnt < kk) { kk -= cnt; pi |= (1u << bit); } }
                ti = pi;
            }
#pragma unroll
            for (int i = 0; i < 4; ++i) bm[lane * 4 + i] = 0u;
            LDS_WAIT();
#pragma unroll
            for (int i = 0; i < 8; ++i) if (kv[i] > prefix || (kv[i] == prefix && ix[i] <= ti)) __hip_atomic_fetch_or(bm + (ix[i] >> 5), 1u << (ix[i] & 31), __ATOMIC_RELAXED, __HIP_MEMORY_SCOPE_WORKGROUP);
            LDS_WAIT();
            unsigned w[4]; int n = 0;
#pragma unroll
            for (int i = 0; i < 4; ++i) { w[i] = bm[lane * 4 + i]; n += __popc(w[i]); }
            int pos = n;
#pragma unroll
            for (int o = 1; o < 64; o <<= 1) { const int t = __shfl_up(pos, o); if (lane >= o) pos += t; }
            pos -= n;
#pragma unroll
            for (int i = 0; i < 4; ++i) { unsigned ww = w[i]; while (ww) { const int bpos = __ffs((int)ww) - 1; ww &= ww - 1; if (pos < TOPK) sel[q * 256 + pos] = (unsigned short)(lane * 128 + i * 32 + bpos); ++pos; } }
            LDS_WAIT();
        }
    } else {
        for (int e = F.tid; e < 32 * 256; e += NWAVES * 64) sel[e] = (unsigned short)(e & 255);
    }
    __syncthreads();
    LAS float* wq_l = (LAS float*)(F.lds + DL_WSCR + wid * 5120);
    LAS float* wp_l = wq_l + 256;
    const bf16_t* Kd = WSP(const bf16_t, WS_KD) + rowb * 64;
    const bf16_t* Vd = WSP(const bf16_t, WS_VD) + rowb * 64;
    for (int jq = 0; jq < 4; ++jq) { const int q = wid * 4 + jq, t = t0 + q; const int nsel = t + 1 < TOPK ? t + 1 : TOPK;
        { const u32x2 qq = *(const u32x2*)(WSP(const bf16_t, WS_QD) + (rowb + t) * 256 + lane * 4);
          *(LAS f32x4*)(wq_l + lane * 4) = (f32x4){bf_lo(qq.x), bf_hi(qq.x), bf_lo(qq.y), bf_hi(qq.y)}; }
        LDS_WAIT();
#pragma unroll 1
        for (int it = 0; it < 4; ++it) { const int e = lane + 64 * it; const bool valid = e < nsel; const int kidx = valid ? (int)sel[q * 256 + e] : 0;
            const u32x4* kr = (const u32x4*)(Kd + (size_t)kidx * 64);
            float a[4] = {0.f, 0.f, 0.f, 0.f};
#pragma unroll 2
            for (int c = 0; c < 8; ++c) { const u32x4 kk = kr[c]; const float kf[8] = {bf_lo(kk.x), bf_hi(kk.x), bf_lo(kk.y), bf_hi(kk.y), bf_lo(kk.z), bf_hi(kk.z), bf_lo(kk.w), bf_hi(kk.w)};
#pragma unroll
                for (int h = 0; h < 4; ++h) { const f32x4 qa = *(const LAS f32x4*)(wq_l + h * 64 + 8 * c), qb = *(const LAS f32x4*)(wq_l + h * 64 + 8 * c + 4);
                    a[h] += (kf[0] * qa[0] + kf[1] * qa[1]) + (kf[2] * qa[2] + kf[3] * qa[3]) + (kf[4] * qb[0] + kf[5] * qb[1]) + (kf[6] * qb[2] + kf[7] * qb[3]); } }
            *(LAS f32x4*)(wp_l + e * 4) = valid ? (f32x4){a[0], a[1], a[2], a[3]} : (f32x4){-INFINITY, -INFINITY, -INFINITY, -INFINITY}; }
        LDS_WAIT();
        f32x4 lg[4];
#pragma unroll
        for (int it = 0; it < 4; ++it) lg[it] = *(const LAS f32x4*)(wp_l + (lane + 64 * it) * 4);
        float rl[4];
#pragma unroll
        for (int h = 0; h < 4; ++h) { float mx = fmaxf(fmaxf(lg[0][h], lg[1][h]), fmaxf(lg[2][h], lg[3][h])); mx = wave_max(mx); float s = 0.f;
#pragma unroll
            for (int it = 0; it < 4; ++it) { lg[it][h] = __builtin_amdgcn_exp2f(lg[it][h] - mx); s += lg[it][h]; }
            rl[h] = 1.0f / wave_sum(s); }
#pragma unroll
        for (int it = 0; it < 4; ++it) *(LAS f32x4*)(wp_l + (lane + 64 * it) * 4) = lg[it];
        LDS_WAIT();
        float o[4] = {0.f, 0.f, 0.f, 0.f};
        for (int e0 = 0; e0 < nsel; e0 += 8) {
            float vv[8];
#pragma unroll
            for (int u = 0; u < 8; ++u) { const int e = e0 + u; const int kidx = e < nsel ? (int)sel[q * 256 + e] : 0; vv[u] = __uint_as_float((unsigned)Vd[(size_t)kidx * 64 + lane] << 16); }
#pragma unroll
            for (int u = 0; u < 8; ++u) { const int e = e0 + u; if (e < nsel) { const f32x4 p4 = *(const LAS f32x4*)(wp_l + e * 4);
                o[0] += p4[0] * vv[u]; o[1] += p4[1] * vv[u]; o[2] += p4[2] * vv[u]; o[3] += p4[3] * vv[u]; } }
        }
        bf16_t* orow = WSP(bf16_t, WS_OCAT) + (rowb + t) * DM + 512;
#pragma unroll
        for (int h = 0; h < 4; ++h) orow[h * 64 + lane] = (bf16_t)(cvtpk(o[h] * rl[h], 0.f) & 0xffffu);
        LDS_WAIT();
    }
}

__device__ __forceinline__ void p2_attention(Frame& F) {
    const int NIT = NB * (SEQ / 32);
    for (int r = 0; r < (NIT + F.G - 1) / F.G; ++r) {
        int b, tile;
        if (F.G == 256) { const int j = F.vcu & 63; b = F.vcu >> 6; tile = r == 0 ? j : (r == 1 ? 127 - j : (r == 2 ? 128 + j : 255 - j)); }
        else { const int it = r * F.G + F.vcu; if (it >= NIT) break; b = it / (SEQ / 32); tile = it % (SEQ / 32); }
        dsa_item(F, b, tile * 32);
    }
    for (int it = F.vcu; it < NB * (SEQ / 128); it += F.G) swa_item(F, it / (SEQ / 128), it % (SEQ / 128));
    for (int it = F.vcu; it < NB * (SEQ / 128); it += F.G) mem_item(F, it / (SEQ / 128), it % (SEQ / 128));
}

#ifndef MK_N_LAUNCHES
#define MK_N_LAUNCHES 1
#endif
constexpr int N_PHASES = 8;
struct Args { const void* in[17]; float* out; unsigned char* ws; int ph_lo, ph_hi, li, pad; };

__global__ void __launch_bounds__(NWAVES * 64, 2) hybrid_fwd(Args args) {
    extern __shared__ __attribute__((aligned(16))) unsigned char lds[];
    Frame F;
    F.lds = (LAS unsigned char*)lds;
    F.MISC = (volatile LAS unsigned*)(F.lds + MISC_OFF);
    F.tid = threadIdx.x; F.lane = F.tid & 63; F.wave = __builtin_amdgcn_readfirstlane(F.tid >> 6);
    F.G = gridDim.x; { const int bx = blockIdx.x; F.vcu = (F.G % 8 == 0) ? (bx % 8) * (F.G / 8) + bx / 8 : bx; }
    F.ws = args.ws; F.ctl = (unsigned*)(args.ws + WS_CTL);
    F.x = (const float*)args.in[0]; F.mem = (const float*)args.in[1]; F.positions = (const int*)args.in[2]; F.g_mix = (const float*)args.in[3]; F.w_in = (const float*)args.in[4];
    F.b_gate = (const float*)args.in[5]; F.sinks = (const float*)args.in[6]; F.g_mem = (const float*)args.in[7]; F.w_mem_kv = (const float*)args.in[8]; F.w_proj_swa = (const float*)args.in[9];
    F.w_proj_dsa = (const float*)args.in[10]; F.w_proj_mem = (const float*)args.in[11]; F.w_out = (const float*)args.in[12]; F.g_mlp = (const float*)args.in[13]; F.w_mlp_in = (const float*)args.in[14];
    F.w_mlp_out = (const float*)args.in[15]; F.g_final = (const float*)args.in[16]; F.out = args.out;
    for (int u = F.tid; u < (LDS_BYTES - LDSCTL_OFF) / 4; u += NWAVES * 64) ((LAS unsigned*)(F.lds + LDSCTL_OFF))[u] = 0u;
    __syncthreads();
    XcdBarrier bar; bar.bar = F.ctl + CW_BAR + args.li * XCD_BAR_WORDS; bar.x = 0; bar.st = nullptr;
    if (args.ph_hi - args.ph_lo > 1) bar = xcd_barrier_post(F.ctl + CW_BAR + args.li * XCD_BAR_WORDS, F.MISC + 8);
    const int lo = args.ph_lo, hi = args.ph_hi;
#ifndef PHASE_MASK
#define PHASE_MASK 0xff
#endif
#define IN(k) (((PHASE_MASK >> (k)) & 1) && lo <= (k) && (k) < hi)
#define BOTH(k) (IN(k) && IN((k) + 1))
#define GRID_BAR() xcd_barrier(bar)
    const int bx = (int)blockIdx.x;

    if (IN(0)) { p0_prologue(F); if (BOTH(0)) GRID_BAR(); }

    if (IN(1)) {
        SchedInProj S; S.nM = T / 256; S.nN = NPOS / 256; S.nwg = S.nM * S.nN; S.G = F.G; S.c = bx;
        S.Ab = (const char*)WSP(bf16_t, WS_XB); S.Bb = (const char*)WSP(bf16_t, WS_WIN); S.Am = (const char*)WSP(bf16_t, WS_MEMB); S.Bm = (const char*)WSP(bf16_t, WS_WMEM);
        EpiInProj E; E.inv_rms = WSP(float, WS_INVRMS0); E.inv_rms_mem = WSP(float, WS_INVRMSM); E.cs = WSP(float, WS_CS); E.b_gate = F.b_gate;
        E.q_s = WSP(bf16_t, WS_QS); E.k_s = WSP(bf16_t, WS_KS); E.v_s = WSP(bf16_t, WS_VS); E.q_d = WSP(bf16_t, WS_QD); E.k_d = WSP(bf16_t, WS_KD); E.v_d = WSP(bf16_t, WS_VD);
        E.q_i = WSP(bf16_t, WS_QI); E.k_i = WSP(bf16_t, WS_KI); E.q_m = WSP(bf16_t, WS_QM); E.gates = WSP(bf16_t, WS_GATES); E.mk = WSP(bf16_t, WS_MK); E.mv = WSP(bf16_t, WS_MV); E.w_i = WSP(float, WS_WI);
        pg8::gemm_phase<EpiInProj, SchedInProj, true>(F.lds + RING_OFF, DM, DM, S, E);
        if (BOTH(1)) GRID_BAR();
    }

    if (IN(2)) { p2_attention(F); if (BOTH(2)) GRID_BAR(); }

    if (IN(3)) {
        SchedMerge S; S.G = F.G; S.c = bx; S.Ab = (const char*)WSP(bf16_t, WS_OCAT); S.Bb = (const char*)WSP(bf16_t, WS_WPROJ);
        EpiMerge E; E.gates = WSP(bf16_t, WS_GATES); E.merged = WSP(bf16_t, WS_MERGED);
        pg8::gemm_phase<EpiMerge, SchedMerge, true>(F.lds + RING_OFF, DM, DM, S, E);
        if (BOTH(3)) GRID_BAR();
    }

    if (IN(4)) {
        SchedGrid S; S.nM = T / 256; S.nN = DM / 256; S.nwg = S.nM * S.nN; S.G = F.G; S.c = bx; S.nt = DM / 64;
        S.Ab = (const char*)WSP(bf16_t, WS_MERGED); S.Bb = (const char*)WSP(bf16_t, WS_WOUT); S.tA = (size_t)256 * DM * 2; S.tB = (size_t)256 * DM * 2;
        EpiResid<true> E; E.base = F.x; E.out = F.out; E.outb = WSP(bf16_t, WS_XB); E.ssq = WSP(float, WS_SSQ1);
        pg8::gemm_phase<EpiResid<true>, SchedGrid, true>(F.lds + RING_OFF, DM, DM, S, E);
        if (BOTH(4)) GRID_BAR();
    }

    if (IN(5)) {
        SchedGrid S; S.nM = T / 256; S.nN = DFF / 256; S.nwg = S.nM * S.nN; S.G = F.G; S.c = bx; S.nt = DM / 64;
        S.Ab = (const char*)WSP(bf16_t, WS_XB); S.Bb = (const char*)WSP(bf16_t, WS_W1); S.tA = (size_t)256 * DM * 2; S.tB = (size_t)256 * DM * 2;
        EpiMlpIn E; E.ssq = WSP(float, WS_SSQ1); E.hid = WSP(bf16_t, WS_HID);
        pg8::gemm_phase<EpiMlpIn, SchedGrid, true>(F.lds + RING_OFF, DM, DM, S, E);
        if (BOTH(5)) GRID_BAR();
    }

    if (IN(6)) {
        SchedGrid S; S.nM = T / 256; S.nN = DM / 256; S.nwg = S.nM * S.nN; S.G = F.G; S.c = bx; S.nt = DFF / 64;
        S.Ab = (const char*)WSP(bf16_t, WS_HID); S.Bb = (const char*)WSP(bf16_t, WS_W2); S.tA = (size_t)256 * DFF * 2; S.tB = (size_t)256 * DFF * 2;
        EpiResid<false> E; E.base = F.out; E.out = F.out; E.outb = nullptr; E.ssq = WSP(float, WS_SSQ2);
        pg8::gemm_phase<EpiResid<false>, SchedGrid, true>(F.lds + RING_OFF, DFF, DFF, S, E);
        if (BOTH(6)) GRID_BAR();
    }

    if (IN(7)) p7_final_norm(F);
#undef IN
#undef BOTH
#undef GRID_BAR
}

extern "C" void kernel_launch(void* const* d_in, const int* in_sizes, int n_in, void* d_out, int out_size, void* d_ws, size_t ws_size, hipStream_t stream) {
    static int grid = 0;
    if (grid == 0) {
        if (n_in != 17 || in_sizes[0] != T * DM || out_size != T * DM || ws_size < WS_END) { fprintf(stderr, "kernel_launch: unexpected shapes (n_in %d, in0 %d, out %d, ws %zu < %zu); nothing launched\n", n_in, n_in > 0 ? in_sizes[0] : -1, out_size, ws_size, (size_t)WS_END); grid = -1; return; }
        int dev = 0, cus = 0, per_cu = 0;
        if (hipGetDevice(&dev) != hipSuccess || hipDeviceGetAttribute(&cus, hipDeviceAttributeMultiprocessorCount, dev) != hipSuccess) { grid = -1; return; }
        if (hipFuncSetAttribute((const void*)hybrid_fwd, hipFuncAttributeMaxDynamicSharedMemorySize, LDS_BYTES) != hipSuccess) { fprintf(stderr, "kernel_launch: hipFuncSetAttribute failed\n"); grid = -1; return; }
        if (hipOccupancyMaxActiveBlocksPerMultiprocessor(&per_cu, (const void*)hybrid_fwd, NWAVES * 64, LDS_BYTES) != hipSuccess || per_cu < 1) { fprintf(stderr, "kernel_launch: occupancy query reports %d workgroups per CU; nothing launched\n", per_cu); (void)hipGetLastError(); grid = -1; return; }
        (void)hipGetLastError();
        grid = cus;
    }
    if (grid < 0) return;
    if (hipMemsetAsync((char*)d_ws + WS_CTL, 0, CTL_ZERO_BYTES, stream) != hipSuccess) return;
    Args a{};
    for (int i = 0; i < 17; ++i) a.in[i] = d_in[i];
    a.out = (float*)d_out; a.ws = (unsigned char*)d_ws;
    if (MK_N_LAUNCHES == 1) { a.ph_lo = 0; a.ph_hi = N_PHASES; a.li = 0; hipLaunchKernelGGL(hybrid_fwd, dim3(grid), dim3(NWAVES * 64), LDS_BYTES, stream, a); }
    else { for (int p = 0; p < N_PHASES; ++p) { a.ph_lo = p; a.ph_hi = p + 1; a.li = 0; hipLaunchKernelGGL(hybrid_fwd, dim3(grid), dim3(NWAVES * 64), LDS_BYTES, stream, a); } }
}
```

```cpp
#include <hip/hip_runtime.h>
#include <cstdio>
#include <cstdint>

#define LAS __attribute__((address_space(3)))
#define GAS __attribute__((address_space(1)))
typedef unsigned short bf16_t;
typedef short bf16x8 __attribute__((ext_vector_type(8)));
typedef float f32x2 __attribute__((ext_vector_type(2)));
typedef float f32x4 __attribute__((ext_vector_type(4)));
typedef float f32x16 __attribute__((ext_vector_type(16)));
typedef unsigned u32x2 __attribute__((ext_vector_type(2)));
typedef unsigned u32x4 __attribute__((ext_vector_type(4)));
typedef __bf16 bf16x2_t __attribute__((ext_vector_type(2)));

constexpr int NB = 4, SEQ = 8192, T = NB * SEQ, DM = 1024, DFF = 4096, DIN = 4804, NPOS = 4864, MEMLEN = 256, MROWS = NB * MEMLEN;
constexpr float EPS = 1e-6f;
constexpr float LOG2E = 1.4426950408889634f;
constexpr float QSCALE = 0.125f * LOG2E;
constexpr float IDX_SCALE = 0.0625f;
constexpr int TOPK = 256;
constexpr int P_QS = 0, P_KS = 512, P_VS = 640, P_QD = 768, P_KD = 1024, P_VD = 1088, P_QI = 1152, P_KI = 1408, P_QM = 1472, P_GATE = 1728, P_WI = 4800, P_END = 4804;

constexpr size_t MiB = 1u << 20;
constexpr size_t WS_CTL = 0, CTL_ZERO_BYTES = 1 * MiB;
constexpr size_t WS_WIN = 1 * MiB, WS_WMEM = 11 * MiB, WS_WPROJ = 12 * MiB, WS_WOUT = 14 * MiB, WS_W1 = 16 * MiB, WS_W2 = 24 * MiB;
constexpr size_t WS_INVRMS0 = 32 * MiB, WS_INVRMSM = 32 * MiB + 128 * 1024, WS_WI = 32 * MiB + 256 * 1024;
constexpr size_t WS_SSQ1 = 33 * MiB, WS_SSQ2 = 35 * MiB, WS_CS = 37 * MiB, WS_MEMB = 45 * MiB, WS_MK = 47 * MiB, WS_MV = 47 * MiB + 512 * 1024;
constexpr size_t WS_XB = 48 * MiB;
constexpr size_t WS_OCAT = 112 * MiB;
constexpr size_t WS_QS = 176 * MiB, WS_KS = 208 * MiB, WS_VS = 216 * MiB, WS_QD = 224 * MiB, WS_KD = 240 * MiB, WS_VD = 244 * MiB, WS_QI = 248 * MiB, WS_KI = 264 * MiB, WS_QM = 268 * MiB;
constexpr size_t WS_GATES = 284 * MiB;
constexpr size_t WS_MERGED = 176 * MiB;
constexpr size_t WS_HID = 176 * MiB;
constexpr size_t WS_END = 476 * MiB;
static_assert(WS_WIN + (size_t)NPOS * DM * 2 <= WS_WMEM && WS_GATES + (size_t)T * 3072 * 2 <= WS_END && WS_HID + (size_t)T * DFF * 2 <= WS_END, "d_ws map");
constexpr int CW_TMO = 0, CW_CODE = 1, CW_BAR = 4096;

constexpr int RING_OFF = 0, RING_BYTES = 131072;
constexpr int LDSCTL_OFF = RING_BYTES, MISC_OFF = LDSCTL_OFF + 320;
constexpr int LDS_BYTES = 147456;
constexpr int NWAVES = 8;

#define LDS_WAIT() asm volatile("s_waitcnt lgkmcnt(0)" ::: "memory")
#define VM_WAIT() asm volatile("s_waitcnt vmcnt(0)" ::: "memory")
#define RLX_AGENT __ATOMIC_RELAXED, __HIP_MEMORY_SCOPE_AGENT

__device__ __forceinline__ unsigned cvtpk(float lo, float hi) { f32x2 v = {lo, hi}; bf16x2_t b = __builtin_convertvector(v, bf16x2_t); return __builtin_bit_cast(unsigned, b); }
__device__ __forceinline__ float bf_lo(unsigned w) { return __uint_as_float(w << 16); }
__device__ __forceinline__ float bf_hi(unsigned w) { return __uint_as_float(w & 0xffff0000u); }
__device__ __forceinline__ float wave_sum(float v) {
#pragma unroll
    for (int o = 1; o < 64; o <<= 1) v += __shfl_xor(v, o);
    return v;
}
__device__ __forceinline__ float wave_max(float v) {
#pragma unroll
    for (int o = 1; o < 64; o <<= 1) v = fmaxf(v, __shfl_xor(v, o));
    return v;
}

namespace pg8 {
constexpr int BM = 256, BK = 64, HALF = 128, HTB = HALF * BK * 2  , STAGE_BYTES = 8 * HTB, NXCD = 8, WGM = 8;
__host__ __device__ __forceinline__ int lds_byte(int r, int c) { const int st = (r >> 4) * 2 + (c >> 5), rr = r & 15, cc = c & 31, ob = rr * 64 + cc * 2; return st * 1024 + (ob ^ (((ob >> 9) & 1) << 5)); }
__host__ __device__ __forceinline__ void stage_rc(int b, int& R, int& C) { const int st = b / 1024, sb = b % 1024, swz = sb ^ (((sb >> 9) & 1) << 5); R = (st >> 1) * 16 + swz / 64; C = (st & 1) * 32 + (swz % 64) / 2; }
__host__ __device__ __forceinline__ int perm32(int rho) { const int n = rho >> 4, i = rho & 15; return 8 * (i >> 2) + 4 * n + (i & 3); }

struct Unit { int pm, pn, kind, nt; const char* A; const char* B; };

__device__ __forceinline__ void map_tile(int L, int nM, int nN, int& pm, int& pn) {
    const int nwg = nM * nN;
    int wgid = L; { const int q = nwg / NXCD, r = nwg % NXCD, xcd = wgid % NXCD, off = wgid / NXCD; wgid = (xcd < r ? xcd * (q + 1) : r * (q + 1) + (xcd - r) * q) + off; }
    const int nig = WGM * nN, gid = wgid / nig, fm = gid * WGM, gsz = (nM - fm) < WGM ? (nM - fm) : WGM;
    pm = fm + ((wgid % nig) % gsz); pn = (wgid % nig) / gsz;
}

template <class Epi, class Sched, bool ALIGN_EPI>
__device__ __forceinline__ void gemm_phase(LAS unsigned char* lds, const int lda, const int ldb, const Sched& S, const Epi& E) {
    const int tid = threadIdx.x, wid = __builtin_amdgcn_readfirstlane(tid >> 6), lane = tid & 63, wr = wid >> 2, wc = wid & 3, fr = lane & 15, fq = lane >> 4;
    unsigned voffA[2], voffB[2];
#pragma unroll
    for (int i = 0; i < 2; ++i) { int R, C; stage_rc(tid * 16 + i * 8192, R, C); const int Rb = Epi::PERM ? ((R & ~31) + perm32(R & 31)) : R;
        voffA[i] = (unsigned)(R * lda + C) * 2u; voffB[i] = (unsigned)(Rb * ldb + C) * 2u; }
    const size_t kstep = (size_t)(BK * 2);
    const size_t hstepA = (size_t)HALF * lda * 2, hstepB = (size_t)HALF * ldb * 2;
    const unsigned ldsw = (unsigned)wid * 1024u;
    const int aoff = lds_byte(wr * 64 + fr, fq * 8), boff = lds_byte(wc * 32 + fr, fq * 8);
#define PG8_SA(b, h) (((b) * 2 + (h)) * HTB)
#define PG8_SB(b, h) ((4 + (b) * 2 + (h)) * HTB)
#define PG8_STAGE(bufoff, gbase, voff) do { _Pragma("unroll") for (int _i = 0; _i < 2; ++_i) \
        __builtin_amdgcn_global_load_lds((const unsigned*)((const char*)(gbase) + (voff)[_i]), (LAS unsigned*)(lds + (bufoff) + ldsw + _i * 8192), 16, 0, 0); } while (0)
#define PG8_LDA(dst, b, h) do { _Pragma("unroll") for (int m = 0; m < 4; ++m) _Pragma("unroll") for (int k = 0; k < 2; ++k) dst[m][k] = *(const LAS bf16x8*)(lds + PG8_SA(b, h) + aoff + m * 2048 + k * 1024); } while (0)
#define PG8_LDB(dst, b, h) do { _Pragma("unroll") for (int n = 0; n < 2; ++n) _Pragma("unroll") for (int k = 0; k < 2; ++k) dst[n][k] = *(const LAS bf16x8*)(lds + PG8_SB(b, h) + boff + n * 2048 + k * 1024); } while (0)
#define PG8_MMA(ai, bj, At, Bt) do { __builtin_amdgcn_s_setprio(1); _Pragma("unroll") for (int m = 0; m < 4; ++m) _Pragma("unroll") for (int n = 0; n < 2; ++n) _Pragma("unroll") for (int k = 0; k < 2; ++k) \
        acc[ai][bj][m][n] = __builtin_amdgcn_mfma_f32_16x16x32_bf16(Bt[n][k], At[m][k], acc[ai][bj][m][n], 0, 0, 0); __builtin_amdgcn_s_setprio(0); } while (0)
#define PG8_WAIT_V(n) asm volatile("s_waitcnt vmcnt(" #n ")" ::: "memory")
#define PG8_WAIT_L(n) asm volatile("s_waitcnt lgkmcnt(" #n ")" ::: "memory")
#define PG8_BAR __builtin_amdgcn_s_barrier()
#define PG8_SCHED __builtin_amdgcn_sched_barrier(0)
    Unit cur, nxt; int ui = 0;
    if (!S.next(0, cur)) return;
    f32x4 acc[2][2][4][2];
#pragma unroll
    for (int a = 0; a < 2; ++a)
#pragma unroll
        for (int b = 0; b < 2; ++b)
#pragma unroll
            for (int m = 0; m < 4; ++m)
#pragma unroll
                for (int n = 0; n < 2; ++n) acc[a][b][m][n] = (f32x4){0.f, 0.f, 0.f, 0.f};
    bf16x8 At[4][2], B0[2][2], B1[2][2];
    const char* cA = cur.A; const char* cB = cur.B;
    PG8_STAGE(PG8_SB(0, 0), cB, voffB); PG8_STAGE(PG8_SB(0, 1), cB + hstepB, voffB); PG8_STAGE(PG8_SA(0, 0), cA, voffA); PG8_STAGE(PG8_SA(0, 1), cA + hstepA, voffA);
    if (wr == 1) PG8_BAR;
    PG8_WAIT_V(2); PG8_BAR;
    PG8_STAGE(PG8_SB(1, 0), cB + kstep, voffB); PG8_STAGE(PG8_SA(1, 0), cA + kstep, voffA); PG8_STAGE(PG8_SB(1, 1), cB + hstepB + kstep, voffB);
    PG8_WAIT_V(6); PG8_BAR;
    for (;;) {
        const bool has_next = S.next(ui + 1, nxt);
        const char* nA = has_next ? nxt.A : cA; const char* nB = has_next ? nxt.B : cB;
        const int nt = cur.nt;
        for (int t = 0; t < nt; t += 2) {
            const bool last = (t == nt - 2);
            const char* a1 = cA + (size_t)(t + 1) * kstep;
            const char* a2 = last ? nA : cA + (size_t)(t + 2) * kstep; const char* b2 = last ? nB : cB + (size_t)(t + 2) * kstep;
            const char* a3 = a2 + kstep; const char* b3 = b2 + kstep;
            PG8_LDB(B0, 0, 0); PG8_LDB(B1, 0, 1); PG8_SCHED; PG8_LDA(At, 0, 0); PG8_STAGE(PG8_SA(1, 1), a1 + hstepA, voffA);
            PG8_WAIT_V(8); PG8_WAIT_L(0); PG8_BAR; PG8_MMA(0, 0, At, B0); PG8_MMA(0, 1, At, B1); PG8_BAR; PG8_SCHED;
            PG8_LDA(At, 0, 1); PG8_STAGE(PG8_SB(0, 0), b2, voffB); PG8_STAGE(PG8_SB(0, 1), b2 + hstepB, voffB); PG8_STAGE(PG8_SA(0, 0), a2, voffA);
            PG8_WAIT_V(8); PG8_WAIT_L(0); PG8_BAR; PG8_MMA(1, 0, At, B0); PG8_MMA(1, 1, At, B1); PG8_BAR; PG8_SCHED;
            PG8_LDB(B0, 1, 0); PG8_LDB(B1, 1, 1); PG8_SCHED; PG8_LDA(At, 1, 0); PG8_STAGE(PG8_SA(0, 1), a2 + hstepA, voffA);
            PG8_WAIT_V(8); PG8_WAIT_L(0); PG8_BAR; PG8_MMA(0, 0, At, B0); PG8_MMA(0, 1, At, B1); PG8_BAR; PG8_SCHED;
            PG8_LDA(At, 1, 1); PG8_STAGE(PG8_SB(1, 0), b3, voffB); PG8_STAGE(PG8_SB(1, 1), b3 + hstepB, voffB); PG8_STAGE(PG8_SA(1, 0), a3, voffA);
            PG8_WAIT_V(8); PG8_WAIT_L(0); PG8_BAR; PG8_MMA(1, 0, At, B0); PG8_MMA(1, 1, At, B1); PG8_BAR; PG8_SCHED;
        }
        if constexpr (ALIGN_EPI) { if (wr == 0) PG8_BAR; }
        E(acc, cur, wr, wc, fr, fq);
        if (!has_next) break;
#pragma unroll
        for (int a = 0; a < 2; ++a)
#pragma unroll
            for (int b = 0; b < 2; ++b)
#pragma unroll
                for (int m = 0; m < 4; ++m)
#pragma unroll
                    for (int n = 0; n < 2; ++n) acc[a][b][m][n] = (f32x4){0.f, 0.f, 0.f, 0.f};
        cur = nxt; cA = nA; cB = nB; ++ui;
        if constexpr (ALIGN_EPI) { if (wr == 1) PG8_BAR; }
    }
    PG8_WAIT_V(0);
    if constexpr (!ALIGN_EPI) { if (wr == 0) PG8_BAR; }
    PG8_BAR;
#undef PG8_SA
#undef PG8_SB
#undef PG8_STAGE
#undef PG8_LDA
#undef PG8_LDB
#undef PG8_MMA
#undef PG8_WAIT_V
#undef PG8_WAIT_L
#undef PG8_BAR
#undef PG8_SCHED
}
}

struct SchedGrid {
    int nM, nN, nwg, G, c, nt; const char* Ab; const char* Bb; size_t tA, tB;
    __device__ __forceinline__ bool next(int i, pg8::Unit& u) const {
        const long L = (long)i * G + c; if (L >= nwg) return false;
        pg8::map_tile((int)L, nM, nN, u.pm, u.pn); u.kind = 0; u.nt = nt; u.A = Ab + (size_t)u.pm * tA; u.B = Bb + (size_t)u.pn * tB; return true;
    }
};
struct SchedInProj {
    int nM, nN, nwg, G, c; const char* Ab; const char* Bb; const char* Am; const char* Bm;
    __device__ __forceinline__ bool next(int i, pg8::Unit& u) const {
        const long L = (long)i * G + c; if (L >= nwg + 8) return false;
        u.nt = DM / 64;
        if (L < nwg) { pg8::map_tile((int)L, nM, nN, u.pm, u.pn); u.kind = 0; u.A = Ab + (size_t)u.pm * (256 * DM * 2); u.B = Bb + (size_t)u.pn * (256 * DM * 2); }
        else { const int e = (int)(L - nwg); u.pm = e >> 1; u.pn = e & 1; u.kind = 1; u.A = Am + (size_t)u.pm * (256 * DM * 2); u.B = Bm + (size_t)u.pn * (256 * DM * 2); }
        return true;
    }
};
struct SchedMerge {
    int G, c; const char* Ab; const char* Bb;
    __device__ __forceinline__ bool next(int i, pg8::Unit& u) const {
        const int round = i / 3, br = i - 3 * round; const long L = (long)round * G + c; if (L >= 512) return false;
        pg8::map_tile((int)L, 128, 4, u.pm, u.pn); u.kind = br; u.nt = br == 0 ? 8 : 4;
        const int koff = br == 0 ? 0 : (br == 1 ? 512 : 768);
        u.A = Ab + (size_t)u.pm * (256 * DM * 2) + koff * 2; u.B = Bb + (size_t)u.pn * (256 * DM * 2) + koff * 2; return true;
    }
};

__device__ __forceinline__ float sigmoidf_fast(float x) { return __builtin_amdgcn_rcpf(1.0f + __builtin_amdgcn_exp2f(-x * LOG2E)); }

struct EpiInProj {
    static constexpr bool PERM = true;
    const float* inv_rms; const float* inv_rms_mem; const float* cs; const float* b_gate;
    bf16_t *q_s, *k_s, *v_s, *q_d, *k_d, *v_d, *q_i, *k_i, *q_m, *gates, *mk, *mv; float* w_i;
    __device__ __forceinline__ void operator()(const f32x4 (&acc)[2][2][4][2], const pg8::Unit& u, int wr, int wc, int fr, int fq) const {
        if (u.kind == 1) {
            bf16_t* dst = u.pn == 0 ? mk : mv;
#pragma unroll
            for (int ai = 0; ai < 2; ++ai)
#pragma unroll
                for (int m = 0; m < 4; ++m) { const int row = u.pm * 256 + ai * 128 + wr * 64 + m * 16 + fr; const float s = inv_rms_mem[row];
#pragma unroll
                    for (int bj = 0; bj < 2; ++bj) { const f32x4 v0 = acc[ai][bj][m][0] * s, v1 = acc[ai][bj][m][1] * s;
                        u32x4 w; w.x = cvtpk(v0[0], v0[1]); w.y = cvtpk(v0[2], v0[3]); w.z = cvtpk(v1[0], v1[1]); w.w = cvtpk(v1[2], v1[3]);
                        *(u32x4*)(dst + (size_t)row * 256 + bj * 128 + wc * 32 + 8 * fq) = w; } }
            return;
        }
#pragma unroll
        for (int bj = 0; bj < 2; ++bj) {
            const int pos0 = u.pn * 256 + bj * 128 + wc * 32;
            const int p = pos0 + 8 * fq;
            int kind; bf16_t* dst; int ld, sec0; float scl = 1.f;
            if (pos0 < P_KS)        { kind = 0; dst = q_s; ld = 512; sec0 = P_QS; scl = QSCALE; }
            else if (pos0 < P_VS)   { kind = 0; dst = k_s; ld = 128; sec0 = P_KS; }
            else if (pos0 < P_QD)   { kind = 1; dst = v_s; ld = 128; sec0 = P_VS; }
            else if (pos0 < P_KD)   { kind = 0; dst = q_d; ld = 256; sec0 = P_QD; scl = QSCALE; }
            else if (pos0 < P_VD)   { kind = 0; dst = k_d; ld = 64;  sec0 = P_KD; }
            else if (pos0 < P_QI)   { kind = 1; dst = v_d; ld = 64;  sec0 = P_VD; }
            else if (pos0 < P_KI)   { kind = 0; dst = q_i; ld = 256; sec0 = P_QI; }
            else if (pos0 < P_QM)   { kind = 0; dst = k_i; ld = 64;  sec0 = P_KI; }
            else if (pos0 < P_GATE) { kind = 1; dst = q_m; ld = 256; sec0 = P_QM; scl = QSCALE; }
            else if (pos0 < P_WI)   { kind = 2; dst = gates; ld = 3072; sec0 = P_GATE; }
            else                    { kind = 3; dst = nullptr; ld = 0; sec0 = P_WI; }
            const int lp = p - sec0;
            if (kind == 0) {
                const int head = lp >> 6, i0 = (lp & 63) >> 1;
#pragma unroll
                for (int ai = 0; ai < 2; ++ai)
#pragma unroll
                    for (int m = 0; m < 4; ++m) { const int row = u.pm * 256 + ai * 128 + wr * 64 + m * 16 + fr; const float s = inv_rms[row] * scl;
                        const f32x4 v0 = acc[ai][bj][m][0] * s, v1 = acc[ai][bj][m][1] * s;
                        const f32x4 ca = *(const f32x4*)(cs + (size_t)row * 64 + 2 * i0), cb = *(const f32x4*)(cs + (size_t)row * 64 + 2 * i0 + 4);
                        const float a0 = v0[0] * ca[0] - v0[1] * ca[1], b0 = v0[1] * ca[0] + v0[0] * ca[1];
                        const float a1 = v0[2] * ca[2] - v0[3] * ca[3], b1 = v0[3] * ca[2] + v0[2] * ca[3];
                        const float a2 = v1[0] * cb[0] - v1[1] * cb[1], b2 = v1[1] * cb[0] + v1[0] * cb[1];
                        const float a3 = v1[2] * cb[2] - v1[3] * cb[3], b3 = v1[3] * cb[2] + v1[2] * cb[3];
                        bf16_t* o = dst + (size_t)row * ld + head * 64 + i0;
                        u32x2 wa, wb; wa.x = cvtpk(a0, a1); wa.y = cvtpk(a2, a3); wb.x = cvtpk(b0, b1); wb.y = cvtpk(b2, b3);
                        *(u32x2*)o = wa; *(u32x2*)(o + 32) = wb; }
            } else if (kind == 1) {
#pragma unroll
                for (int ai = 0; ai < 2; ++ai)
#pragma unroll
                    for (int m = 0; m < 4; ++m) { const int row = u.pm * 256 + ai * 128 + wr * 64 + m * 16 + fr; const float s = inv_rms[row] * scl;
                        const f32x4 v0 = acc[ai][bj][m][0] * s, v1 = acc[ai][bj][m][1] * s;
                        u32x4 w; w.x = cvtpk(v0[0], v0[1]); w.y = cvtpk(v0[2], v0[3]); w.z = cvtpk(v1[0], v1[1]); w.w = cvtpk(v1[2], v1[3]);
                        *(u32x4*)(dst + (size_t)row * ld + lp) = w; }
            } else if (kind == 2) {
                const f32x4 g0 = *(const f32x4*)(b_gate + lp), g1 = *(const f32x4*)(b_gate + lp + 4);
#pragma unroll
                for (int ai = 0; ai < 2; ++ai)
#pragma unroll
                    for (int m = 0; m < 4; ++m) { const int row = u.pm * 256 + ai * 128 + wr * 64 + m * 16 + fr; const float s = inv_rms[row];
                        const f32x4 v0 = acc[ai][bj][m][0] * s + g0, v1 = acc[ai][bj][m][1] * s + g1;
                        u32x4 w; w.x = cvtpk(sigmoidf_fast(v0[0]), sigmoidf_fast(v0[1])); w.y = cvtpk(sigmoidf_fast(v0[2]), sigmoidf_fast(v0[3]));
                        w.z = cvtpk(sigmoidf_fast(v1[0]), sigmoidf_fast(v1[1])); w.w = cvtpk(sigmoidf_fast(v1[2]), sigmoidf_fast(v1[3]));
                        *(u32x4*)(dst + (size_t)row * ld + lp) = w; }
            } else {
                if (pos0 == P_WI && fq == 0) {
#pragma unroll
                    for (int ai = 0; ai < 2; ++ai)
#pragma unroll
                        for (int m = 0; m < 4; ++m) { const int row = u.pm * 256 + ai * 128 + wr * 64 + m * 16 + fr; const float s = inv_rms[row] * IDX_SCALE;
                            *(f32x4*)(w_i + (size_t)row * 4) = acc[ai][bj][m][0] * s; }
                }
            }
        }
    }
};

struct EpiMerge {
    static constexpr bool PERM = true;
    const bf16_t* gates; bf16_t* merged;
    __device__ __forceinline__ void operator()(const f32x4 (&acc)[2][2][4][2], const pg8::Unit& u, int wr, int wc, int fr, int fq) const {
        const int br = u.kind;
#pragma unroll
        for (int ai = 0; ai < 2; ++ai)
#pragma unroll
            for (int m = 0; m < 4; ++m) { const int row = u.pm * 256 + ai * 128 + wr * 64 + m * 16 + fr;
#pragma unroll
                for (int bj = 0; bj < 2; ++bj) { const int col = u.pn * 256 + bj * 128 + wc * 32 + 8 * fq;
                    const u32x4 g = *(const u32x4*)(gates + (size_t)row * 3072 + br * 1024 + col);
                    f32x4 v0 = acc[ai][bj][m][0], v1 = acc[ai][bj][m][1];
                    v0[0] *= bf_lo(g.x); v0[1] *= bf_hi(g.x); v0[2] *= bf_lo(g.y); v0[3] *= bf_hi(g.y); v1[0] *= bf_lo(g.z); v1[1] *= bf_hi(g.z); v1[2] *= bf_lo(g.w); v1[3] *= bf_hi(g.w);
                    bf16_t* o = merged + (size_t)row * 1024 + col;
                    if (br > 0) { const u32x4 pv = *(const u32x4*)o;
                        v0[0] += bf_lo(pv.x); v0[1] += bf_hi(pv.x); v0[2] += bf_lo(pv.y); v0[3] += bf_hi(pv.y); v1[0] += bf_lo(pv.z); v1[1] += bf_hi(pv.z); v1[2] += bf_lo(pv.w); v1[3] += bf_hi(pv.w); }
                    u32x4 w; w.x = cvtpk(v0[0], v0[1]); w.y = cvtpk(v0[2], v0[3]); w.z = cvtpk(v1[0], v1[1]); w.w = cvtpk(v1[2], v1[3]);
                    *(u32x4*)o = w; } }
    }
};

template <bool WRITE_BF> struct EpiResid {
    static constexpr bool PERM = false;
    const float* base; float* out; bf16_t* outb; float* ssq;
    __device__ __forceinline__ void operator()(const f32x4 (&acc)[2][2][4][2], const pg8::Unit& u, int wr, int wc, int fr, int fq) const {
#pragma unroll
        for (int ai = 0; ai < 2; ++ai)
#pragma unroll
            for (int m = 0; m < 4; ++m) { const int row = u.pm * 256 + ai * 128 + wr * 64 + m * 16 + fr; float q = 0.f;
#pragma unroll
                for (int bj = 0; bj < 2; ++bj)
#pragma unroll
                    for (int n = 0; n < 2; ++n) { const size_t off = (size_t)row * DM + u.pn * 256 + bj * 128 + wc * 32 + n * 16 + 4 * fq;
                        const f32x4 o = *(const f32x4*)(base + off) + acc[ai][bj][m][n];
                        *(f32x4*)(out + off) = o; q += (o[0] * o[0] + o[1] * o[1]) + (o[2] * o[2] + o[3] * o[3]);
                        if (WRITE_BF) { u32x2 w; w.x = cvtpk(o[0], o[1]); w.y = cvtpk(o[2], o[3]); *(u32x2*)(outb + off) = w; } }
                q += __shfl_xor(q, 16); q += __shfl_xor(q, 32);
                if (fq == 0) ssq[(size_t)row * 16 + u.pn * 4 + wc] = q; }
    }
};

struct EpiMlpIn {
    static constexpr bool PERM = true;
    const float* ssq; bf16_t* hid;
    __device__ __forceinline__ void operator()(const f32x4 (&acc)[2][2][4][2], const pg8::Unit& u, int wr, int wc, int fr, int fq) const {
#pragma unroll
        for (int ai = 0; ai < 2; ++ai)
#pragma unroll
            for (int m = 0; m < 4; ++m) { const int row = u.pm * 256 + ai * 128 + wr * 64 + m * 16 + fr;
                const f32x4* sp = (const f32x4*)(ssq + (size_t)row * 16); const f32x4 s0 = sp[0], s1 = sp[1], s2 = sp[2], s3 = sp[3];
                const float tot = ((s0[0] + s0[1]) + (s0[2] + s0[3])) + ((s1[0] + s1[1]) + (s1[2] + s1[3])) + ((s2[0] + s2[1]) + (s2[2] + s2[3])) + ((s3[0] + s3[1]) + (s3[2] + s3[3]));
                const float s = 1.0f / sqrtf(tot * (1.0f / DM) + EPS);
#pragma unroll
                for (int bj = 0; bj < 2; ++bj) { f32x4 v0 = acc[ai][bj][m][0] * s, v1 = acc[ai][bj][m][1] * s;
#pragma unroll
                    for (int e = 0; e < 4; ++e) { const float a = fmaxf(v0[e], 0.f), b = fmaxf(v1[e], 0.f); v0[e] = a * a; v1[e] = b * b; }
                    u32x4 w; w.x = cvtpk(v0[0], v0[1]); w.y = cvtpk(v0[2], v0[3]); w.z = cvtpk(v1[0], v1[1]); w.w = cvtpk(v1[2], v1[3]);
                    *(u32x4*)(hid + (size_t)row * DFF + u.pn * 256 + bj * 128 + wc * 32 + 8 * fq) = w; } }
    }
};

#define XB_TMO      128
#define XB_XCNT(j)  (256  + 64 * (j))
#define XB_XSUB(j)  (1280 + 64 * (j))
#define XB_XGEN(j)  (2304 + 64 * (j))
#define XB_TOP      3328
#define XB_TOPGEN   3392
#define XCD_BAR_WORDS 3456
#define XB_SPIN_CAP (1u << 20)
__device__ __forceinline__ unsigned xb_ld(unsigned* p)              { return __hip_atomic_load(p, __ATOMIC_RELAXED, __HIP_MEMORY_SCOPE_AGENT); }
__device__ __forceinline__ unsigned xb_add(unsigned* p, unsigned v) { return __hip_atomic_fetch_add(p, v, __ATOMIC_RELAXED, __HIP_MEMORY_SCOPE_AGENT); }
__device__ __forceinline__ unsigned xb_xcc_id() { return (unsigned)__builtin_amdgcn_s_getreg((3 << 11) | 20) & 0xFu; }
#define XB_SPIN(cond, bar) do { unsigned _sp = 0; while (cond) { __builtin_amdgcn_s_sleep(1); \
    if ((++_sp & 255u) == 0u) { if (xb_ld(&(bar)[XB_TMO])) break; if (_sp > XB_SPIN_CAP) { atomicAdd(&(bar)[XB_TMO], 1u); break; } } } } while (0)
struct XcdBarrier { unsigned* bar; unsigned x; volatile LAS unsigned* st; };
__device__ __forceinline__ XcdBarrier xcd_barrier_post(unsigned* bar, volatile LAS unsigned* st) {
    XcdBarrier b; b.bar = bar; b.x = xb_xcc_id(); b.st = st;
    if (threadIdx.x == 0) (void)xb_add(&bar[XB_XCNT(b.x)], 1u);
    return b;
}
__device__ __forceinline__ void xcd_barrier_complete(unsigned* bar, unsigned x, unsigned& nloc, unsigned& nx) {
    const unsigned G = gridDim.x * gridDim.y * gridDim.z;
    unsigned sum, cnt, mine, sp = 0u;
    for (;;) {
        sum = 0u; cnt = 0u; mine = 0u;
#pragma unroll
        for (unsigned j = 0; j < 16; ++j) { const unsigned c = xb_ld(&bar[XB_XCNT(j)]); sum += c; cnt += (c > 0u) ? 1u : 0u; mine = (j == x) ? c : mine; }
        if (sum == G) break;
        __builtin_amdgcn_s_sleep(1);
        if ((++sp & 255u) == 0u) { if (xb_ld(&bar[XB_TMO])) break; if (sp > XB_SPIN_CAP) { atomicAdd(&bar[XB_TMO], 1u); break; } }
    }
    nloc = mine > 0u ? mine : 1u; nx = cnt > 0u ? cnt : 1u;
}
__device__ __forceinline__ void xcd_barrier(const XcdBarrier& b) {
    asm volatile("s_waitcnt vmcnt(0)" ::: "memory");
    __syncthreads();
    if (threadIdx.x == 0) {
        unsigned* bar = b.bar;
        __builtin_amdgcn_s_waitcnt(0);
        unsigned nloc = b.st[0], nx = b.st[1];
        if (nloc == 0u) { xcd_barrier_complete(bar, b.x, nloc, nx); b.st[0] = nloc; b.st[1] = nx; }
        const unsigned old = xb_add(&bar[XB_XSUB(b.x)], 1u);
        const unsigned gen = old / nloc;
        if (old + 1u == (gen + 1u) * nloc) {
            __builtin_amdgcn_fence(__ATOMIC_RELEASE, "agent");
            asm volatile("s_waitcnt vmcnt(0)" ::: "memory");
            const unsigned og = xb_add(&bar[XB_TOP], 1u);
            const unsigned tg = og / nx;
            if (og + 1u == (tg + 1u) * nx) xb_add(&bar[XB_TOPGEN], 1u);
            else XB_SPIN(xb_ld(&bar[XB_TOPGEN]) == tg, bar);
            __builtin_amdgcn_fence(__ATOMIC_ACQUIRE, "agent");
            xb_add(&bar[XB_XGEN(b.x)], 1u);
            asm volatile("s_waitcnt vmcnt(0)" ::: "memory");
        } else {
            XB_SPIN(xb_ld(&bar[XB_XGEN(b.x)]) == gen, bar);
            __builtin_amdgcn_fence(__ATOMIC_ACQUIRE, "agent");
            asm volatile("s_waitcnt vmcnt(0)" ::: "memory");
        }
    }
    __syncthreads();
}

struct Frame {
    LAS unsigned char* lds;
    volatile LAS unsigned* MISC;
    unsigned* ctl;
    int tid, lane, wave, vcu, G;
    unsigned char* ws;
    const float *x, *mem; const int* positions; const float *g_mix, *w_in, *b_gate, *sinks, *g_mem, *w_mem_kv, *w_proj_swa, *w_proj_dsa, *w_proj_mem, *w_out, *g_mlp, *w_mlp_in, *w_mlp_out, *g_final;
    float* out;
};
#define WSP(T_, off) ((T_*)(F.ws + (off)))

__device__ __forceinline__ int rope_src(int base, int lp) { return base + (lp & ~63) + ((lp & 1) ? 32 + ((lp & 63) >> 1) : ((lp & 63) >> 1)); }
__device__ __forceinline__ int win_src(int pos) {
    if (pos < P_KS) return rope_src(0, pos);
    if (pos < P_VS) return rope_src(512, pos - P_KS);
    if (pos < P_QD) return pos;
    if (pos < P_KD) return rope_src(768, pos - P_QD);
    if (pos < P_VD) return rope_src(1024, pos - P_KD);
    if (pos < P_QI) return pos;
    if (pos < P_KI) return rope_src(1152, pos - P_QI);
    if (pos < P_QM) return rope_src(1408, pos - P_KI);
    if (pos < P_GATE) return 1476 + (pos - P_QM);
    if (pos < P_WI) return 1732 + (pos - P_GATE);
    if (pos < P_END) return 1472 + (pos - P_WI);
    return -1;
}
template <bool MAP> __device__ __forceinline__ void p0_transpose_item(const float* W, int ldw, int k0, int n0, const float* gk, bf16_t* WT, int ldwt, LAS float* scr, int lane) {
    const int j = lane & 31; const int sc = MAP ? win_src(n0 + j) : n0 + j;
#pragma unroll 8
    for (int i = 0; i < 32; ++i) { const int kk = 2 * i + (lane >> 5); float v = sc >= 0 ? W[(size_t)(k0 + kk) * ldw + sc] : 0.f; if (gk) v *= gk[k0 + kk]; scr[kk * 33 + j] = v; }
    LDS_WAIT(); asm volatile("" ::: "memory");
    const int c = lane & 7;
#pragma unroll
    for (int jj = 0; jj < 4; ++jj) { const int n = (lane >> 3) + 8 * jj; const LAS float* s = scr + (8 * c) * 33 + n;
        u32x4 o; o.x = cvtpk(s[0 * 33], s[1 * 33]); o.y = cvtpk(s[2 * 33], s[3 * 33]); o.z = cvtpk(s[4 * 33], s[5 * 33]); o.w = cvtpk(s[6 * 33], s[7 * 33]);
        *(u32x4*)(WT + (size_t)(n0 + n) * ldwt + k0 + 8 * c) = o; }
    LDS_WAIT(); asm volatile("" ::: "memory");
}
__device__ __forceinline__ void row_to_bf16(const float* xrow, bf16_t* orow, float* inv, int lane) {
    const f32x4* xr = (const f32x4*)xrow + lane;
    f32x4 v[4]; float s = 0.f;
#pragma unroll
    for (int j = 0; j < 4; ++j) { v[j] = xr[64 * j]; s += (v[j][0] * v[j][0] + v[j][1] * v[j][1]) + (v[j][2] * v[j][2] + v[j][3] * v[j][3]); }
    s = wave_sum(s);
    if (lane == 0) *inv = 1.0f / sqrtf(s * (1.0f / DM) + EPS);
    u32x2* o8 = (u32x2*)orow + lane;
#pragma unroll
    for (int j = 0; j < 4; ++j) { u32x2 w; w.x = cvtpk(v[j][0], v[j][1]); w.y = cvtpk(v[j][2], v[j][3]); o8[64 * j] = w; }
}
__device__ __forceinline__ void p0_prologue(Frame& F) {
    LAS float* scr = (LAS float*)(F.lds + RING_OFF + F.wave * 16384);
    const int gw = F.vcu * NWAVES + F.wave, NGW = F.G * NWAVES;
    constexpr int I_IN = 16 * (NPOS / 32), I_MEM = 16 * 16, I_PS = 8 * 32, I_PD = 4 * 32, I_PM = 4 * 32, I_OUT = 16 * 32, I_1 = 16 * 128, I_2 = 64 * 32;
    constexpr int NITEMS = I_IN + I_MEM + I_PS + I_PD + I_PM + I_OUT + I_1 + I_2;
    for (int it = gw; it < NITEMS; it += NGW) {
        int r = it;
        if (r < I_IN) { const int nb = NPOS / 32; p0_transpose_item<true>(F.w_in, DIN, 64 * (r / nb), 32 * (r % nb), F.g_mix, WSP(bf16_t, WS_WIN), DM, scr, F.lane); continue; } r -= I_IN;
        if (r < I_MEM) { p0_transpose_item<false>(F.w_mem_kv, 512, 64 * (r / 16), 32 * (r % 16), F.g_mem, WSP(bf16_t, WS_WMEM), DM, scr, F.lane); continue; } r -= I_MEM;
        if (r < I_PS) { p0_transpose_item<false>(F.w_proj_swa, DM, 64 * (r / 32), 32 * (r % 32), nullptr, WSP(bf16_t, WS_WPROJ), DM, scr, F.lane); continue; } r -= I_PS;
        if (r < I_PD) { p0_transpose_item<false>(F.w_proj_dsa, DM, 64 * (r / 32), 32 * (r % 32), nullptr, WSP(bf16_t, WS_WPROJ) + 512, DM, scr, F.lane); continue; } r -= I_PD;
        if (r < I_PM) { p0_transpose_item<false>(F.w_proj_mem, DM, 64 * (r / 32), 32 * (r % 32), nullptr, WSP(bf16_t, WS_WPROJ) + 768, DM, scr, F.lane); continue; } r -= I_PM;
        if (r < I_OUT) { p0_transpose_item<false>(F.w_out, DM, 64 * (r / 32), 32 * (r % 32), nullptr, WSP(bf16_t, WS_WOUT), DM, scr, F.lane); continue; } r -= I_OUT;
        if (r < I_1) { p0_transpose_item<false>(F.w_mlp_in, DFF, 64 * (r / 128), 32 * (r % 128), F.g_mlp, WSP(bf16_t, WS_W1), DM, scr, F.lane); continue; } r -= I_1;
        p0_transpose_item<false>(F.w_mlp_out, DM, 64 * (r / 32), 32 * (r % 32), nullptr, WSP(bf16_t, WS_W2), DFF, scr, F.lane);
    }
    for (int m = gw; m < T; m += NGW) row_to_bf16(F.x + (size_t)m * DM, WSP(bf16_t, WS_XB) + (size_t)m * DM, WSP(float, WS_INVRMS0) + m, F.lane);
    for (int m = gw; m < MROWS; m += NGW) row_to_bf16(F.mem + (size_t)m * DM, WSP(bf16_t, WS_MEMB) + (size_t)m * DM, WSP(float, WS_INVRMSM) + m, F.lane);
    { const int gt = gw * 64 + F.lane, NGT = NGW * 64; const int i = gt & 31;
      const float invf = (float)exp2((double)(-i) * (13.287712379549449 / 32.0));
      float* cs = WSP(float, WS_CS);
      for (int idx = gt; idx < T * 32; idx += NGT) { const float ang = (float)F.positions[idx >> 5] * invf; float s, c; sincosf(ang, &s, &c); *(f32x2*)(cs + (size_t)idx * 2) = (f32x2){c, s}; } }
}

__device__ __forceinline__ void p7_final_norm(Frame& F) {
    const int gw = F.vcu * NWAVES + F.wave, NGW = F.G * NWAVES;
    const float* ssq = WSP(float, WS_SSQ2);
    f32x4 g[4];
#pragma unroll
    for (int j = 0; j < 4; ++j) g[j] = ((const f32x4*)F.g_final)[F.lane + 64 * j];
    for (int m = gw; m < T; m += NGW) {
        float p = F.lane < 16 ? ssq[(size_t)m * 16 + F.lane] : 0.f;
        p = wave_sum(p);
        const float s = 1.0f / sqrtf(p * (1.0f / DM) + EPS);
        f32x4* o = (f32x4*)(F.out + (size_t)m * DM) + F.lane;
#pragma unroll
        for (int j = 0; j < 4; ++j) { const f32x4 v = o[64 * j]; o[64 * j] = v * s * g[j]; }
    }
}

__device__ __forceinline__ int crow(int r, int hi) { return (r & 3) + 8 * (r >> 2) + 4 * hi; }
__device__ __forceinline__ float xor32f(float v) { return __shfl_xor(v, 32); }

template <int MODE> __device__ __forceinline__ void attn32(const bf16_t* Qp, int ldq, const bf16_t* Kp, int ldk, const bf16_t* Vp, int ldv, int jlo, int jhi, int qpos0, float sink_l2, bf16_t* Op, int ldo, int lane) {
    const int r32 = lane & 31, hi = lane >> 5;
    bf16x8 qf[4];
#pragma unroll
    for (int s = 0; s < 4; ++s) qf[s] = *(const bf16x8*)(Qp + (size_t)r32 * ldq + 16 * s + 8 * hi);
    float m = MODE == 1 ? sink_l2 : -INFINITY, l = MODE == 1 ? 1.0f : 0.0f;
    f32x16 o0 = {}, o1 = {};
    const int qp = qpos0 + r32;
    for (int j = jlo; j < jhi; ++j) {
        const bf16_t* kr = Kp + (size_t)(32 * j + r32) * ldk + 8 * hi;
        f32x16 sc = {};
#pragma unroll
        for (int s = 0; s < 4; ++s) { const bf16x8 kf = *(const bf16x8*)(kr + 16 * s); sc = __builtin_amdgcn_mfma_f32_32x32x16_bf16(kf, qf[s], sc, 0, 0, 0); }
        if (MODE == 1) {
#pragma unroll
            for (int i = 0; i < 16; ++i) { const int kp = 32 * j + crow(i, hi); if (kp > qp || qp - kp >= 128) sc[i] = -INFINITY; }
        }
        float tm = sc[0];
#pragma unroll
        for (int i = 1; i < 16; ++i) tm = fmaxf(tm, sc[i]);
        tm = fmaxf(tm, xor32f(tm));
        const float mn = fmaxf(m, tm);
        const float alpha = (mn == -INFINITY) ? 1.0f : __builtin_amdgcn_exp2f(m - mn);
        const float msub = (mn == -INFINITY) ? 0.0f : mn;
        float rs = 0.f;
#pragma unroll
        for (int i = 0; i < 16; ++i) { sc[i] = __builtin_amdgcn_exp2f(sc[i] - msub); rs += sc[i]; }
        rs += xor32f(rs);
        l = l * alpha + rs; m = mn;
#pragma unroll
        for (int i = 0; i < 16; ++i) { o0[i] *= alpha; o1[i] *= alpha; }
        u32x4 pw[2];
#pragma unroll
        for (int s = 0; s < 2; ++s) { pw[s].x = cvtpk(sc[8 * s + 0], sc[8 * s + 1]); pw[s].y = cvtpk(sc[8 * s + 2], sc[8 * s + 3]); pw[s].z = cvtpk(sc[8 * s + 4], sc[8 * s + 5]); pw[s].w = cvtpk(sc[8 * s + 6], sc[8 * s + 7]); }
#pragma unroll
        for (int s = 0; s < 2; ++s) {
            bf16x8 a0, a1;
#pragma unroll
            for (int jj = 0; jj < 8; ++jj) { const bf16_t* vr = Vp + (size_t)(32 * j + 16 * s + 8 * (jj >> 2) + 4 * hi + (jj & 3)) * ldv + r32; a0[jj] = (short)vr[0]; a1[jj] = (short)vr[32]; }
            const bf16x8 pb = __builtin_bit_cast(bf16x8, pw[s]);
            o0 = __builtin_amdgcn_mfma_f32_32x32x16_bf16(a0, pb, o0, 0, 0, 0);
            o1 = __builtin_amdgcn_mfma_f32_32x32x16_bf16(a1, pb, o1, 0, 0, 0);
        }
    }
    const float rl = 1.0f / l;
    bf16_t* orow = Op + (size_t)r32 * ldo;
#pragma unroll
    for (int g = 0; g < 4; ++g) {
        u32x2 w0, w1; w0.x = cvtpk(o0[4 * g] * rl, o0[4 * g + 1] * rl); w0.y = cvtpk(o0[4 * g + 2] * rl, o0[4 * g + 3] * rl);
        w1.x = cvtpk(o1[4 * g] * rl, o1[4 * g + 1] * rl); w1.y = cvtpk(o1[4 * g + 2] * rl, o1[4 * g + 3] * rl);
        *(u32x2*)(orow + 8 * g + 4 * hi) = w0; *(u32x2*)(orow + 32 + 8 * g + 4 * hi) = w1;
    }
}

__device__ __forceinline__ void swa_item(Frame& F, int b, int qb) {
    const int h = F.wave, kvh = h >> 2;
    const float sink = F.sinks[h] * LOG2E;
    const bf16_t* Kp = WSP(const bf16_t, WS_KS) + (size_t)b * SEQ * 128 + kvh * 64;
    const bf16_t* Vp = WSP(const bf16_t, WS_VS) + (size_t)b * SEQ * 128 + kvh * 64;
    for (int sub = 0; sub < 4; ++sub) {
        const int q0 = qb * 128 + 32 * sub; const int jhi = q0 / 32 + 1; int jlo = jhi - 5; if (jlo < 0) jlo = 0;
        attn32<1>(WSP(const bf16_t, WS_QS) + ((size_t)b * SEQ + q0) * 512 + h * 64, 512, Kp, 128, Vp, 128, jlo, jhi, q0, sink, WSP(bf16_t, WS_OCAT) + ((size_t)b * SEQ + q0) * DM + h * 64, DM, F.lane);
    }
}
__device__ __forceinline__ void mem_item(Frame& F, int b, int qb) {
    const int h = F.wave & 3, half = F.wave >> 2;
    const bf16_t* Kp = WSP(const bf16_t, WS_MK) + (size_t)b * MEMLEN * 256 + h * 64;
    const bf16_t* Vp = WSP(const bf16_t, WS_MV) + (size_t)b * MEMLEN * 256 + h * 64;
    for (int sub = 0; sub < 2; ++sub) {
        const int q0 = qb * 128 + 64 * half + 32 * sub;
        attn32<0>(WSP(const bf16_t, WS_QM) + ((size_t)b * SEQ + q0) * 256 + h * 64, 256, Kp, 256, Vp, 256, 0, MEMLEN / 32, 0, 0.f, WSP(bf16_t, WS_OCAT) + ((size_t)b * SEQ + q0) * DM + 768 + h * 64, DM, F.lane);
    }
}


constexpr int DSA_CAP = 512;
constexpr int DL_MAX = 0;
constexpr int DL_CKEY = 0;
constexpr int DL_CIDX = 65536;
constexpr int DL_VS = 0;
constexpr int DL_CNT = 98304;
constexpr int DL_HIST = 99328;
constexpr int DL_SEL = 107520;
typedef short v4i16_t __attribute__((ext_vector_type(4)));
__device__ __forceinline__ unsigned fkey(float f) { const unsigned u = __float_as_uint(f); return (u & 0x80000000u) ? ~u : (u | 0x80000000u); }
__device__ __forceinline__ float fkey_inv(unsigned k) { return __uint_as_float((k & 0x80000000u) ? (k & 0x7fffffffu) : ~k); }
__device__ __forceinline__ void glds16(const void* gsrc, unsigned lds_dst) { unsigned keep;
    asm volatile("s_mov_b32 %0, m0\n\ts_mov_b32 m0, %2\n\ts_nop 0\n\tglobal_load_lds_dwordx4 %1, off\n\ts_mov_b32 m0, %0" : "=&s"(keep) : "v"(gsrc), "s"(lds_dst) : "memory"); }

template <int NV, int ROUNDS> __device__ __forceinline__ unsigned radix_kth(const unsigned (&v)[NV], int count, LAS unsigned* hist, int k, int lane, int& k_out, int& ceq_out) {
    unsigned prefix = 0u; int ceq = 0;
#pragma unroll
    for (int r = ROUNDS - 1; r >= 0; --r) {
        const int shift = 8 * r;
        *(LAS u32x4*)(hist + 4 * lane) = (u32x4){0u, 0u, 0u, 0u};
        LDS_WAIT();
#pragma unroll
        for (int i = 0; i < NV; ++i) { const bool ok = (lane + 64 * i < count) && (r == ROUNDS - 1 || (v[i] >> (shift + 8)) == (prefix >> (shift + 8)));
            if (ok) __hip_atomic_fetch_add(hist + ((v[i] >> shift) & 255u), 1u, __ATOMIC_RELAXED, __HIP_MEMORY_SCOPE_WORKGROUP); }
        LDS_WAIT();
        const u32x4 h = *(const LAS u32x4*)(hist + 4 * lane);
        const unsigned s = (h.x + h.y) + (h.z + h.w);
        unsigned Tl = s;
#pragma unroll
        for (int o = 1; o < 64; o <<= 1) { const unsigned t = __shfl_down(Tl, o); if (lane + o < 64) Tl += t; }
        const unsigned long long bal = __ballot(Tl >= (unsigned)k);
        const int ls = bal ? 63 - __clzll(bal) : 0;
        const unsigned above = Tl - s, c3 = above + h.w, c2 = c3 + h.z, c1 = c2 + h.y;
        unsigned bin, kk, cb;
        if (c3 >= (unsigned)k) { bin = 3; kk = k - above; cb = h.w; } else if (c2 >= (unsigned)k) { bin = 2; kk = k - c3; cb = h.z; } else if (c1 >= (unsigned)k) { bin = 1; kk = k - c2; cb = h.y; } else { bin = 0; kk = k - c1; cb = h.x; }
        const unsigned digit = (unsigned)__builtin_amdgcn_readlane((int)(bin + 4u * lane), ls);
        k = __builtin_amdgcn_readlane((int)kk, ls); ceq = __builtin_amdgcn_readlane((int)cb, ls);
        prefix |= digit << shift;
    }
    k_out = k; ceq_out = ceq; return prefix;
}

__device__ __forceinline__ void dsa_item(Frame& F, int b, int t0) {
    const int lane = F.lane, wid = F.wave, r32 = lane & 31, hi = lane >> 5;
    LAS unsigned short* maxbuf = (LAS unsigned short*)(F.lds + DL_MAX);
    LAS unsigned* ckey = (LAS unsigned*)(F.lds + DL_CKEY);
    LAS unsigned short* cidx = (LAS unsigned short*)(F.lds + DL_CIDX);
    LAS unsigned* ccnt = (LAS unsigned*)(F.lds + DL_CNT);
    LAS unsigned* ctau = ccnt + 32;
    LAS unsigned* hist = (LAS unsigned*)(F.lds + DL_HIST) + wid * 256;
    LAS unsigned short* sel = (LAS unsigned short*)(F.lds + DL_SEL);
    const size_t rowb = (size_t)b * SEQ;
    __syncthreads();
    if (t0 >= TOPK) {
        const int nkt = t0 / 32 + 1, nmax = t0 + 32;
        int lg = 0; while ((1024 << lg) < nmax) ++lg;
        const int npl = 16 >> lg;
        bf16x8 qf[4][4]; float wq[4];
        { const bf16_t* qrow = WSP(const bf16_t, WS_QI) + (rowb + t0 + r32) * 256 + 8 * hi;
#pragma unroll
          for (int h = 0; h < 4; ++h)
#pragma unroll
              for (int s = 0; s < 4; ++s) qf[h][s] = *(const bf16x8*)(qrow + h * 64 + 16 * s);
          const f32x4 w4 = *(const f32x4*)(WSP(const float, WS_WI) + (rowb + t0 + r32) * 4); wq[0] = w4[0]; wq[1] = w4[1]; wq[2] = w4[2]; wq[3] = w4[3]; }
        if (F.tid < 32) ccnt[F.tid] = 0u;
        const bf16_t* kbase = WSP(const bf16_t, WS_KI) + (rowb + r32) * 64 + 8 * hi;
        float thrf = 0.f;
        for (int pass = 0; pass < 2; ++pass) {
            if (pass == 1) thrf = fkey_inv(ctau[r32] << 16);
            bf16x8 kn[4];
            if (wid < nkt) {
#pragma unroll
                for (int s = 0; s < 4; ++s) kn[s] = *(const bf16x8*)(kbase + (size_t)(32 * wid) * 64 + 16 * s);
            }
            for (int j = wid; j < nkt; j += NWAVES) {
                bf16x8 kf[4];
#pragma unroll
                for (int s = 0; s < 4; ++s) kf[s] = kn[s];
                if (j + NWAVES < nkt) {
#pragma unroll
                    for (int s = 0; s < 4; ++s) kn[s] = *(const bf16x8*)(kbase + (size_t)(32 * (j + NWAVES)) * 64 + 16 * s);
                }
                float sc[16];
#pragma unroll
                for (int i = 0; i < 16; ++i) sc[i] = 0.f;
#pragma unroll
                for (int h = 0; h < 4; ++h) { f32x16 d = {};
#pragma unroll
                    for (int s = 0; s < 4; ++s) d = __builtin_amdgcn_mfma_f32_32x32x16_bf16(kf[s], qf[h][s], d, 0, 0, 0);
#pragma unroll
                    for (int i = 0; i < 16; ++i) sc[i] = fmaf(fmaxf(d[i], 0.f), wq[h], sc[i]); }
                if (j == nkt - 1) {
#pragma unroll
                    for (int i = 0; i < 16; ++i) if (crow(i, hi) > r32) sc[i] = -INFINITY;
                }
                if (pass == 0) {
                    LAS unsigned short* mb = maxbuf + r32 * 1024 + (j * 2 + hi) * npl;
                    if (lg == 0) {
#pragma unroll
                        for (int i = 0; i < 16; ++i) mb[i] = (unsigned short)(fkey(sc[i]) >> 16);
                    } else {
                        float m2[8];
#pragma unroll
                        for (int i = 0; i < 8; ++i) m2[i] = fmaxf(sc[2 * i], sc[2 * i + 1]);
                        if (lg == 1) {
#pragma unroll
                            for (int i = 0; i < 8; ++i) mb[i] = (unsigned short)(fkey(m2[i]) >> 16);
                        } else if (lg == 2) {
#pragma unroll
                            for (int i = 0; i < 4; ++i) mb[i] = (unsigned short)(fkey(fmaxf(m2[2 * i], m2[2 * i + 1])) >> 16);
                        } else {
                            mb[0] = (unsigned short)(fkey(fmaxf(fmaxf(m2[0], m2[1]), fmaxf(m2[2], m2[3]))) >> 16);
                            mb[1] = (unsigned short)(fkey(fmaxf(fmaxf(m2[4], m2[5]), fmaxf(m2[6], m2[7]))) >> 16);
                        }
                    }
                } else {
#pragma unroll
                    for (int i = 0; i < 16; ++i) {
                        if (sc[i] >= thrf) {
                            const unsigned slot = __hip_atomic_fetch_add(ccnt + r32, 1u, __ATOMIC_RELAXED, __HIP_MEMORY_SCOPE_WORKGROUP);
                            if (slot < (unsigned)DSA_CAP) { ckey[r32 * DSA_CAP + slot] = fkey(sc[i]); cidx[r32 * DSA_CAP + slot] = (unsigned short)(32 * j + crow(i, hi)); }
                        }
                    }
                }
            }
            __syncthreads();
            if (pass == 0) {
                const int G = nmax >> lg;
                for (int jq = 0; jq < 4; ++jq) { const int q = wid * 4 + jq;
                    unsigned v[16];
#pragma unroll
                    for (int i = 0; i < 16; ++i) { const int e = lane + 64 * i; v[i] = e < G ? (unsigned)maxbuf[q * 1024 + e] : 0u; }
                    int ko, ce; const unsigned tau = radix_kth<16, 2>(v, G, hist, TOPK, lane, ko, ce);
                    if (lane == 0) ctau[q] = tau;
                }
                __syncthreads();
            }
        }
        for (int jq = 0; jq < 4; ++jq) { const int q = wid * 4 + jq;
            int c = (int)ccnt[q]; if (c > DSA_CAP) c = DSA_CAP;
            unsigned kv[8], ix[8];
#pragma unroll
            for (int i = 0; i < 8; ++i) { const int e = lane + 64 * i; kv[i] = e < c ? ckey[q * DSA_CAP + e] : 0u; ix[i] = e < c ? (unsigned)cidx[q * DSA_CAP + e] : 0xffffu; }
            int k, ceq; const unsigned thr = radix_kth<8, 4>(kv, c, hist, TOPK, lane, k, ceq);
            unsigned ti = 0xffffu;
            if (ceq > k) {
                unsigned pi = 0u; int kk = k;
                for (int bit = 15; bit >= 0; --bit) { const unsigned test = pi >> bit; int cnt = 0;
#pragma unroll
                    for (int i = 0; i < 8; ++i) cnt += __popcll(__ballot(kv[i] == thr && (ix[i] >> bit) == test));
                    if (cnt < kk) { kk -= cnt; pi |= (1u << bit); } }
                ti = pi;
            }
            *(LAS u32x4*)(hist + 4 * lane) = (u32x4){0u, 0u, 0u, 0u};
            LDS_WAIT();
#pragma unroll
            for (int i = 0; i < 8; ++i) if (kv[i] > thr || (kv[i] == thr && ix[i] <= ti)) __hip_atomic_fetch_or(hist + (ix[i] >> 5), 1u << (ix[i] & 31), __ATOMIC_RELAXED, __HIP_MEMORY_SCOPE_WORKGROUP);
            LDS_WAIT();
            const u32x4 w4 = *(const LAS u32x4*)(hist + 4 * lane);
            const unsigned w[4] = {w4.x, w4.y, w4.z, w4.w};
            const int n = (__popc(w[0]) + __popc(w[1])) + (__popc(w[2]) + __popc(w[3]));
            int pos = n;
#pragma unroll
            for (int o = 1; o < 64; o <<= 1) { const int t = __shfl_up(pos, o); if (lane >= o) pos += t; }
            pos -= n;
#pragma unroll
            for (int i = 0; i < 4; ++i) { unsigned ww = w[i]; while (ww) { const int bpos = __ffs((int)ww) - 1; ww &= ww - 1; if (pos < TOPK) sel[q * 256 + pos] = (unsigned short)(lane * 128 + i * 32 + bpos); ++pos; } }
            LDS_WAIT();
        }
    } else {
        for (int e = F.tid; e < 32 * 256; e += NWAVES * 64) sel[e] = (unsigned short)(e & 255);
    }
    __syncthreads();
    const int c16 = lane & 15, g4 = lane >> 4;
    const bf16_t* Kd = WSP(const bf16_t, WS_KD) + rowb * 64;
    const bf16_t* Vd = WSP(const bf16_t, WS_VD) + rowb * 64;
    const unsigned vs_base = (unsigned)(uintptr_t)(F.lds + DL_VS) + (unsigned)wid * 12288u;
    const LAS unsigned char* vs_ptr = F.lds + DL_VS + wid * 12288;
    const int tr_off = (4 * g4 + (c16 >> 2)) * 128 + (c16 & 3) * 8;
    for (int jq = 0; jq < 4; ++jq) { const int q = wid * 4 + jq, t = t0 + q; const int nsel = t + 1 < TOPK ? t + 1 : TOPK;
        const LAS unsigned short* selq = sel + q * 256;
#define DSA_VDMA(u) do { _Pragma("unroll") for (int p_ = 0; p_ < 4; ++p_) { const int kidx_ = (int)selq[32 * (u) + 8 * p_ + (lane >> 3)]; \
            glds16(Vd + (size_t)kidx_ * 64 + (lane & 7) * 8, (unsigned)__builtin_amdgcn_readfirstlane(vs_base + (unsigned)(((u) % 3) * 4096 + p_ * 1024))); } } while (0)
        asm volatile("s_waitcnt lgkmcnt(0)" ::: "memory");
        DSA_VDMA(0); DSA_VDMA(1); DSA_VDMA(2);
        bf16x8 qf[2];
        { const bf16_t* qrow = WSP(const bf16_t, WS_QD) + (rowb + t) * 256 + (c16 & 3) * 64 + 8 * g4;
          qf[0] = *(const bf16x8*)qrow; qf[1] = *(const bf16x8*)(qrow + 32);
          if (c16 >= 4) { qf[0] = (bf16x8){0, 0, 0, 0, 0, 0, 0, 0}; qf[1] = qf[0]; } }
        f32x4 S[16];
#pragma unroll
        for (int ch = 0; ch < 4; ++ch) {
            bf16x8 kf[4][2];
#pragma unroll
            for (int kb = 0; kb < 4; ++kb) { const int kidx = (int)selq[64 * ch + 16 * kb + c16]; const bf16_t* kr = Kd + (size_t)kidx * 64 + 8 * g4; kf[kb][0] = *(const bf16x8*)kr; kf[kb][1] = *(const bf16x8*)(kr + 32); }
#pragma unroll
            for (int kb = 0; kb < 4; ++kb) { f32x4 a = {0.f, 0.f, 0.f, 0.f};
                a = __builtin_amdgcn_mfma_f32_16x16x32_bf16(kf[kb][0], qf[0], a, 0, 0, 0); a = __builtin_amdgcn_mfma_f32_16x16x32_bf16(kf[kb][1], qf[1], a, 0, 0, 0); S[4 * ch + kb] = a; }
        }
        if (nsel < TOPK) {
#pragma unroll
            for (int kb = 0; kb < 16; ++kb)
#pragma unroll
                for (int r = 0; r < 4; ++r) if (16 * kb + 4 * g4 + r >= nsel) S[kb][r] = -INFINITY;
        }
        float mx = S[0][0];
#pragma unroll
        for (int kb = 0; kb < 16; ++kb)
#pragma unroll
            for (int r = 0; r < 4; ++r) mx = fmaxf(mx, S[kb][r]);
        mx = fmaxf(mx, __shfl_xor(mx, 16)); mx = fmaxf(mx, __shfl_xor(mx, 32));
        float l = 0.f;
#pragma unroll
        for (int kb = 0; kb < 16; ++kb)
#pragma unroll
            for (int r = 0; r < 4; ++r) { S[kb][r] = __builtin_amdgcn_exp2f(S[kb][r] - mx); l += S[kb][r]; }
        l += __shfl_xor(l, 16); l += __shfl_xor(l, 32);
        f32x4 O[4];
#pragma unroll
        for (int db = 0; db < 4; ++db) O[db] = (f32x4){0.f, 0.f, 0.f, 0.f};
#pragma unroll
        for (int u = 0; u < 8; ++u) {
            u32x4 pw; pw.x = cvtpk(S[2 * u][0], S[2 * u][1]); pw.y = cvtpk(S[2 * u][2], S[2 * u][3]); pw.z = cvtpk(S[2 * u + 1][0], S[2 * u + 1][1]); pw.w = cvtpk(S[2 * u + 1][2], S[2 * u + 1][3]);
            const bf16x8 pb = __builtin_bit_cast(bf16x8, pw);
            if (u < 3) { if (u == 0) asm volatile("s_waitcnt vmcnt(0)" ::: "memory"); }
            else if (u < 6) asm volatile("s_waitcnt vmcnt(8)" ::: "memory");
            else if (u == 6) asm volatile("s_waitcnt vmcnt(4)" ::: "memory");
            else asm volatile("s_waitcnt vmcnt(0)" ::: "memory");
            const LAS unsigned char* sp = vs_ptr + (u % 3) * 4096 + tr_off;
#pragma unroll
            for (int db = 0; db < 4; ++db) {
                const v4i16_t lo = __builtin_amdgcn_ds_read_tr16_b64_v4i16((LAS v4i16_t*)(sp + db * 32));
                const v4i16_t hv = __builtin_amdgcn_ds_read_tr16_b64_v4i16((LAS v4i16_t*)(sp + db * 32 + 2048));
                const bf16x8 va = (bf16x8){lo[0], lo[1], lo[2], lo[3], hv[0], hv[1], hv[2], hv[3]};
                O[db] = __builtin_amdgcn_mfma_f32_16x16x32_bf16(va, pb, O[db], 0, 0, 0);
            }
            if (u + 3 < 8) { asm volatile("s_waitcnt lgkmcnt(0)" ::: "memory"); DSA_VDMA(u + 3); }
        }
#undef DSA_VDMA
        if (c16 < 4) {
            const float rl = 1.0f / l;
            bf16_t* orow = WSP(bf16_t, WS_OCAT) + (rowb + t) * DM + 512 + c16 * 64 + 4 * g4;
#pragma unroll
            for (int db = 0; db < 4; ++db) { u32x2 w; w.x = cvtpk(O[db][0] * rl, O[db][1] * rl); w.y = cvtpk(O[db][2] * rl, O[db][3] * rl); *(u32x2*)(orow + 16 * db) = w; }
        }
    }
}


__device__ __forceinline__ void p2_attention(Frame& F) {
    const int NIT = NB * (SEQ / 32);
#ifndef REP_DSA
#define REP_DSA 1
#endif
#ifndef REP_SWAMEM
#define REP_SWAMEM 1
#endif
    for (int rep = 0; rep < REP_DSA; ++rep)
    for (int r = 0; r < (NIT + F.G - 1) / F.G; ++r) {
        int b, tile;
        if (F.G == 256) { const int j = F.vcu & 63; b = F.vcu >> 6; tile = r == 0 ? j : (r == 1 ? 127 - j : (r == 2 ? 128 + j : 255 - j)); }
        else { const int it = r * F.G + F.vcu; if (it >= NIT) break; b = it / (SEQ / 32); tile = it % (SEQ / 32); }
        dsa_item(F, b, tile * 32);
    }
    for (int rep = 0; rep < REP_SWAMEM; ++rep) {
    for (int it = F.vcu; it < NB * (SEQ / 128); it += F.G) swa_item(F, it / (SEQ / 128), it % (SEQ / 128));
    for (int it = F.vcu; it < NB * (SEQ / 128); it += F.G) mem_item(F, it / (SEQ / 128), it % (SEQ / 128));
    }
}

#ifndef MK_N_LAUNCHES
#define MK_N_LAUNCHES 1
#endif
constexpr int N_PHASES = 8;
struct Args { const void* in[17]; float* out; unsigned char* ws; int ph_lo, ph_hi, li, pad; };

__global__ void __launch_bounds__(NWAVES * 64, 2) hybrid_fwd(Args args) {
    extern __shared__ __attribute__((aligned(16))) unsigned char lds[];
    Frame F;
    F.lds = (LAS unsigned char*)lds;
    F.MISC = (volatile LAS unsigned*)(F.lds + MISC_OFF);
    F.tid = threadIdx.x; F.lane = F.tid & 63; F.wave = __builtin_amdgcn_readfirstlane(F.tid >> 6);
    F.G = gridDim.x; { const int bx = blockIdx.x; F.vcu = (F.G % 8 == 0) ? (bx % 8) * (F.G / 8) + bx / 8 : bx; }
    F.ws = args.ws; F.ctl = (unsigned*)(args.ws + WS_CTL);
    F.x = (const float*)args.in[0]; F.mem = (const float*)args.in[1]; F.positions = (const int*)args.in[2]; F.g_mix = (const float*)args.in[3]; F.w_in = (const float*)args.in[4];
    F.b_gate = (const float*)args.in[5]; F.sinks = (const float*)args.in[6]; F.g_mem = (const float*)args.in[7]; F.w_mem_kv = (const float*)args.in[8]; F.w_proj_swa = (const float*)args.in[9];
    F.w_proj_dsa = (const float*)args.in[10]; F.w_proj_mem = (const float*)args.in[11]; F.w_out = (const float*)args.in[12]; F.g_mlp = (const float*)args.in[13]; F.w_mlp_in = (const float*)args.in[14];
    F.w_mlp_out = (const float*)args.in[15]; F.g_final = (const float*)args.in[16]; F.out = args.out;
    for (int u = F.tid; u < (LDS_BYTES - LDSCTL_OFF) / 4; u += NWAVES * 64) ((LAS unsigned*)(F.lds + LDSCTL_OFF))[u] = 0u;
    __syncthreads();
    XcdBarrier bar; bar.bar = F.ctl + CW_BAR + args.li * XCD_BAR_WORDS; bar.x = 0; bar.st = nullptr;
    if (args.ph_hi - args.ph_lo > 1) bar = xcd_barrier_post(F.ctl + CW_BAR + args.li * XCD_BAR_WORDS, F.MISC + 8);
    const int lo = args.ph_lo, hi = args.ph_hi;
#ifndef PHASE_MASK
#define PHASE_MASK 0xff
#endif
#define IN(k) (((PHASE_MASK >> (k)) & 1) && lo <= (k) && (k) < hi)
#define BOTH(k) (IN(k) && IN((k) + 1))
#define GRID_BAR() xcd_barrier(bar)
    const int bx = (int)blockIdx.x;

    if (IN(0)) { p0_prologue(F); if (BOTH(0)) GRID_BAR(); }

    if (IN(1)) {
        SchedInProj S; S.nM = T / 256; S.nN = NPOS / 256; S.nwg = S.nM * S.nN; S.G = F.G; S.c = bx;
        S.Ab = (const char*)WSP(bf16_t, WS_XB); S.Bb = (const char*)WSP(bf16_t, WS_WIN); S.Am = (const char*)WSP(bf16_t, WS_MEMB); S.Bm = (const char*)WSP(bf16_t, WS_WMEM);
        EpiInProj E; E.inv_rms = WSP(float, WS_INVRMS0); E.inv_rms_mem = WSP(float, WS_INVRMSM); E.cs = WSP(float, WS_CS); E.b_gate = F.b_gate;
        E.q_s = WSP(bf16_t, WS_QS); E.k_s = WSP(bf16_t, WS_KS); E.v_s = WSP(bf16_t, WS_VS); E.q_d = WSP(bf16_t, WS_QD); E.k_d = WSP(bf16_t, WS_KD); E.v_d = WSP(bf16_t, WS_VD);
        E.q_i = WSP(bf16_t, WS_QI); E.k_i = WSP(bf16_t, WS_KI); E.q_m = WSP(bf16_t, WS_QM); E.gates = WSP(bf16_t, WS_GATES); E.mk = WSP(bf16_t, WS_MK); E.mv = WSP(bf16_t, WS_MV); E.w_i = WSP(float, WS_WI);
        pg8::gemm_phase<EpiInProj, SchedInProj, true>(F.lds + RING_OFF, DM, DM, S, E);
        if (BOTH(1)) GRID_BAR();
    }

    if (IN(2)) { p2_attention(F); if (BOTH(2)) GRID_BAR(); }

    if (IN(3)) {
        SchedMerge S; S.G = F.G; S.c = bx; S.Ab = (const char*)WSP(bf16_t, WS_OCAT); S.Bb = (const char*)WSP(bf16_t, WS_WPROJ);
        EpiMerge E; E.gates = WSP(bf16_t, WS_GATES); E.merged = WSP(bf16_t, WS_MERGED);
        pg8::gemm_phase<EpiMerge, SchedMerge, true>(F.lds + RING_OFF, DM, DM, S, E);
        if (BOTH(3)) GRID_BAR();
    }

    if (IN(4)) {
        SchedGrid S; S.nM = T / 256; S.nN = DM / 256; S.nwg = S.nM * S.nN; S.G = F.G; S.c = bx; S.nt = DM / 64;
        S.Ab = (const char*)WSP(bf16_t, WS_MERGED); S.Bb = (const char*)WSP(bf16_t, WS_WOUT); S.tA = (size_t)256 * DM * 2; S.tB = (size_t)256 * DM * 2;
        EpiResid<true> E; E.base = F.x; E.out = F.out; E.outb = WSP(bf16_t, WS_XB); E.ssq = WSP(float, WS_SSQ1);
        pg8::gemm_phase<EpiResid<true>, SchedGrid, true>(F.lds + RING_OFF, DM, DM, S, E);
        if (BOTH(4)) GRID_BAR();
    }

    if (IN(5)) {
        SchedGrid S; S.nM = T / 256; S.nN = DFF / 256; S.nwg = S.nM * S.nN; S.G = F.G; S.c = bx; S.nt = DM / 64;
        S.Ab = (const char*)WSP(bf16_t, WS_XB); S.Bb = (const char*)WSP(bf16_t, WS_W1); S.tA = (size_t)256 * DM * 2; S.tB = (size_t)256 * DM * 2;
        EpiMlpIn E; E.ssq = WSP(float, WS_SSQ1); E.hid = WSP(bf16_t, WS_HID);
        pg8::gemm_phase<EpiMlpIn, SchedGrid, true>(F.lds + RING_OFF, DM, DM, S, E);
        if (BOTH(5)) GRID_BAR();
    }

    if (IN(6)) {
        SchedGrid S; S.nM = T / 256; S.nN = DM / 256; S.nwg = S.nM * S.nN; S.G = F.G; S.c = bx; S.nt = DFF / 64;
        S.Ab = (const char*)WSP(bf16_t, WS_HID); S.Bb = (const char*)WSP(bf16_t, WS_W2); S.tA = (size_t)256 * DFF * 2; S.tB = (size_t)256 * DFF * 2;
        EpiResid<false> E; E.base = F.out; E.out = F.out; E.outb = nullptr; E.ssq = WSP(float, WS_SSQ2);
        pg8::gemm_phase<EpiResid<false>, SchedGrid, true>(F.lds + RING_OFF, DFF, DFF, S, E);
        if (BOTH(6)) GRID_BAR();
    }

    if (IN(7)) p7_final_norm(F);
#undef IN
#undef BOTH
#undef GRID_BAR
}

extern "C" void kernel_launch(void* const* d_in, const int* in_sizes, int n_in, void* d_out, int out_size, void* d_ws, size_t ws_size, hipStream_t stream) {
    static int grid = 0;
    if (grid == 0) {
        if (n_in != 17 || in_sizes[0] != T * DM || out_size != T * DM || ws_size < WS_END) { fprintf(stderr, "kernel_launch: unexpected shapes (n_in %d, in0 %d, out %d, ws %zu < %zu); nothing launched\n", n_in, n_in > 0 ? in_sizes[0] : -1, out_size, ws_size, (size_t)WS_END); grid = -1; return; }
        int dev = 0, cus = 0, per_cu = 0;
        if (hipGetDevice(&dev) != hipSuccess || hipDeviceGetAttribute(&cus, hipDeviceAttributeMultiprocessorCount, dev) != hipSuccess) { grid = -1; return; }
        if (hipFuncSetAttribute((const void*)hybrid_fwd, hipFuncAttributeMaxDynamicSharedMemorySize, LDS_BYTES) != hipSuccess) { fprintf(stderr, "kernel_launch: hipFuncSetAttribute failed\n"); grid = -1; return; }
        if (hipOccupancyMaxActiveBlocksPerMultiprocessor(&per_cu, (const void*)hybrid_fwd, NWAVES * 64, LDS_BYTES) != hipSuccess || per_cu < 1) { fprintf(stderr, "kernel_launch: occupancy query reports %d workgroups per CU; nothing launched\n", per_cu); (void)hipGetLastError(); grid = -1; return; }
        (void)hipGetLastError();
        grid = cus;
    }
    if (grid < 0) return;
    if (hipMemsetAsync((char*)d_ws + WS_CTL, 0, CTL_ZERO_BYTES, stream) != hipSuccess) return;
    Args a{};
    for (int i = 0; i < 17; ++i) a.in[i] = d_in[i];
    a.out = (float*)d_out; a.ws = (unsigned char*)d_ws;
    if (MK_N_LAUNCHES == 1) { a.ph_lo = 0; a.ph_hi = N_PHASES; a.li = 0; hipLaunchKernelGGL(hybrid_fwd, dim3(grid), dim3(NWAVES * 64), LDS_BYTES, stream, a); }
    else { for (int p = 0; p < N_PHASES; ++p) { a.ph_lo = p; a.ph_hi = p + 1; a.li = 0; hipLaunchKernelGGL(hybrid_fwd, dim3(grid), dim3(NWAVES * 64), LDS_BYTES, stream, a); } }
}
```

```cpp
#include <hip/hip_runtime.h>
#include <cstdio>
#include <cstdint>

#define LAS __attribute__((address_space(3)))
#define GAS __attribute__((address_space(1)))
typedef unsigned short bf16_t;
typedef short bf16x8 __attribute__((ext_vector_type(8)));
typedef float f32x2 __attribute__((ext_vector_type(2)));
typedef float f32x4 __attribute__((ext_vector_type(4)));
typedef float f32x16 __attribute__((ext_vector_type(16)));
typedef unsigned u32x2 __attribute__((ext_vector_type(2)));
typedef unsigned u32x4 __attribute__((ext_vector_type(4)));
typedef __bf16 bf16x2_t __attribute__((ext_vector_type(2)));

constexpr int NB = 4, SEQ = 8192, T = NB * SEQ, DM = 1024, DFF = 4096, DIN = 4804, NPOS = 4864, MEMLEN = 256, MROWS = NB * MEMLEN;
constexpr float EPS = 1e-6f;
constexpr float LOG2E = 1.4426950408889634f;
constexpr float QSCALE = 0.125f * LOG2E;
constexpr float IDX_SCALE = 0.0625f;
constexpr int TOPK = 256;
constexpr int P_QS = 0, P_KS = 512, P_VS = 640, P_QD = 768, P_KD = 1024, P_VD = 1088, P_QI = 1152, P_KI = 1408, P_QM = 1472, P_GATE = 1728, P_WI = 4800, P_END = 4804;

constexpr size_t MiB = 1u << 20;
constexpr size_t WS_CTL = 0, CTL_ZERO_BYTES = 1 * MiB;
constexpr size_t WS_WIN = 1 * MiB, WS_WMEM = 11 * MiB, WS_WPROJ = 12 * MiB, WS_WOUT = 14 * MiB, WS_W1 = 16 * MiB, WS_W2 = 24 * MiB;
constexpr size_t WS_INVRMS0 = 32 * MiB, WS_INVRMSM = 32 * MiB + 128 * 1024, WS_WI = 32 * MiB + 256 * 1024;
constexpr size_t WS_SSQ1 = 33 * MiB, WS_SSQ2 = 35 * MiB, WS_CS = 37 * MiB, WS_MEMB = 45 * MiB, WS_MK = 47 * MiB, WS_MV = 47 * MiB + 512 * 1024;
constexpr size_t WS_XB = 48 * MiB;
constexpr size_t WS_OCAT = 112 * MiB;
constexpr size_t WS_QS = 176 * MiB, WS_KS = 208 * MiB, WS_VS = 216 * MiB, WS_QD = 224 * MiB, WS_KD = 240 * MiB, WS_VD = 244 * MiB, WS_QI = 248 * MiB, WS_KI = 264 * MiB, WS_QM = 268 * MiB;
constexpr size_t WS_GATES = 284 * MiB;
constexpr size_t WS_MERGED = 176 * MiB;
constexpr size_t WS_HID = 176 * MiB;
constexpr size_t WS_END = 476 * MiB;
static_assert(WS_WIN + (size_t)NPOS * DM * 2 <= WS_WMEM && WS_GATES + (size_t)T * 3072 * 2 <= WS_END && WS_HID + (size_t)T * DFF * 2 <= WS_END, "d_ws map");
constexpr int CW_TMO = 0, CW_CODE = 1, CW_BAR = 4096;

constexpr int RING_OFF = 0, RING_BYTES = 131072;
constexpr int LDSCTL_OFF = RING_BYTES, MISC_OFF = LDSCTL_OFF + 320;
constexpr int LDS_BYTES = 147456;
constexpr int NWAVES = 8;

#define LDS_WAIT() asm volatile("s_waitcnt lgkmcnt(0)" ::: "memory")
#define VM_WAIT() asm volatile("s_waitcnt vmcnt(0)" ::: "memory")
#define RLX_AGENT __ATOMIC_RELAXED, __HIP_MEMORY_SCOPE_AGENT

__device__ __forceinline__ unsigned cvtpk(float lo, float hi) { f32x2 v = {lo, hi}; bf16x2_t b = __builtin_convertvector(v, bf16x2_t); return __builtin_bit_cast(unsigned, b); }
__device__ __forceinline__ float bf_lo(unsigned w) { return __uint_as_float(w << 16); }
__device__ __forceinline__ float bf_hi(unsigned w) { return __uint_as_float(w & 0xffff0000u); }
__device__ __forceinline__ float wave_sum(float v) {
#pragma unroll
    for (int o = 1; o < 64; o <<= 1) v += __shfl_xor(v, o);
    return v;
}
__device__ __forceinline__ float wave_max(float v) {
#pragma unroll
    for (int o = 1; o < 64; o <<= 1) v = fmaxf(v, __shfl_xor(v, o));
    return v;
}

namespace pg8 {
constexpr int BM = 256, BK = 64, HALF = 128, HTB = HALF * BK * 2  , STAGE_BYTES = 8 * HTB, NXCD = 8, WGM = 8;
__host__ __device__ __forceinline__ int lds_byte(int r, int c) { const int st = (r >> 4) * 2 + (c >> 5), rr = r & 15, cc = c & 31, ob = rr * 64 + cc * 2; return st * 1024 + (ob ^ (((ob >> 9) & 1) << 5)); }
__host__ __device__ __forceinline__ void stage_rc(int b, int& R, int& C) { const int st = b / 1024, sb = b % 1024, swz = sb ^ (((sb >> 9) & 1) << 5); R = (st >> 1) * 16 + swz / 64; C = (st & 1) * 32 + (swz % 64) / 2; }
__host__ __device__ __forceinline__ int perm32(int rho) { const int n = rho >> 4, i = rho & 15; return 8 * (i >> 2) + 4 * n + (i & 3); }

struct Unit { int pm, pn, kind, nt; const char* A; const char* B; };

__device__ __forceinline__ void map_tile(int L, int nM, int nN, int& pm, int& pn) {
    const int nwg = nM * nN;
    int wgid = L; { const int q = nwg / NXCD, r = nwg % NXCD, xcd = wgid % NXCD, off = wgid / NXCD; wgid = (xcd < r ? xcd * (q + 1) : r * (q + 1) + (xcd - r) * q) + off; }
    const int nig = WGM * nN, gid = wgid / nig, fm = gid * WGM, gsz = (nM - fm) < WGM ? (nM - fm) : WGM;
    pm = fm + ((wgid % nig) % gsz); pn = (wgid % nig) / gsz;
}

template <class Epi, class Sched, bool ALIGN_EPI>
__device__ __forceinline__ void gemm_phase(LAS unsigned char* lds, const int lda, const int ldb, const Sched& S, const Epi& E) {
    const int tid = threadIdx.x, wid = __builtin_amdgcn_readfirstlane(tid >> 6), lane = tid & 63, wr = wid >> 2, wc = wid & 3, fr = lane & 15, fq = lane >> 4;
    unsigned voffA[2], voffB[2];
#pragma unroll
    for (int i = 0; i < 2; ++i) { int R, C; stage_rc(tid * 16 + i * 8192, R, C); const int Rb = Epi::PERM ? ((R & ~31) + perm32(R & 31)) : R;
        voffA[i] = (unsigned)(R * lda + C) * 2u; voffB[i] = (unsigned)(Rb * ldb + C) * 2u; }
    const size_t kstep = (size_t)(BK * 2);
    const size_t hstepA = (size_t)HALF * lda * 2, hstepB = (size_t)HALF * ldb * 2;
    const unsigned ldsw = (unsigned)wid * 1024u;
    const int aoff = lds_byte(wr * 64 + fr, fq * 8), boff = lds_byte(wc * 32 + fr, fq * 8);
#define PG8_SA(b, h) (((b) * 2 + (h)) * HTB)
#define PG8_SB(b, h) ((4 + (b) * 2 + (h)) * HTB)
#define PG8_STAGE(bufoff, gbase, voff) do { _Pragma("unroll") for (int _i = 0; _i < 2; ++_i) \
        __builtin_amdgcn_global_load_lds((const unsigned*)((const char*)(gbase) + (voff)[_i]), (LAS unsigned*)(lds + (bufoff) + ldsw + _i * 8192), 16, 0, 0); } while (0)
#define PG8_LDA(dst, b, h) do { _Pragma("unroll") for (int m = 0; m < 4; ++m) _Pragma("unroll") for (int k = 0; k < 2; ++k) dst[m][k] = *(const LAS bf16x8*)(lds + PG8_SA(b, h) + aoff + m * 2048 + k * 1024); } while (0)
#define PG8_LDB(dst, b, h) do { _Pragma("unroll") for (int n = 0; n < 2; ++n) _Pragma("unroll") for (int k = 0; k < 2; ++k) dst[n][k] = *(const LAS bf16x8*)(lds + PG8_SB(b, h) + boff + n * 2048 + k * 1024); } while (0)
#define PG8_MMA(ai, bj, At, Bt) do { __builtin_amdgcn_s_setprio(1); _Pragma("unroll") for (int m = 0; m < 4; ++m) _Pragma("unroll") for (int n = 0; n < 2; ++n) _Pragma("unroll") for (int k = 0; k < 2; ++k) \
        acc[ai][bj][m][n] = __builtin_amdgcn_mfma_f32_16x16x32_bf16(Bt[n][k], At[m][k], acc[ai][bj][m][n], 0, 0, 0); __builtin_amdgcn_s_setprio(0); } while (0)
#define PG8_WAIT_V(n) asm volatile("s_waitcnt vmcnt(" #n ")" ::: "memory")
#define PG8_WAIT_L(n) asm volatile("s_waitcnt lgkmcnt(" #n ")" ::: "memory")
#define PG8_BAR __builtin_amdgcn_s_barrier()
#define PG8_SCHED __builtin_amdgcn_sched_barrier(0)
    Unit cur, nxt; int ui = 0;
    if (!S.next(0, cur)) return;
    f32x4 acc[2][2][4][2];
#pragma unroll
    for (int a = 0; a < 2; ++a)
#pragma unroll
        for (int b = 0; b < 2; ++b)
#pragma unroll
            for (int m = 0; m < 4; ++m)
#pragma unroll
                for (int n = 0; n < 2; ++n) acc[a][b][m][n] = (f32x4){0.f, 0.f, 0.f, 0.f};
    bf16x8 At[4][2], B0[2][2], B1[2][2];
    const char* cA = cur.A; const char* cB = cur.B;
    PG8_STAGE(PG8_SB(0, 0), cB, voffB); PG8_STAGE(PG8_SB(0, 1), cB + hstepB, voffB); PG8_STAGE(PG8_SA(0, 0), cA, voffA); PG8_STAGE(PG8_SA(0, 1), cA + hstepA, voffA);
    if (wr == 1) PG8_BAR;
    PG8_WAIT_V(2); PG8_BAR;
    PG8_STAGE(PG8_SB(1, 0), cB + kstep, voffB); PG8_STAGE(PG8_SA(1, 0), cA + kstep, voffA); PG8_STAGE(PG8_SB(1, 1), cB + hstepB + kstep, voffB);
    PG8_WAIT_V(6); PG8_BAR;
    for (;;) {
        const bool has_next = S.next(ui + 1, nxt);
        const char* nA = has_next ? nxt.A : cA; const char* nB = has_next ? nxt.B : cB;
        const int nt = cur.nt;
        for (int t = 0; t < nt; t += 2) {
            const bool last = (t == nt - 2);
            const char* a1 = cA + (size_t)(t + 1) * kstep;
            const char* a2 = last ? nA : cA + (size_t)(t + 2) * kstep; const char* b2 = last ? nB : cB + (size_t)(t + 2) * kstep;
            const char* a3 = a2 + kstep; const char* b3 = b2 + kstep;
            PG8_LDB(B0, 0, 0); PG8_LDB(B1, 0, 1); PG8_SCHED; PG8_LDA(At, 0, 0); PG8_STAGE(PG8_SA(1, 1), a1 + hstepA, voffA);
            PG8_WAIT_V(8); PG8_WAIT_L(0); PG8_BAR; PG8_MMA(0, 0, At, B0); PG8_MMA(0, 1, At, B1); PG8_BAR; PG8_SCHED;
            PG8_LDA(At, 0, 1); PG8_STAGE(PG8_SB(0, 0), b2, voffB); PG8_STAGE(PG8_SB(0, 1), b2 + hstepB, voffB); PG8_STAGE(PG8_SA(0, 0), a2, voffA);
            PG8_WAIT_V(8); PG8_WAIT_L(0); PG8_BAR; PG8_MMA(1, 0, At, B0); PG8_MMA(1, 1, At, B1); PG8_BAR; PG8_SCHED;
            PG8_LDB(B0, 1, 0); PG8_LDB(B1, 1, 1); PG8_SCHED; PG8_LDA(At, 1, 0); PG8_STAGE(PG8_SA(0, 1), a2 + hstepA, voffA);
            PG8_WAIT_V(8); PG8_WAIT_L(0); PG8_BAR; PG8_MMA(0, 0, At, B0); PG8_MMA(0, 1, At, B1); PG8_BAR; PG8_SCHED;
            PG8_LDA(At, 1, 1); PG8_STAGE(PG8_SB(1, 0), b3, voffB); PG8_STAGE(PG8_SB(1, 1), b3 + hstepB, voffB); PG8_STAGE(PG8_SA(1, 0), a3, voffA);
            PG8_WAIT_V(8); PG8_WAIT_L(0); PG8_BAR; PG8_MMA(1, 0, At, B0); PG8_MMA(1, 1, At, B1); PG8_BAR; PG8_SCHED;
        }
        if constexpr (ALIGN_EPI) { if (wr == 0) PG8_BAR; }
        E(acc, cur, wr, wc, fr, fq);
        if (!has_next) break;
#pragma unroll
        for (int a = 0; a < 2; ++a)
#pragma unroll
            for (int b = 0; b < 2; ++b)
#pragma unroll
                for (int m = 0; m < 4; ++m)
#pragma unroll
                    for (int n = 0; n < 2; ++n) acc[a][b][m][n] = (f32x4){0.f, 0.f, 0.f, 0.f};
        cur = nxt; cA = nA; cB = nB; ++ui;
        if constexpr (ALIGN_EPI) { if (wr == 1) PG8_BAR; }
    }
    PG8_WAIT_V(0);
    if constexpr (!ALIGN_EPI) { if (wr == 0) PG8_BAR; }
    PG8_BAR;
#undef PG8_SA
#undef PG8_SB
#undef PG8_STAGE
#undef PG8_LDA
#undef PG8_LDB
#undef PG8_MMA
#undef PG8_WAIT_V
#undef PG8_WAIT_L
#undef PG8_BAR
#undef PG8_SCHED
}
}

struct SchedGrid {
    int nM, nN, nwg, G, c, nt; const char* Ab; const char* Bb; size_t tA, tB;
    __device__ __forceinline__ bool next(int i, pg8::Unit& u) const {
        const long L = (long)i * G + c; if (L >= nwg) return false;
        pg8::map_tile((int)L, nM, nN, u.pm, u.pn); u.kind = 0; u.nt = nt; u.A = Ab + (size_t)u.pm * tA; u.B = Bb + (size_t)u.pn * tB; return true;
    }
};
struct SchedInProj {
    int nM, nN, nwg, G, c; const char* Ab; const char* Bb; const char* Am; const char* Bm;
    __device__ __forceinline__ bool next(int i, pg8::Unit& u) const {
        const long L = (long)i * G + c; if (L >= nwg + 8) return false;
        u.nt = DM / 64;
        if (L < nwg) { pg8::map_tile((int)L, nM, nN, u.pm, u.pn); u.kind = 0; u.A = Ab + (size_t)u.pm * (256 * DM * 2); u.B = Bb + (size_t)u.pn * (256 * DM * 2); }
        else { const int e = (int)(L - nwg); u.pm = e >> 1; u.pn = e & 1; u.kind = 1; u.A = Am + (size_t)u.pm * (256 * DM * 2); u.B = Bm + (size_t)u.pn * (256 * DM * 2); }
        return true;
    }
};
struct SchedMerge {
    int G, c; const char* Ab; const char* Bb;
    __device__ __forceinline__ bool next(int i, pg8::Unit& u) const {
        const int round = i / 3, br = i - 3 * round; const long L = (long)round * G + c; if (L >= 512) return false;
        pg8::map_tile((int)L, 128, 4, u.pm, u.pn); u.kind = br; u.nt = br == 0 ? 8 : 4;
        const int koff = br == 0 ? 0 : (br == 1 ? 512 : 768);
        u.A = Ab + (size_t)u.pm * (256 * DM * 2) + koff * 2; u.B = Bb + (size_t)u.pn * (256 * DM * 2) + koff * 2; return true;
    }
};

__device__ __forceinline__ float sigmoidf_fast(float x) { return __builtin_amdgcn_rcpf(1.0f + __builtin_amdgcn_exp2f(-x * LOG2E)); }

struct EpiInProj {
    static constexpr bool PERM = true;
    const float* inv_rms; const float* inv_rms_mem; const float* cs; const float* b_gate;
    bf16_t *q_s, *k_s, *v_s, *q_d, *k_d, *v_d, *q_i, *k_i, *q_m, *gates, *mk, *mv; float* w_i;
    __device__ __forceinline__ void operator()(const f32x4 (&acc)[2][2][4][2], const pg8::Unit& u, int wr, int wc, int fr, int fq) const {
        if (u.kind == 1) {
            bf16_t* dst = u.pn == 0 ? mk : mv;
#pragma unroll
            for (int ai = 0; ai < 2; ++ai)
#pragma unroll
                for (int m = 0; m < 4; ++m) { const int row = u.pm * 256 + ai * 128 + wr * 64 + m * 16 + fr; const float s = inv_rms_mem[row];
#pragma unroll
                    for (int bj = 0; bj < 2; ++bj) { const f32x4 v0 = acc[ai][bj][m][0] * s, v1 = acc[ai][bj][m][1] * s;
                        u32x4 w; w.x = cvtpk(v0[0], v0[1]); w.y = cvtpk(v0[2], v0[3]); w.z = cvtpk(v1[0], v1[1]); w.w = cvtpk(v1[2], v1[3]);
                        *(u32x4*)(dst + (size_t)row * 256 + bj * 128 + wc * 32 + 8 * fq) = w; } }
            return;
        }
#pragma unroll
        for (int bj = 0; bj < 2; ++bj) {
            const int pos0 = u.pn * 256 + bj * 128 + wc * 32;
            const int p = pos0 + 8 * fq;
            int kind; bf16_t* dst; int ld, sec0; float scl = 1.f;
            if (pos0 < P_KS)        { kind = 0; dst = q_s; ld = 512; sec0 = P_QS; scl = QSCALE; }
            else if (pos0 < P_VS)   { kind = 0; dst = k_s; ld = 128; sec0 = P_KS; }
            else if (pos0 < P_QD)   { kind = 1; dst = v_s; ld = 128; sec0 = P_VS; }
            else if (pos0 < P_KD)   { kind = 0; dst = q_d; ld = 256; sec0 = P_QD; scl = QSCALE; }
            else if (pos0 < P_VD)   { kind = 0; dst = k_d; ld = 64;  sec0 = P_KD; }
            else if (pos0 < P_QI)   { kind = 1; dst = v_d; ld = 64;  sec0 = P_VD; }
            else if (pos0 < P_KI)   { kind = 0; dst = q_i; ld = 256; sec0 = P_QI; }
            else if (pos0 < P_QM)   { kind = 0; dst = k_i; ld = 64;  sec0 = P_KI; }
            else if (pos0 < P_GATE) { kind = 1; dst = q_m; ld = 256; sec0 = P_QM; scl = QSCALE; }
            else if (pos0 < P_WI)   { kind = 2; dst = gates; ld = 3072; sec0 = P_GATE; }
            else                    { kind = 3; dst = nullptr; ld = 0; sec0 = P_WI; }
            const int lp = p - sec0;
            if (kind == 0) {
                const int head = lp >> 6, i0 = (lp & 63) >> 1;
#pragma unroll
                for (int ai = 0; ai < 2; ++ai)
#pragma unroll
                    for (int m = 0; m < 4; ++m) { const int row = u.pm * 256 + ai * 128 + wr * 64 + m * 16 + fr; const float s = inv_rms[row] * scl;
                        const f32x4 v0 = acc[ai][bj][m][0] * s, v1 = acc[ai][bj][m][1] * s;
                        const f32x4 ca = *(const f32x4*)(cs + (size_t)row * 64 + 2 * i0), cb = *(const f32x4*)(cs + (size_t)row * 64 + 2 * i0 + 4);
                        const float a0 = v0[0] * ca[0] - v0[1] * ca[1], b0 = v0[1] * ca[0] + v0[0] * ca[1];
                        const float a1 = v0[2] * ca[2] - v0[3] * ca[3], b1 = v0[3] * ca[2] + v0[2] * ca[3];
                        const float a2 = v1[0] * cb[0] - v1[1] * cb[1], b2 = v1[1] * cb[0] + v1[0] * cb[1];
                        const float a3 = v1[2] * cb[2] - v1[3] * cb[3], b3 = v1[3] * cb[2] + v1[2] * cb[3];
                        bf16_t* o = dst + (size_t)row * ld + head * 64 + i0;
                        u32x2 wa, wb; wa.x = cvtpk(a0, a1); wa.y = cvtpk(a2, a3); wb.x = cvtpk(b0, b1); wb.y = cvtpk(b2, b3);
                        *(u32x2*)o = wa; *(u32x2*)(o + 32) = wb; }
            } else if (kind == 1) {
#pragma unroll
                for (int ai = 0; ai < 2; ++ai)
#pragma unroll
                    for (int m = 0; m < 4; ++m) { const int row = u.pm * 256 + ai * 128 + wr * 64 + m * 16 + fr; const float s = inv_rms[row] * scl;
                        const f32x4 v0 = acc[ai][bj][m][0] * s, v1 = acc[ai][bj][m][1] * s;
                        u32x4 w; w.x = cvtpk(v0[0], v0[1]); w.y = cvtpk(v0[2], v0[3]); w.z = cvtpk(v1[0], v1[1]); w.w = cvtpk(v1[2], v1[3]);
                        *(u32x4*)(dst + (size_t)row * ld + lp) = w; }
            } else if (kind == 2) {
                const f32x4 g0 = *(const f32x4*)(b_gate + lp), g1 = *(const f32x4*)(b_gate + lp + 4);
#pragma unroll
                for (int ai = 0; ai < 2; ++ai)
#pragma unroll
                    for (int m = 0; m < 4; ++m) { const int row = u.pm * 256 + ai * 128 + wr * 64 + m * 16 + fr; const float s = inv_rms[row];
                        const f32x4 v0 = acc[ai][bj][m][0] * s + g0, v1 = acc[ai][bj][m][1] * s + g1;
                        u32x4 w; w.x = cvtpk(sigmoidf_fast(v0[0]), sigmoidf_fast(v0[1])); w.y = cvtpk(sigmoidf_fast(v0[2]), sigmoidf_fast(v0[3]));
                        w.z = cvtpk(sigmoidf_fast(v1[0]), sigmoidf_fast(v1[1])); w.w = cvtpk(sigmoidf_fast(v1[2]), sigmoidf_fast(v1[3]));
                        *(u32x4*)(dst + (size_t)row * ld + lp) = w; }
            } else {
                if (pos0 == P_WI && fq == 0) {
#pragma unroll
                    for (int ai = 0; ai < 2; ++ai)
#pragma unroll
                        for (int m = 0; m < 4; ++m) { const int row = u.pm * 256 + ai * 128 + wr * 64 + m * 16 + fr; const float s = inv_rms[row] * IDX_SCALE;
                            *(f32x4*)(w_i + (size_t)row * 4) = acc[ai][bj][m][0] * s; }
                }
            }
        }
    }
};

struct EpiMerge {
    static constexpr bool PERM = true;
    const bf16_t* gates; bf16_t* merged;
    __device__ __forceinline__ void operator()(const f32x4 (&acc)[2][2][4][2], const pg8::Unit& u, int wr, int wc, int fr, int fq) const {
        const int br = u.kind;
#pragma unroll
        for (int ai = 0; ai < 2; ++ai)
#pragma unroll
            for (int m = 0; m < 4; ++m) { const int row = u.pm * 256 + ai * 128 + wr * 64 + m * 16 + fr;
#pragma unroll
                for (int bj = 0; bj < 2; ++bj) { const int col = u.pn * 256 + bj * 128 + wc * 32 + 8 * fq;
                    const u32x4 g = *(const u32x4*)(gates + (size_t)row * 3072 + br * 1024 + col);
                    f32x4 v0 = acc[ai][bj][m][0], v1 = acc[ai][bj][m][1];
                    v0[0] *= bf_lo(g.x); v0[1] *= bf_hi(g.x); v0[2] *= bf_lo(g.y); v0[3] *= bf_hi(g.y); v1[0] *= bf_lo(g.z); v1[1] *= bf_hi(g.z); v1[2] *= bf_lo(g.w); v1[3] *= bf_hi(g.w);
                    bf16_t* o = merged + (size_t)row * 1024 + col;
                    if (br > 0) { const u32x4 pv = *(const u32x4*)o;
                        v0[0] += bf_lo(pv.x); v0[1] += bf_hi(pv.x); v0[2] += bf_lo(pv.y); v0[3] += bf_hi(pv.y); v1[0] += bf_lo(pv.z); v1[1] += bf_hi(pv.z); v1[2] += bf_lo(pv.w); v1[3] += bf_hi(pv.w); }
                    u32x4 w; w.x = cvtpk(v0[0], v0[1]); w.y = cvtpk(v0[2], v0[3]); w.z = cvtpk(v1[0], v1[1]); w.w = cvtpk(v1[2], v1[3]);
                    *(u32x4*)o = w; } }
    }
};

template <bool WRITE_BF> struct EpiResid {
    static constexpr bool PERM = false;
    const float* base; float* out; bf16_t* outb; float* ssq;
    __device__ __forceinline__ void operator()(const f32x4 (&acc)[2][2][4][2], const pg8::Unit& u, int wr, int wc, int fr, int fq) const {
#pragma unroll
        for (int ai = 0; ai < 2; ++ai)
#pragma unroll
            for (int m = 0; m < 4; ++m) { const int row = u.pm * 256 + ai * 128 + wr * 64 + m * 16 + fr; float q = 0.f;
#pragma unroll
                for (int bj = 0; bj < 2; ++bj)
#pragma unroll
                    for (int n = 0; n < 2; ++n) { const size_t off = (size_t)row * DM + u.pn * 256 + bj * 128 + wc * 32 + n * 16 + 4 * fq;
                        const f32x4 o = *(const f32x4*)(base + off) + acc[ai][bj][m][n];
                        *(f32x4*)(out + off) = o; q += (o[0] * o[0] + o[1] * o[1]) + (o[2] * o[2] + o[3] * o[3]);
                        if (WRITE_BF) { u32x2 w; w.x = cvtpk(o[0], o[1]); w.y = cvtpk(o[2], o[3]); *(u32x2*)(outb + off) = w; } }
                q += __shfl_xor(q, 16); q += __shfl_xor(q, 32);
                if (fq == 0) ssq[(size_t)row * 16 + u.pn * 4 + wc] = q; }
    }
};

struct EpiMlpIn {
    static constexpr bool PERM = true;
    const float* ssq; bf16_t* hid;
    __device__ __forceinline__ void operator()(const f32x4 (&acc)[2][2][4][2], const pg8::Unit& u, int wr, int wc, int fr, int fq) const {
#pragma unroll
        for (int ai = 0; ai < 2; ++ai)
#pragma unroll
            for (int m = 0; m < 4; ++m) { const int row = u.pm * 256 + ai * 128 + wr * 64 + m * 16 + fr;
                const f32x4* sp = (const f32x4*)(ssq + (size_t)row * 16); const f32x4 s0 = sp[0], s1 = sp[1], s2 = sp[2], s3 = sp[3];
                const float tot = ((s0[0] + s0[1]) + (s0[2] + s0[3])) + ((s1[0] + s1[1]) + (s1[2] + s1[3])) + ((s2[0] + s2[1]) + (s2[2] + s2[3])) + ((s3[0] + s3[1]) + (s3[2] + s3[3]));
                const float s = 1.0f / sqrtf(tot * (1.0f / DM) + EPS);
#pragma unroll
                for (int bj = 0; bj < 2; ++bj) { f32x4 v0 = acc[ai][bj][m][0] * s, v1 = acc[ai][bj][m][1] * s;
#pragma unroll
                    for (int e = 0; e < 4; ++e) { const float a = fmaxf(v0[e], 0.f), b = fmaxf(v1[e], 0.f); v0[e] = a * a; v1[e] = b * b; }
                    u32x4 w; w.x = cvtpk(v0[0], v0[1]); w.y = cvtpk(v0[2], v0[3]); w.z = cvtpk(v1[0], v1[1]); w.w = cvtpk(v1[2], v1[3]);
                    *(u32x4*)(hid + (size_t)row * DFF + u.pn * 256 + bj * 128 + wc * 32 + 8 * fq) = w; } }
    }
};

#define XB_TMO      128
#define XB_XCNT(j)  (256  + 64 * (j))
#define XB_XSUB(j)  (1280 + 64 * (j))
#define XB_XGEN(j)  (2304 + 64 * (j))
#define XB_TOP      3328
#define XB_TOPGEN   3392
#define XCD_BAR_WORDS 3456
#define XB_SPIN_CAP (1u << 20)
__device__ __forceinline__ unsigned xb_ld(unsigned* p)              { return __hip_atomic_load(p, __ATOMIC_RELAXED, __HIP_MEMORY_SCOPE_AGENT); }
__device__ __forceinline__ unsigned xb_add(unsigned* p, unsigned v) { return __hip_atomic_fetch_add(p, v, __ATOMIC_RELAXED, __HIP_MEMORY_SCOPE_AGENT); }
__device__ __forceinline__ unsigned xb_xcc_id() { return (unsigned)__builtin_amdgcn_s_getreg((3 << 11) | 20) & 0xFu; }
#define XB_SPIN(cond, bar) do { unsigned _sp = 0; while (cond) { __builtin_amdgcn_s_sleep(1); \
    if ((++_sp & 255u) == 0u) { if (xb_ld(&(bar)[XB_TMO])) break; if (_sp > XB_SPIN_CAP) { atomicAdd(&(bar)[XB_TMO], 1u); break; } } } } while (0)
struct XcdBarrier { unsigned* bar; unsigned x; volatile LAS unsigned* st; };
__device__ __forceinline__ XcdBarrier xcd_barrier_post(unsigned* bar, volatile LAS unsigned* st) {
    XcdBarrier b; b.bar = bar; b.x = xb_xcc_id(); b.st = st;
    if (threadIdx.x == 0) (void)xb_add(&bar[XB_XCNT(b.x)], 1u);
    return b;
}
__device__ __forceinline__ void xcd_barrier_complete(unsigned* bar, unsigned x, unsigned& nloc, unsigned& nx) {
    const unsigned G = gridDim.x * gridDim.y * gridDim.z;
    unsigned sum, cnt, mine, sp = 0u;
    for (;;) {
        sum = 0u; cnt = 0u; mine = 0u;
#pragma unroll
        for (unsigned j = 0; j < 16; ++j) { const unsigned c = xb_ld(&bar[XB_XCNT(j)]); sum += c; cnt += (c > 0u) ? 1u : 0u; mine = (j == x) ? c : mine; }
        if (sum == G) break;
        __builtin_amdgcn_s_sleep(1);
        if ((++sp & 255u) == 0u) { if (xb_ld(&bar[XB_TMO])) break; if (sp > XB_SPIN_CAP) { atomicAdd(&bar[XB_TMO], 1u); break; } }
    }
    nloc = mine > 0u ? mine : 1u; nx = cnt > 0u ? cnt : 1u;
}
__device__ __forceinline__ void xcd_barrier(const XcdBarrier& b) {
    asm volatile("s_waitcnt vmcnt(0)" ::: "memory");
    __syncthreads();
    if (threadIdx.x == 0) {
        unsigned* bar = b.bar;
        __builtin_amdgcn_s_waitcnt(0);
        unsigned nloc = b.st[0], nx = b.st[1];
        if (nloc == 0u) { xcd_barrier_complete(bar, b.x, nloc, nx); b.st[0] = nloc; b.st[1] = nx; }
        const unsigned old = xb_add(&bar[XB_XSUB(b.x)], 1u);
        const unsigned gen = old / nloc;
        if (old + 1u == (gen + 1u) * nloc) {
            __builtin_amdgcn_fence(__ATOMIC_RELEASE, "agent");
            asm volatile("s_waitcnt vmcnt(0)" ::: "memory");
            const unsigned og = xb_add(&bar[XB_TOP], 1u);
            const unsigned tg = og / nx;
            if (og + 1u == (tg + 1u) * nx) xb_add(&bar[XB_TOPGEN], 1u);
            else XB_SPIN(xb_ld(&bar[XB_TOPGEN]) == tg, bar);
            __builtin_amdgcn_fence(__ATOMIC_ACQUIRE, "agent");
            xb_add(&bar[XB_XGEN(b.x)], 1u);
            asm volatile("s_waitcnt vmcnt(0)" ::: "memory");
        } else {
            XB_SPIN(xb_ld(&bar[XB_XGEN(b.x)]) == gen, bar);
            __builtin_amdgcn_fence(__ATOMIC_ACQUIRE, "agent");
            asm volatile("s_waitcnt vmcnt(0)" ::: "memory");
        }
    }
    __syncthreads();
}

struct Frame {
    LAS unsigned char* lds;
    volatile LAS unsigned* MISC;
    unsigned* ctl;
    int tid, lane, wave, vcu, G;
    unsigned char* ws;
    const float *x, *mem; const int* positions; const float *g_mix, *w_in, *b_gate, *sinks, *g_mem, *w_mem_kv, *w_proj_swa, *w_proj_dsa, *w_proj_mem, *w_out, *g_mlp, *w_mlp_in, *w_mlp_out, *g_final;
    float* out;
};
#define WSP(T_, off) ((T_*)(F.ws + (off)))

__device__ __forceinline__ int rope_src(int base, int lp) { return base + (lp & ~63) + ((lp & 1) ? 32 + ((lp & 63) >> 1) : ((lp & 63) >> 1)); }
__device__ __forceinline__ int win_src(int pos) {
    if (pos < P_KS) return rope_src(0, pos);
    if (pos < P_VS) return rope_src(512, pos - P_KS);
    if (pos < P_QD) return pos;
    if (pos < P_KD) return rope_src(768, pos - P_QD);
    if (pos < P_VD) return rope_src(1024, pos - P_KD);
    if (pos < P_QI) return pos;
    if (pos < P_KI) return rope_src(1152, pos - P_QI);
    if (pos < P_QM) return rope_src(1408, pos - P_KI);
    if (pos < P_GATE) return 1476 + (pos - P_QM);
    if (pos < P_WI) return 1732 + (pos - P_GATE);
    if (pos < P_END) return 1472 + (pos - P_WI);
    return -1;
}
template <bool MAP> __device__ __forceinline__ void p0_transpose_item(const float* W, int ldw, int k0, int n0, const float* gk, bf16_t* WT, int ldwt, LAS float* scr, int lane) {
    const int j = lane & 31; const int sc = MAP ? win_src(n0 + j) : n0 + j;
#pragma unroll 8
    for (int i = 0; i < 32; ++i) { const int kk = 2 * i + (lane >> 5); float v = sc >= 0 ? W[(size_t)(k0 + kk) * ldw + sc] : 0.f; if (gk) v *= gk[k0 + kk]; scr[kk * 33 + j] = v; }
    LDS_WAIT(); asm volatile("" ::: "memory");
    const int c = lane & 7;
#pragma unroll
    for (int jj = 0; jj < 4; ++jj) { const int n = (lane >> 3) + 8 * jj; const LAS float* s = scr + (8 * c) * 33 + n;
        u32x4 o; o.x = cvtpk(s[0 * 33], s[1 * 33]); o.y = cvtpk(s[2 * 33], s[3 * 33]); o.z = cvtpk(s[4 * 33], s[5 * 33]); o.w = cvtpk(s[6 * 33], s[7 * 33]);
        *(u32x4*)(WT + (size_t)(n0 + n) * ldwt + k0 + 8 * c) = o; }
    LDS_WAIT(); asm volatile("" ::: "memory");
}
__device__ __forceinline__ void row_to_bf16(const float* xrow, bf16_t* orow, float* inv, int lane) {
    const f32x4* xr = (const f32x4*)xrow + lane;
    f32x4 v[4]; float s = 0.f;
#pragma unroll
    for (int j = 0; j < 4; ++j) { v[j] = xr[64 * j]; s += (v[j][0] * v[j][0] + v[j][1] * v[j][1]) + (v[j][2] * v[j][2] + v[j][3] * v[j][3]); }
    s = wave_sum(s);
    if (lane == 0) *inv = 1.0f / sqrtf(s * (1.0f / DM) + EPS);
    u32x2* o8 = (u32x2*)orow + lane;
#pragma unroll
    for (int j = 0; j < 4; ++j) { u32x2 w; w.x = cvtpk(v[j][0], v[j][1]); w.y = cvtpk(v[j][2], v[j][3]); o8[64 * j] = w; }
}
__device__ __forceinline__ void p0_prologue(Frame& F) {
    LAS float* scr = (LAS float*)(F.lds + RING_OFF + F.wave * 16384);
    const int gw = F.vcu * NWAVES + F.wave, NGW = F.G * NWAVES;
    constexpr int I_IN = 16 * (NPOS / 32), I_MEM = 16 * 16, I_PS = 8 * 32, I_PD = 4 * 32, I_PM = 4 * 32, I_OUT = 16 * 32, I_1 = 16 * 128, I_2 = 64 * 32;
    constexpr int NITEMS = I_IN + I_MEM + I_PS + I_PD + I_PM + I_OUT + I_1 + I_2;
    for (int it = gw; it < NITEMS; it += NGW) {
        int r = it;
        if (r < I_IN) { const int nb = NPOS / 32; p0_transpose_item<true>(F.w_in, DIN, 64 * (r / nb), 32 * (r % nb), F.g_mix, WSP(bf16_t, WS_WIN), DM, scr, F.lane); continue; } r -= I_IN;
        if (r < I_MEM) { p0_transpose_item<false>(F.w_mem_kv, 512, 64 * (r / 16), 32 * (r % 16), F.g_mem, WSP(bf16_t, WS_WMEM), DM, scr, F.lane); continue; } r -= I_MEM;
        if (r < I_PS) { p0_transpose_item<false>(F.w_proj_swa, DM, 64 * (r / 32), 32 * (r % 32), nullptr, WSP(bf16_t, WS_WPROJ), DM, scr, F.lane); continue; } r -= I_PS;
        if (r < I_PD) { p0_transpose_item<false>(F.w_proj_dsa, DM, 64 * (r / 32), 32 * (r % 32), nullptr, WSP(bf16_t, WS_WPROJ) + 512, DM, scr, F.lane); continue; } r -= I_PD;
        if (r < I_PM) { p0_transpose_item<false>(F.w_proj_mem, DM, 64 * (r / 32), 32 * (r % 32), nullptr, WSP(bf16_t, WS_WPROJ) + 768, DM, scr, F.lane); continue; } r -= I_PM;
        if (r < I_OUT) { p0_transpose_item<false>(F.w_out, DM, 64 * (r / 32), 32 * (r % 32), nullptr, WSP(bf16_t, WS_WOUT), DM, scr, F.lane); continue; } r -= I_OUT;
        if (r < I_1) { p0_transpose_item<false>(F.w_mlp_in, DFF, 64 * (r / 128), 32 * (r % 128), F.g_mlp, WSP(bf16_t, WS_W1), DM, scr, F.lane); continue; } r -= I_1;
        p0_transpose_item<false>(F.w_mlp_out, DM, 64 * (r / 32), 32 * (r % 32), nullptr, WSP(bf16_t, WS_W2), DFF, scr, F.lane);
    }
    for (int m = gw; m < T; m += NGW) row_to_bf16(F.x + (size_t)m * DM, WSP(bf16_t, WS_XB) + (size_t)m * DM, WSP(float, WS_INVRMS0) + m, F.lane);
    for (int m = gw; m < MROWS; m += NGW) row_to_bf16(F.mem + (size_t)m * DM, WSP(bf16_t, WS_MEMB) + (size_t)m * DM, WSP(float, WS_INVRMSM) + m, F.lane);
    { const int gt = gw * 64 + F.lane, NGT = NGW * 64; const int i = gt & 31;
      const float invf = (float)exp2((double)(-i) * (13.287712379549449 / 32.0));
      float* cs = WSP(float, WS_CS);
      for (int idx = gt; idx < T * 32; idx += NGT) { const float ang = (float)F.positions[idx >> 5] * invf; float s, c; sincosf(ang, &s, &c); *(f32x2*)(cs + (size_t)idx * 2) = (f32x2){c, s}; } }
}

__device__ __forceinline__ void p7_final_norm(Frame& F) {
    const int gw = F.vcu * NWAVES + F.wave, NGW = F.G * NWAVES;
    const float* ssq = WSP(float, WS_SSQ2);
    f32x4 g[4];
#pragma unroll
    for (int j = 0; j < 4; ++j) g[j] = ((const f32x4*)F.g_final)[F.lane + 64 * j];
    for (int m = gw; m < T; m += NGW) {
        float p = F.lane < 16 ? ssq[(size_t)m * 16 + F.lane] : 0.f;
        p = wave_sum(p);
        const float s = 1.0f / sqrtf(p * (1.0f / DM) + EPS);
        f32x4* o = (f32x4*)(F.out + (size_t)m * DM) + F.lane;
#pragma unroll
        for (int j = 0; j < 4; ++j) { const f32x4 v = o[64 * j]; o[64 * j] = v * s * g[j]; }
    }
}

__device__ __forceinline__ int crow(int r, int hi) { return (r & 3) + 8 * (r >> 2) + 4 * hi; }
__device__ __forceinline__ float xor32f(float v) { return __shfl_xor(v, 32); }

template <int MODE> __device__ __forceinline__ void attn32(const bf16_t* Qp, int ldq, const bf16_t* Kp, int ldk, const bf16_t* Vp, int ldv, int jlo, int jhi, int qpos0, float sink_l2, bf16_t* Op, int ldo, int lane) {
    const int r32 = lane & 31, hi = lane >> 5;
    bf16x8 qf[4];
#pragma unroll
    for (int s = 0; s < 4; ++s) qf[s] = *(const bf16x8*)(Qp + (size_t)r32 * ldq + 16 * s + 8 * hi);
    float m = MODE == 1 ? sink_l2 : -INFINITY, l = MODE == 1 ? 1.0f : 0.0f;
    f32x16 o0 = {}, o1 = {};
    const int qp = qpos0 + r32;
    for (int j = jlo; j < jhi; ++j) {
        const bf16_t* kr = Kp + (size_t)(32 * j + r32) * ldk + 8 * hi;
        f32x16 sc = {};
#pragma unroll
        for (int s = 0; s < 4; ++s) { const bf16x8 kf = *(const bf16x8*)(kr + 16 * s); sc = __builtin_amdgcn_mfma_f32_32x32x16_bf16(kf, qf[s], sc, 0, 0, 0); }
        if (MODE == 1) { const int dq = qp - 32 * j - 4 * hi;
#pragma unroll
            for (int i = 0; i < 16; ++i) { const int dk = (i & 3) + 8 * (i >> 2); if (dk > dq || dq - dk >= 128) sc[i] = -INFINITY; }
        }
        float tm = sc[0];
#pragma unroll
        for (int i = 1; i < 16; ++i) tm = fmaxf(tm, sc[i]);
        tm = fmaxf(tm, xor32f(tm));
        const float mn = fmaxf(m, tm);
        const float alpha = (mn == -INFINITY) ? 1.0f : __builtin_amdgcn_exp2f(m - mn);
        const float msub = (mn == -INFINITY) ? 0.0f : mn;
        float rs = 0.f;
#pragma unroll
        for (int i = 0; i < 16; ++i) { sc[i] = __builtin_amdgcn_exp2f(sc[i] - msub); rs += sc[i]; }
        rs += xor32f(rs);
        l = l * alpha + rs; m = mn;
#pragma unroll
        for (int i = 0; i < 16; ++i) { o0[i] *= alpha; o1[i] *= alpha; }
        u32x4 pw[2];
#pragma unroll
        for (int s = 0; s < 2; ++s) { pw[s].x = cvtpk(sc[8 * s + 0], sc[8 * s + 1]); pw[s].y = cvtpk(sc[8 * s + 2], sc[8 * s + 3]); pw[s].z = cvtpk(sc[8 * s + 4], sc[8 * s + 5]); pw[s].w = cvtpk(sc[8 * s + 6], sc[8 * s + 7]); }
#pragma unroll
        for (int s = 0; s < 2; ++s) {
            bf16x8 a0, a1;
#pragma unroll
            for (int jj = 0; jj < 8; ++jj) { const bf16_t* vr = Vp + (size_t)(32 * j + 16 * s + 8 * (jj >> 2) + 4 * hi + (jj & 3)) * ldv + r32; a0[jj] = (short)vr[0]; a1[jj] = (short)vr[32]; }
            const bf16x8 pb = __builtin_bit_cast(bf16x8, pw[s]);
            o0 = __builtin_amdgcn_mfma_f32_32x32x16_bf16(a0, pb, o0, 0, 0, 0);
            o1 = __builtin_amdgcn_mfma_f32_32x32x16_bf16(a1, pb, o1, 0, 0, 0);
        }
    }
    const float rl = 1.0f / l;
    bf16_t* orow = Op + (size_t)r32 * ldo;
#pragma unroll
    for (int g = 0; g < 4; ++g) {
        u32x2 w0, w1; w0.x = cvtpk(o0[4 * g] * rl, o0[4 * g + 1] * rl); w0.y = cvtpk(o0[4 * g + 2] * rl, o0[4 * g + 3] * rl);
        w1.x = cvtpk(o1[4 * g] * rl, o1[4 * g + 1] * rl); w1.y = cvtpk(o1[4 * g + 2] * rl, o1[4 * g + 3] * rl);
        *(u32x2*)(orow + 8 * g + 4 * hi) = w0; *(u32x2*)(orow + 32 + 8 * g + 4 * hi) = w1;
    }
}

__device__ __forceinline__ void swa_item(Frame& F, int b, int qb) {
    const int h = F.wave, kvh = h >> 2;
    const float sink = F.sinks[h] * LOG2E;
    const bf16_t* Kp = WSP(const bf16_t, WS_KS) + (size_t)b * SEQ * 128 + kvh * 64;
    const bf16_t* Vp = WSP(const bf16_t, WS_VS) + (size_t)b * SEQ * 128 + kvh * 64;
    for (int sub = 0; sub < 4; ++sub) {
        const int q0 = qb * 128 + 32 * sub; const int jhi = q0 / 32 + 1; int jlo = jhi - 5; if (jlo < 0) jlo = 0;
        attn32<1>(WSP(const bf16_t, WS_QS) + ((size_t)b * SEQ + q0) * 512 + h * 64, 512, Kp, 128, Vp, 128, jlo, jhi, q0, sink, WSP(bf16_t, WS_OCAT) + ((size_t)b * SEQ + q0) * DM + h * 64, DM, F.lane);
    }
}
__device__ __forceinline__ void mem_item(Frame& F, int b, int qb) {
    const int h = F.wave & 3, half = F.wave >> 2;
    const bf16_t* Kp = WSP(const bf16_t, WS_MK) + (size_t)b * MEMLEN * 256 + h * 64;
    const bf16_t* Vp = WSP(const bf16_t, WS_MV) + (size_t)b * MEMLEN * 256 + h * 64;
    for (int sub = 0; sub < 2; ++sub) {
        const int q0 = qb * 128 + 64 * half + 32 * sub;
        attn32<0>(WSP(const bf16_t, WS_QM) + ((size_t)b * SEQ + q0) * 256 + h * 64, 256, Kp, 256, Vp, 256, 0, MEMLEN / 32, 0, 0.f, WSP(bf16_t, WS_OCAT) + ((size_t)b * SEQ + q0) * DM + 768 + h * 64, DM, F.lane);
    }
}


constexpr int DSA_CAP = 512;
constexpr int MAXLD = 1026;
constexpr int CKLD = 513, CILD = 514;
constexpr int DL_MAX = 0;
constexpr int DL_CKEY = 0;
constexpr int DL_CIDX = 65664;
constexpr int DL_VS = 0;
constexpr int DL_CNT = 98560;
constexpr int DL_HIST = 99584;
constexpr int DL_SEL = 107776;
typedef short v4i16_t __attribute__((ext_vector_type(4)));
__device__ __forceinline__ unsigned fkey(float f) { const unsigned u = __float_as_uint(f); return (u & 0x80000000u) ? ~u : (u | 0x80000000u); }
__device__ __forceinline__ float fkey_inv(unsigned k) { return __uint_as_float((k & 0x80000000u) ? (k & 0x7fffffffu) : ~k); }
__device__ __forceinline__ void glds16(const void* gsrc, unsigned lds_dst) { unsigned keep;
    asm volatile("s_mov_b32 %0, m0\n\ts_mov_b32 m0, %2\n\ts_nop 0\n\tglobal_load_lds_dwordx4 %1, off\n\ts_mov_b32 m0, %0" : "=&s"(keep) : "v"(gsrc), "s"(lds_dst) : "memory"); }

template <int NV, int ROUNDS> __device__ __forceinline__ unsigned radix_kth(const unsigned (&v)[NV], int count, LAS unsigned* hist, int k, int lane, int& k_out, int& ceq_out) {
    unsigned prefix = 0u; int ceq = 0;
#pragma unroll
    for (int r = ROUNDS - 1; r >= 0; --r) {
        const int shift = 8 * r;
        *(LAS u32x4*)(hist + 4 * lane) = (u32x4){0u, 0u, 0u, 0u};
        LDS_WAIT();
#pragma unroll
        for (int i = 0; i < NV; ++i) { const bool ok = (lane + 64 * i < count) && (r == ROUNDS - 1 || (v[i] >> (shift + 8)) == (prefix >> (shift + 8)));
            if (ok) __hip_atomic_fetch_add(hist + ((v[i] >> shift) & 255u), 1u, __ATOMIC_RELAXED, __HIP_MEMORY_SCOPE_WORKGROUP); }
        LDS_WAIT();
        const u32x4 h = *(const LAS u32x4*)(hist + 4 * lane);
        const unsigned s = (h.x + h.y) + (h.z + h.w);
        unsigned Tl = s;
#pragma unroll
        for (int o = 1; o < 64; o <<= 1) { const unsigned t = __shfl_down(Tl, o); if (lane + o < 64) Tl += t; }
        const unsigned long long bal = __ballot(Tl >= (unsigned)k);
        const int ls = bal ? 63 - __clzll(bal) : 0;
        const unsigned above = Tl - s, c3 = above + h.w, c2 = c3 + h.z, c1 = c2 + h.y;
        unsigned bin, kk, cb;
        if (c3 >= (unsigned)k) { bin = 3; kk = k - above; cb = h.w; } else if (c2 >= (unsigned)k) { bin = 2; kk = k - c3; cb = h.z; } else if (c1 >= (unsigned)k) { bin = 1; kk = k - c2; cb = h.y; } else { bin = 0; kk = k - c1; cb = h.x; }
        const unsigned digit = (unsigned)__builtin_amdgcn_readlane((int)(bin + 4u * lane), ls);
        k = __builtin_amdgcn_readlane((int)kk, ls); ceq = __builtin_amdgcn_readlane((int)cb, ls);
        prefix |= digit << shift;
    }
    k_out = k; ceq_out = ceq; return prefix;
}

__device__ __forceinline__ void dsa_item(Frame& F, int b, int t0) {
    const int lane = F.lane, wid = F.wave, r32 = lane & 31, hi = lane >> 5;
    LAS unsigned short* maxbuf = (LAS unsigned short*)(F.lds + DL_MAX);
    LAS unsigned* ckey = (LAS unsigned*)(F.lds + DL_CKEY);
    LAS unsigned short* cidx = (LAS unsigned short*)(F.lds + DL_CIDX);
    LAS unsigned* ccnt = (LAS unsigned*)(F.lds + DL_CNT);
    LAS unsigned* ctau = ccnt + 32;
    LAS unsigned* hist = (LAS unsigned*)(F.lds + DL_HIST) + wid * 256;
    LAS unsigned short* sel = (LAS unsigned short*)(F.lds + DL_SEL);
    const size_t rowb = (size_t)b * SEQ;
    unsigned char* wsl = F.ws; asm volatile("" : "+s"(wsl));
#define WSL(T_, off) ((T_*)(wsl + (off)))
    __syncthreads();
#ifndef REP_SEL
#define REP_SEL 1
#endif
#ifndef REP_GATHER
#define REP_GATHER 1
#endif
    for (int rep_ = 0; rep_ < REP_SEL; ++rep_) {
    if (rep_) __syncthreads();
    if (t0 >= TOPK) {
        const int nkt = t0 / 32 + 1, nmax = t0 + 32;
        int lg = 0; while ((1024 << lg) < nmax) ++lg;
        const int npl = 16 >> lg;
        bf16x8 qf[4][4]; float wq[4];
        { const bf16_t* qrow = WSL(const bf16_t, WS_QI) + (rowb + t0 + r32) * 256 + 8 * hi;
#pragma unroll
          for (int h = 0; h < 4; ++h)
#pragma unroll
              for (int s = 0; s < 4; ++s) qf[h][s] = *(const bf16x8*)(qrow + h * 64 + 16 * s);
          const f32x4 w4 = *(const f32x4*)(WSL(const float, WS_WI) + (rowb + t0 + r32) * 4); wq[0] = w4[0]; wq[1] = w4[1]; wq[2] = w4[2]; wq[3] = w4[3]; }
        if (F.tid < 32) ccnt[F.tid] = 0u;
        const bf16_t* kbase = WSL(const bf16_t, WS_KI) + (rowb + r32) * 64 + 8 * hi;
        float thrf = 0.f;
        for (int pass = 0; pass < 2; ++pass) {
            if (pass == 1) thrf = fkey_inv(ctau[r32] << 16);
            bf16x8 kn[4];
            if (wid < nkt) {
#pragma unroll
                for (int s = 0; s < 4; ++s) kn[s] = *(const bf16x8*)(kbase + (size_t)(32 * wid) * 64 + 16 * s);
            }
            for (int j = wid; j < nkt; j += NWAVES) {
                bf16x8 kf[4];
#pragma unroll
                for (int s = 0; s < 4; ++s) kf[s] = kn[s];
                if (j + NWAVES < nkt) {
#pragma unroll
                    for (int s = 0; s < 4; ++s) kn[s] = *(const bf16x8*)(kbase + (size_t)(32 * (j + NWAVES)) * 64 + 16 * s);
                }
                float sc[16];
                {
                    f32x16 da = {}, db = {};
#pragma unroll
                    for (int s = 0; s < 4; ++s) da = __builtin_amdgcn_mfma_f32_32x32x16_bf16(kf[s], qf[0][s], da, 0, 0, 0);
#pragma unroll
                    for (int s = 0; s < 4; ++s) db = __builtin_amdgcn_mfma_f32_32x32x16_bf16(kf[s], qf[1][s], db, 0, 0, 0);
#pragma unroll
                    for (int i = 0; i < 16; ++i) { const int di = __float_as_int(da[i]); sc[i] = __int_as_float(di > 0 ? di : 0) * wq[0]; }
                    da = (f32x16){};
#pragma unroll
                    for (int s = 0; s < 4; ++s) da = __builtin_amdgcn_mfma_f32_32x32x16_bf16(kf[s], qf[2][s], da, 0, 0, 0);
#pragma unroll
                    for (int i = 0; i < 16; ++i) { const int di = __float_as_int(db[i]); sc[i] = fmaf(__int_as_float(di > 0 ? di : 0), wq[1], sc[i]); }
                    db = (f32x16){};
#pragma unroll
                    for (int s = 0; s < 4; ++s) db = __builtin_amdgcn_mfma_f32_32x32x16_bf16(kf[s], qf[3][s], db, 0, 0, 0);
#pragma unroll
                    for (int i = 0; i < 16; ++i) { const int di = __float_as_int(da[i]); sc[i] = fmaf(__int_as_float(di > 0 ? di : 0), wq[2], sc[i]); }
#pragma unroll
                    for (int i = 0; i < 16; ++i) { const int di = __float_as_int(db[i]); sc[i] = fmaf(__int_as_float(di > 0 ? di : 0), wq[3], sc[i]); }
                }
                if (j == nkt - 1) { const int dlim = r32 - 4 * hi;
#pragma unroll
                    for (int i = 0; i < 16; ++i) if ((i & 3) + 8 * (i >> 2) > dlim) sc[i] = -INFINITY;
                }
                if (pass == 0) {
                    LAS unsigned short* mb = maxbuf + r32 * MAXLD + (j * 2 + hi) * npl;
                    if (lg == 0) {
#pragma unroll
                        for (int i = 0; i < 16; ++i) mb[i] = (unsigned short)(fkey(sc[i]) >> 16);
                    } else {
                        float m2[8];
#pragma unroll
                        for (int i = 0; i < 8; ++i) m2[i] = fmaxf(sc[2 * i], sc[2 * i + 1]);
                        if (lg == 1) {
#pragma unroll
                            for (int i = 0; i < 8; ++i) mb[i] = (unsigned short)(fkey(m2[i]) >> 16);
                        } else if (lg == 2) {
#pragma unroll
                            for (int i = 0; i < 4; ++i) mb[i] = (unsigned short)(fkey(fmaxf(m2[2 * i], m2[2 * i + 1])) >> 16);
                        } else {
                            mb[0] = (unsigned short)(fkey(fmaxf(fmaxf(m2[0], m2[1]), fmaxf(m2[2], m2[3]))) >> 16);
                            mb[1] = (unsigned short)(fkey(fmaxf(fmaxf(m2[4], m2[5]), fmaxf(m2[6], m2[7]))) >> 16);
                        }
                    }
                } else {
                    int cntl = 0;
#pragma unroll
                    for (int i = 0; i < 16; ++i) cntl += (sc[i] >= thrf) ? 1 : 0;
                    if (__ballot(cntl > 0)) {
                        unsigned slot = 0u;
                        if (cntl > 0) slot = __hip_atomic_fetch_add(ccnt + r32, (unsigned)cntl, __ATOMIC_RELAXED, __HIP_MEMORY_SCOPE_WORKGROUP);
                        LAS unsigned* ck = ckey + r32 * CKLD; LAS unsigned short* ci = cidx + r32 * CILD; const int ib = 32 * j + 4 * hi;
#pragma unroll
                        for (int i = 0; i < 16; ++i) {
                            if (sc[i] >= thrf) { const unsigned sl = slot < (unsigned)(DSA_CAP - 1) ? slot : (unsigned)(DSA_CAP - 1);
                                ck[sl] = fkey(sc[i]); ci[sl] = (unsigned short)(ib + ((i & 3) + 8 * (i >> 2))); ++slot; }
                        }
                    }
                }
            }
            __syncthreads();
            if (pass == 0) {
                const int G = nmax >> lg;
                for (int jq = 0; jq < 4; ++jq) { const int q = wid * 4 + jq;
                    unsigned v[16];
#pragma unroll
                    for (int i = 0; i < 16; ++i) { const int e = lane + 64 * i; v[i] = e < G ? (unsigned)maxbuf[q * MAXLD + e] : 0u; }
                    int ko, ce; const unsigned tau = radix_kth<16, 2>(v, G, hist, TOPK, lane, ko, ce);
                    if (lane == 0) ctau[q] = tau;
                }
                __syncthreads();
            }
        }
        for (int jq = 0; jq < 4; ++jq) { const int q = wid * 4 + jq;
            int c = (int)ccnt[q]; if (c > DSA_CAP) c = DSA_CAP;
            unsigned kv[8], ix[8];
#pragma unroll
            for (int i = 0; i < 8; ++i) { const int e = lane + 64 * i; kv[i] = e < c ? ckey[q * CKLD + e] : 0u; ix[i] = e < c ? (unsigned)cidx[q * CILD + e] : 0xffffu; }
            int k, ceq; const unsigned thr = radix_kth<8, 4>(kv, c, hist, TOPK, lane, k, ceq);
            unsigned ti = 0xffffu;
            if (ceq > k) {
                unsigned pi = 0u; int kk = k;
                for (int bit = 15; bit >= 0; --bit) { const unsigned test = pi >> bit; int cnt = 0;
#pragma unroll
                    for (int i = 0; i < 8; ++i) cnt += __popcll(__ballot(kv[i] == thr && (ix[i] >> bit) == test));
                    if (cnt < kk) { kk -= cnt; pi |= (1u << bit); } }
                ti = pi;
            }
            *(LAS u32x4*)(hist + 4 * lane) = (u32x4){0u, 0u, 0u, 0u};
            LDS_WAIT();
#pragma unroll
            for (int i = 0; i < 8; ++i) if (kv[i] > thr || (kv[i] == thr && ix[i] <= ti)) __hip_atomic_fetch_or(hist + (ix[i] >> 5), 1u << (ix[i] & 31), __ATOMIC_RELAXED, __HIP_MEMORY_SCOPE_WORKGROUP);
            LDS_WAIT();
            const u32x4 w4 = *(const LAS u32x4*)(hist + 4 * lane);
            const unsigned w[4] = {w4.x, w4.y, w4.z, w4.w};
            const int n = (__popc(w[0]) + __popc(w[1])) + (__popc(w[2]) + __popc(w[3]));
            int pos = n;
#pragma unroll
            for (int o = 1; o < 64; o <<= 1) { const int t = __shfl_up(pos, o); if (lane >= o) pos += t; }
            pos -= n;
#pragma unroll
            for (int i = 0; i < 4; ++i) { unsigned ww = w[i]; while (ww) { const int bpos = __ffs((int)ww) - 1; ww &= ww - 1; if (pos < TOPK) sel[q * 256 + pos] = (unsigned short)(lane * 128 + i * 32 + bpos); ++pos; } }
            LDS_WAIT();
        }
    } else {
        for (int e = F.tid; e < 32 * 256; e += NWAVES * 64) sel[e] = (unsigned short)(e & 255);
    }
    }
    __syncthreads();
    const int c16 = lane & 15, g4 = lane >> 4;
    const bf16_t* Kd = WSL(const bf16_t, WS_KD) + rowb * 64;
    const bf16_t* Vd = WSL(const bf16_t, WS_VD) + rowb * 64;
    const unsigned vs_base = (unsigned)(uintptr_t)(F.lds + DL_VS) + (unsigned)wid * 12288u;
    const LAS unsigned char* vs_ptr = F.lds + DL_VS + wid * 12288;
    const int tr_off = (4 * g4 + (c16 >> 2)) * 128 + (c16 & 3) * 8;
    for (int rep_ = 0; rep_ < REP_GATHER; ++rep_)
    for (int jq = 0; jq < 4; ++jq) { const int q = wid * 4 + jq, t = t0 + q; const int nsel = t + 1 < TOPK ? t + 1 : TOPK;
        const LAS unsigned short* selq = sel + q * 256;
#define DSA_VDMA(u) do { _Pragma("unroll") for (int p_ = 0; p_ < 4; ++p_) { const int kidx_ = (int)selq[32 * (u) + 8 * p_ + (lane >> 3)]; \
            glds16(Vd + (size_t)kidx_ * 64 + (lane & 7) * 8, (unsigned)__builtin_amdgcn_readfirstlane(vs_base + (unsigned)(((u) % 3) * 4096 + p_ * 1024))); } } while (0)
        asm volatile("s_waitcnt lgkmcnt(0)" ::: "memory");
        DSA_VDMA(0); DSA_VDMA(1); DSA_VDMA(2);
        bf16x8 qf[2];
        { const bf16_t* qrow = WSL(const bf16_t, WS_QD) + (rowb + t) * 256 + (c16 & 3) * 64 + 8 * g4;
          qf[0] = *(const bf16x8*)qrow; qf[1] = *(const bf16x8*)(qrow + 32);
          if (c16 >= 4) { qf[0] = (bf16x8){0, 0, 0, 0, 0, 0, 0, 0}; qf[1] = qf[0]; } }
        bf16x8 kf[4][2], kn[4][2];
#define DSA_KLOAD(dst, ch_) do { _Pragma("unroll") for (int kb = 0; kb < 4; ++kb) { const int kidx = (int)selq[64 * (ch_) + 16 * kb + c16]; const bf16_t* kr = Kd + (size_t)kidx * 64 + 8 * g4; dst[kb][0] = *(const bf16x8*)kr; dst[kb][1] = *(const bf16x8*)(kr + 32); } } while (0)
        DSA_KLOAD(kf, 0);
        float mrun = -INFINITY, l = 0.f;
        f32x4 O[4];
#pragma unroll
        for (int db = 0; db < 4; ++db) O[db] = (f32x4){0.f, 0.f, 0.f, 0.f};
#pragma unroll
        for (int ch = 0; ch < 4; ++ch) {
            if (ch + 1 < 4) DSA_KLOAD(kn, ch + 1);
            asm volatile("" ::: "memory");
            f32x4 S[4];
#pragma unroll
            for (int kb = 0; kb < 4; ++kb) { f32x4 a = {0.f, 0.f, 0.f, 0.f};
                a = __builtin_amdgcn_mfma_f32_16x16x32_bf16(kf[kb][0], qf[0], a, 0, 0, 0); a = __builtin_amdgcn_mfma_f32_16x16x32_bf16(kf[kb][1], qf[1], a, 0, 0, 0); S[kb] = a; }
            if (nsel < TOPK) { const int nlim = nsel - 4 * g4;
#pragma unroll
                for (int kb = 0; kb < 4; ++kb)
#pragma unroll
                    for (int r = 0; r < 4; ++r) if (64 * ch + 16 * kb + r >= nlim) S[kb][r] = -INFINITY;
            }
            float cm = fmaxf(fmaxf(S[0][0], S[0][1]), fmaxf(S[0][2], S[0][3]));
#pragma unroll
            for (int kb = 1; kb < 4; ++kb) cm = fmaxf(cm, fmaxf(fmaxf(S[kb][0], S[kb][1]), fmaxf(S[kb][2], S[kb][3])));
            cm = fmaxf(cm, __shfl_xor(cm, 16)); cm = fmaxf(cm, __shfl_xor(cm, 32));
            const float mn = fmaxf(mrun, cm);
            const float alpha = __builtin_amdgcn_exp2f(mrun - mn);
            mrun = mn;
            float ps = 0.f;
#pragma unroll
            for (int kb = 0; kb < 4; ++kb)
#pragma unroll
                for (int r = 0; r < 4; ++r) { S[kb][r] = __builtin_amdgcn_exp2f(S[kb][r] - mn); ps += S[kb][r]; }
            l = l * alpha + ps;
#pragma unroll
            for (int db = 0; db < 4; ++db) O[db] = O[db] * alpha;
#pragma unroll
            for (int u2 = 0; u2 < 2; ++u2) { const int u = 2 * ch + u2;
                u32x4 pw; pw.x = cvtpk(S[2 * u2][0], S[2 * u2][1]); pw.y = cvtpk(S[2 * u2][2], S[2 * u2][3]); pw.z = cvtpk(S[2 * u2 + 1][0], S[2 * u2 + 1][1]); pw.w = cvtpk(S[2 * u2 + 1][2], S[2 * u2 + 1][3]);
                const bf16x8 pb = __builtin_bit_cast(bf16x8, pw);
                if (u == 3) asm volatile("s_waitcnt vmcnt(12)" ::: "memory");
                else if (u == 5) asm volatile("s_waitcnt vmcnt(16)" ::: "memory");
                else if (u == 6) asm volatile("s_waitcnt vmcnt(12)" ::: "memory");
                else if (u == 7) asm volatile("s_waitcnt vmcnt(0)" ::: "memory");
                const LAS unsigned char* sp = vs_ptr + (u % 3) * 4096 + tr_off;
#pragma unroll
                for (int db = 0; db < 4; ++db) {
                    const v4i16_t lo = __builtin_amdgcn_ds_read_tr16_b64_v4i16((LAS v4i16_t*)(sp + db * 32));
                    const v4i16_t hv = __builtin_amdgcn_ds_read_tr16_b64_v4i16((LAS v4i16_t*)(sp + db * 32 + 2048));
                    const bf16x8 va = (bf16x8){lo[0], lo[1], lo[2], lo[3], hv[0], hv[1], hv[2], hv[3]};
                    O[db] = __builtin_amdgcn_mfma_f32_16x16x32_bf16(va, pb, O[db], 0, 0, 0);
                }
                if (u + 3 < 8) { asm volatile("s_waitcnt lgkmcnt(0)" ::: "memory"); DSA_VDMA(u + 3); }
            }
#pragma unroll
            for (int kb = 0; kb < 4; ++kb) { kf[kb][0] = kn[kb][0]; kf[kb][1] = kn[kb][1]; }
        }
        l += __shfl_xor(l, 16); l += __shfl_xor(l, 32);
#undef DSA_KLOAD
#undef DSA_VDMA
        if (c16 < 4) {
            const float rl = 1.0f / l;
            bf16_t* orow = WSL(bf16_t, WS_OCAT) + (rowb + t) * DM + 512 + c16 * 64 + 4 * g4;
#pragma unroll
            for (int db = 0; db < 4; ++db) { u32x2 w; w.x = cvtpk(O[db][0] * rl, O[db][1] * rl); w.y = cvtpk(O[db][2] * rl, O[db][3] * rl); *(u32x2*)(orow + 16 * db) = w; }
        }
    }
}
#undef WSL

__device__ __forceinline__ void p2_attention(Frame& F) {
    const int NIT = NB * (SEQ / 32);
#ifndef REP_DSA
#define REP_DSA 1
#endif
#ifndef REP_SWAMEM
#define REP_SWAMEM 1
#endif
    for (int rep = 0; rep < REP_DSA; ++rep)
    for (int r = 0; r < (NIT + F.G - 1) / F.G; ++r) {
        int b, tile;
        if (F.G == 256) { const int j = F.vcu & 63; b = F.vcu >> 6; tile = r == 0 ? j : (r == 1 ? 127 - j : (r == 2 ? 128 + j : 255 - j)); }
        else { const int it = r * F.G + F.vcu; if (it >= NIT) break; b = it / (SEQ / 32); tile = it % (SEQ / 32); }
        dsa_item(F, b, tile * 32);
    }
    for (int rep = 0; rep < REP_SWAMEM; ++rep) {
    for (int it = F.vcu; it < NB * (SEQ / 128); it += F.G) swa_item(F, it / (SEQ / 128), it % (SEQ / 128));
    for (int it = F.vcu; it < NB * (SEQ / 128); it += F.G) mem_item(F, it / (SEQ / 128), it % (SEQ / 128));
    }
}

#ifndef MK_N_LAUNCHES
#define MK_N_LAUNCHES 1
#endif
constexpr int N_PHASES = 8;
struct Args { const void* in[17]; float* out; unsigned char* ws; int ph_lo, ph_hi, li, pad; };

__global__ void __launch_bounds__(NWAVES * 64, 2) hybrid_fwd(Args args) {
    extern __shared__ __attribute__((aligned(16))) unsigned char lds[];
    Frame F;
    F.lds = (LAS unsigned char*)lds;
    F.MISC = (volatile LAS unsigned*)(F.lds + MISC_OFF);
    F.tid = threadIdx.x; F.lane = F.tid & 63; F.wave = __builtin_amdgcn_readfirstlane(F.tid >> 6);
    F.G = gridDim.x; { const int bx = blockIdx.x; F.vcu = (F.G % 8 == 0) ? (bx % 8) * (F.G / 8) + bx / 8 : bx; }
    F.ws = args.ws; F.ctl = (unsigned*)(args.ws + WS_CTL);
    F.x = (const float*)args.in[0]; F.mem = (const float*)args.in[1]; F.positions = (const int*)args.in[2]; F.g_mix = (const float*)args.in[3]; F.w_in = (const float*)args.in[4];
    F.b_gate = (const float*)args.in[5]; F.sinks = (const float*)args.in[6]; F.g_mem = (const float*)args.in[7]; F.w_mem_kv = (const float*)args.in[8]; F.w_proj_swa = (const float*)args.in[9];
    F.w_proj_dsa = (const float*)args.in[10]; F.w_proj_mem = (const float*)args.in[11]; F.w_out = (const float*)args.in[12]; F.g_mlp = (const float*)args.in[13]; F.w_mlp_in = (const float*)args.in[14];
    F.w_mlp_out = (const float*)args.in[15]; F.g_final = (const float*)args.in[16]; F.out = args.out;
    for (int u = F.tid; u < (LDS_BYTES - LDSCTL_OFF) / 4; u += NWAVES * 64) ((LAS unsigned*)(F.lds + LDSCTL_OFF))[u] = 0u;
    __syncthreads();
    XcdBarrier bar; bar.bar = F.ctl + CW_BAR + args.li * XCD_BAR_WORDS; bar.x = 0; bar.st = nullptr;
    if (args.ph_hi - args.ph_lo > 1) bar = xcd_barrier_post(F.ctl + CW_BAR + args.li * XCD_BAR_WORDS, F.MISC + 8);
    const int lo = args.ph_lo, hi = args.ph_hi;
#ifndef PHASE_MASK
#define PHASE_MASK 0xff
#endif
#define IN(k) (((PHASE_MASK >> (k)) & 1) && lo <= (k) && (k) < hi)
#define BOTH(k) (IN(k) && IN((k) + 1))
#define GRID_BAR() xcd_barrier(bar)
    const int bx = (int)blockIdx.x;

    if (IN(0)) { p0_prologue(F); if (BOTH(0)) GRID_BAR(); }

    if (IN(1)) {
        SchedInProj S; S.nM = T / 256; S.nN = NPOS / 256; S.nwg = S.nM * S.nN; S.G = F.G; S.c = bx;
        S.Ab = (const char*)WSP(bf16_t, WS_XB); S.Bb = (const char*)WSP(bf16_t, WS_WIN); S.Am = (const char*)WSP(bf16_t, WS_MEMB); S.Bm = (const char*)WSP(bf16_t, WS_WMEM);
        EpiInProj E; E.inv_rms = WSP(float, WS_INVRMS0); E.inv_rms_mem = WSP(float, WS_INVRMSM); E.cs = WSP(float, WS_CS); E.b_gate = F.b_gate;
        E.q_s = WSP(bf16_t, WS_QS); E.k_s = WSP(bf16_t, WS_KS); E.v_s = WSP(bf16_t, WS_VS); E.q_d = WSP(bf16_t, WS_QD); E.k_d = WSP(bf16_t, WS_KD); E.v_d = WSP(bf16_t, WS_VD);
        E.q_i = WSP(bf16_t, WS_QI); E.k_i = WSP(bf16_t, WS_KI); E.q_m = WSP(bf16_t, WS_QM); E.gates = WSP(bf16_t, WS_GATES); E.mk = WSP(bf16_t, WS_MK); E.mv = WSP(bf16_t, WS_MV); E.w_i = WSP(float, WS_WI);
        pg8::gemm_phase<EpiInProj, SchedInProj, true>(F.lds + RING_OFF, DM, DM, S, E);
        if (BOTH(1)) GRID_BAR();
    }

    if (IN(2)) { p2_attention(F); if (BOTH(2)) GRID_BAR(); }

    if (IN(3)) {
        SchedMerge S; S.G = F.G; S.c = bx; S.Ab = (const char*)WSP(bf16_t, WS_OCAT); S.Bb = (const char*)WSP(bf16_t, WS_WPROJ);
        EpiMerge E; E.gates = WSP(bf16_t, WS_GATES); E.merged = WSP(bf16_t, WS_MERGED);
        pg8::gemm_phase<EpiMerge, SchedMerge, true>(F.lds + RING_OFF, DM, DM, S, E);
        if (BOTH(3)) GRID_BAR();
    }

    if (IN(4)) {
        SchedGrid S; S.nM = T / 256; S.nN = DM / 256; S.nwg = S.nM * S.nN; S.G = F.G; S.c = bx; S.nt = DM / 64;
        S.Ab = (const char*)WSP(bf16_t, WS_MERGED); S.Bb = (const char*)WSP(bf16_t, WS_WOUT); S.tA = (size_t)256 * DM * 2; S.tB = (size_t)256 * DM * 2;
        EpiResid<true> E; E.base = F.x; E.out = F.out; E.outb = WSP(bf16_t, WS_XB); E.ssq = WSP(float, WS_SSQ1);
        pg8::gemm_phase<EpiResid<true>, SchedGrid, true>(F.lds + RING_OFF, DM, DM, S, E);
        if (BOTH(4)) GRID_BAR();
    }

    if (IN(5)) {
        SchedGrid S; S.nM = T / 256; S.nN = DFF / 256; S.nwg = S.nM * S.nN; S.G = F.G; S.c = bx; S.nt = DM / 64;
        S.Ab = (const char*)WSP(bf16_t, WS_XB); S.Bb = (const char*)WSP(bf16_t, WS_W1); S.tA = (size_t)256 * DM * 2; S.tB = (size_t)256 * DM * 2;
        EpiMlpIn E; E.ssq = WSP(float, WS_SSQ1); E.hid = WSP(bf16_t, WS_HID);
        pg8::gemm_phase<EpiMlpIn, SchedGrid, true>(F.lds + RING_OFF, DM, DM, S, E);
        if (BOTH(5)) GRID_BAR();
    }

    if (IN(6)) {
        SchedGrid S; S.nM = T / 256; S.nN = DM / 256; S.nwg = S.nM * S.nN; S.G = F.G; S.c = bx; S.nt = DFF / 64;
        S.Ab = (const char*)WSP(bf16_t, WS_HID); S.Bb = (const char*)WSP(bf16_t, WS_W2); S.tA = (size_t)256 * DFF * 2; S.tB = (size_t)256 * DFF * 2;
        EpiResid<false> E; E.base = F.out; E.out = F.out; E.outb = nullptr; E.ssq = WSP(float, WS_SSQ2);
        pg8::gemm_phase<EpiResid<false>, SchedGrid, true>(F.lds + RING_OFF, DFF, DFF, S, E);
        if (BOTH(6)) GRID_BAR();
    }

    if (IN(7)) p7_final_norm(F);
#undef IN
#undef BOTH
#undef GRID_BAR
}

extern "C" void kernel_launch(void* const* d_in, const int* in_sizes, int n_in, void* d_out, int out_size, void* d_ws, size_t ws_size, hipStream_t stream) {
    static int grid = 0;
    if (grid == 0) {
        if (n_in != 17 || in_sizes[0] != T * DM || out_size != T * DM || ws_size < WS_END) { fprintf(stderr, "kernel_launch: unexpected shapes (n_in %d, in0 %d, out %d, ws %zu < %zu); nothing launched\n", n_in, n_in > 0 ? in_sizes[0] : -1, out_size, ws_size, (size_t)WS_END); grid = -1; return; }
        int dev = 0, cus = 0, per_cu = 0;
        if (hipGetDevice(&dev) != hipSuccess || hipDeviceGetAttribute(&cus, hipDeviceAttributeMultiprocessorCount, dev) != hipSuccess) { grid = -1; return; }
        if (hipFuncSetAttribute((const void*)hybrid_fwd, hipFuncAttributeMaxDynamicSharedMemorySize, LDS_BYTES) != hipSuccess) { fprintf(stderr, "kernel_launch: hipFuncSetAttribute failed\n"); grid = -1; return; }
        if (hipOccupancyMaxActiveBlocksPerMultiprocessor(&per_cu, (const void*)hybrid_fwd, NWAVES * 64, LDS_BYTES) != hipSuccess || per_cu < 1) { fprintf(stderr, "kernel_launch: occupancy query reports %d workgroups per CU; nothing launched\n", per_cu); (void)hipGetLastError(); grid = -1; return; }
        (void)hipGetLastError();
        grid = cus;
    }
    if (grid < 0) return;
    if (hipMemsetAsync((char*)d_ws + WS_CTL, 0, CTL_ZERO_BYTES, stream) != hipSuccess) return;
    Args a{};
    for (int i = 0; i < 17; ++i) a.in[i] = d_in[i];
    a.out = (float*)d_out; a.ws = (unsigned char*)d_ws;
    if (MK_N_LAUNCHES == 1) { a.ph_lo = 0; a.ph_hi = N_PHASES; a.li = 0; hipLaunchKernelGGL(hybrid_fwd, dim3(grid), dim3(NWAVES * 64), LDS_BYTES, stream, a); }
    else { for (int p = 0; p < N_PHASES; ++p) { a.ph_lo = p; a.ph_hi = p + 1; a.li = 0; hipLaunchKernelGGL(hybrid_fwd, dim3(grid), dim3(NWAVES * 64), LDS_BYTES, stream, a); } }
}
```

```cpp
#include <hip/hip_runtime.h>
#include <cstdio>
#include <cstdint>

#define LAS __attribute__((address_space(3)))
#define GAS __attribute__((address_space(1)))
typedef unsigned short bf16_t;
typedef short bf16x8 __attribute__((ext_vector_type(8)));
typedef float f32x2 __attribute__((ext_vector_type(2)));
typedef float f32x4 __attribute__((ext_vector_type(4)));
typedef float f32x16 __attribute__((ext_vector_type(16)));
typedef unsigned u32x2 __attribute__((ext_vector_type(2)));
typedef unsigned u32x4 __attribute__((ext_vector_type(4)));
typedef __bf16 bf16x2_t __attribute__((ext_vector_type(2)));

constexpr int NB = 4, SEQ = 8192, T = NB * SEQ, DM = 1024, DFF = 4096, DIN = 4804, NPOS = 4864, MEMLEN = 256, MROWS = NB * MEMLEN;
constexpr float EPS = 1e-6f;
constexpr float LOG2E = 1.4426950408889634f;
constexpr float QSCALE = 0.125f * LOG2E;
constexpr float IDX_SCALE = 0.0625f;
constexpr int TOPK = 256;
constexpr int P_QS = 0, P_KS = 512, P_VS = 640, P_QD = 768, P_KD = 1024, P_VD = 1088, P_QI = 1152, P_KI = 1408, P_QM = 1472, P_GATE = 1728, P_WI = 4800, P_END = 4804;

constexpr size_t MiB = 1u << 20;
constexpr size_t WS_CTL = 0, CTL_ZERO_BYTES = 1 * MiB;
constexpr size_t WS_WIN = 1 * MiB, WS_WMEM = 11 * MiB, WS_WPROJ = 12 * MiB, WS_WOUT = 14 * MiB, WS_W1 = 16 * MiB, WS_W2 = 24 * MiB;
constexpr size_t WS_INVRMS0 = 32 * MiB, WS_INVRMSM = 32 * MiB + 128 * 1024, WS_WI = 32 * MiB + 256 * 1024;
constexpr size_t WS_SSQ1 = 33 * MiB, WS_SSQ2 = 35 * MiB, WS_CS = 37 * MiB, WS_MEMB = 45 * MiB, WS_MK = 47 * MiB, WS_MV = 47 * MiB + 512 * 1024;
constexpr size_t WS_XB = 48 * MiB;
constexpr size_t WS_OCAT = 112 * MiB;
constexpr size_t WS_QS = 176 * MiB, WS_KS = 208 * MiB, WS_VS = 216 * MiB, WS_QD = 224 * MiB, WS_KD = 240 * MiB, WS_VD = 244 * MiB, WS_QI = 248 * MiB, WS_KI = 264 * MiB, WS_QM = 268 * MiB;
constexpr size_t WS_GATES = 284 * MiB;
constexpr size_t WS_MERGED = 176 * MiB;
constexpr size_t WS_HID = 176 * MiB;
constexpr size_t WS_END = 476 * MiB;
static_assert(WS_WIN + (size_t)NPOS * DM * 2 <= WS_WMEM && WS_GATES + (size_t)T * 3072 * 2 <= WS_END && WS_HID + (size_t)T * DFF * 2 <= WS_END, "d_ws map");
constexpr int CW_TMO = 0, CW_CODE = 1, CW_BAR = 4096;

constexpr int RING_OFF = 0, RING_BYTES = 131072;
constexpr int LDSCTL_OFF = RING_BYTES, MISC_OFF = LDSCTL_OFF + 320;
constexpr int LDS_BYTES = 147456;
constexpr int NWAVES = 8;

#define LDS_WAIT() asm volatile("s_waitcnt lgkmcnt(0)" ::: "memory")
#define VM_WAIT() asm volatile("s_waitcnt vmcnt(0)" ::: "memory")
#define RLX_AGENT __ATOMIC_RELAXED, __HIP_MEMORY_SCOPE_AGENT

__device__ __forceinline__ unsigned cvtpk(float lo, float hi) { f32x2 v = {lo, hi}; bf16x2_t b = __builtin_convertvector(v, bf16x2_t); return __builtin_bit_cast(unsigned, b); }
__device__ __forceinline__ float bf_lo(unsigned w) { return __uint_as_float(w << 16); }
__device__ __forceinline__ float bf_hi(unsigned w) { return __uint_as_float(w & 0xffff0000u); }
__device__ __forceinline__ float wave_sum(float v) {
#pragma unroll
    for (int o = 1; o < 64; o <<= 1) v += __shfl_xor(v, o);
    return v;
}
__device__ __forceinline__ float wave_max(float v) {
#pragma unroll
    for (int o = 1; o < 64; o <<= 1) v = fmaxf(v, __shfl_xor(v, o));
    return v;
}

namespace pg8 {
constexpr int BM = 256, BK = 64, HALF = 128, HTB = HALF * BK * 2  , STAGE_BYTES = 8 * HTB, NXCD = 8, WGM = 8;
__host__ __device__ __forceinline__ int lds_byte(int r, int c) { const int st = (r >> 4) * 2 + (c >> 5), rr = r & 15, cc = c & 31, ob = rr * 64 + cc * 2; return st * 1024 + (ob ^ (((ob >> 9) & 1) << 5)); }
__host__ __device__ __forceinline__ void stage_rc(int b, int& R, int& C) { const int st = b / 1024, sb = b % 1024, swz = sb ^ (((sb >> 9) & 1) << 5); R = (st >> 1) * 16 + swz / 64; C = (st & 1) * 32 + (swz % 64) / 2; }
__host__ __device__ __forceinline__ int perm32(int rho) { const int n = rho >> 4, i = rho & 15; return 8 * (i >> 2) + 4 * n + (i & 3); }

struct Unit { int pm, pn, kind, nt; const char* A; const char* B; };

__device__ __forceinline__ void map_tile(int L, int nM, int nN, int& pm, int& pn) {
    const int nwg = nM * nN;
    int wgid = L; { const int q = nwg / NXCD, r = nwg % NXCD, xcd = wgid % NXCD, off = wgid / NXCD; wgid = (xcd < r ? xcd * (q + 1) : r * (q + 1) + (xcd - r) * q) + off; }
    const int nig = WGM * nN, gid = wgid / nig, fm = gid * WGM, gsz = (nM - fm) < WGM ? (nM - fm) : WGM;
    pm = fm + ((wgid % nig) % gsz); pn = (wgid % nig) / gsz;
}

template <class Epi, class Sched, bool ALIGN_EPI>
__device__ __forceinline__ void gemm_phase(LAS unsigned char* lds, const int lda, const int ldb, const Sched& S, const Epi& E) {
    const int tid = threadIdx.x, wid = __builtin_amdgcn_readfirstlane(tid >> 6), lane = tid & 63, wr = wid >> 2, wc = wid & 3, fr = lane & 15, fq = lane >> 4;
    unsigned voffA[2], voffB[2];
#pragma unroll
    for (int i = 0; i < 2; ++i) { int R, C; stage_rc(tid * 16 + i * 8192, R, C); const int Rb = Epi::PERM ? ((R & ~31) + perm32(R & 31)) : R;
        voffA[i] = (unsigned)(R * lda + C) * 2u; voffB[i] = (unsigned)(Rb * ldb + C) * 2u; }
    const size_t kstep = (size_t)(BK * 2);
    const size_t hstepA = (size_t)HALF * lda * 2, hstepB = (size_t)HALF * ldb * 2;
    const unsigned ldsw = (unsigned)wid * 1024u;
    const int aoff = lds_byte(wr * 64 + fr, fq * 8), boff = lds_byte(wc * 32 + fr, fq * 8);
#define PG8_SA(b, h) (((b) * 2 + (h)) * HTB)
#define PG8_SB(b, h) ((4 + (b) * 2 + (h)) * HTB)
#define PG8_STAGE(bufoff, gbase, voff) do { _Pragma("unroll") for (int _i = 0; _i < 2; ++_i) \
        __builtin_amdgcn_global_load_lds((const unsigned*)((const char*)(gbase) + (voff)[_i]), (LAS unsigned*)(lds + (bufoff) + ldsw + _i * 8192), 16, 0, 0); } while (0)
#define PG8_LDA(dst, b, h) do { _Pragma("unroll") for (int m = 0; m < 4; ++m) _Pragma("unroll") for (int k = 0; k < 2; ++k) dst[m][k] = *(const LAS bf16x8*)(lds + PG8_SA(b, h) + aoff + m * 2048 + k * 1024); } while (0)
#define PG8_LDB(dst, b, h) do { _Pragma("unroll") for (int n = 0; n < 2; ++n) _Pragma("unroll") for (int k = 0; k < 2; ++k) dst[n][k] = *(const LAS bf16x8*)(lds + PG8_SB(b, h) + boff + n * 2048 + k * 1024); } while (0)
#define PG8_MMA(ai, bj, At, Bt) do { __builtin_amdgcn_s_setprio(1); _Pragma("unroll") for (int m = 0; m < 4; ++m) _Pragma("unroll") for (int n = 0; n < 2; ++n) _Pragma("unroll") for (int k = 0; k < 2; ++k) \
        acc[ai][bj][m][n] = __builtin_amdgcn_mfma_f32_16x16x32_bf16(Bt[n][k], At[m][k], acc[ai][bj][m][n], 0, 0, 0); __builtin_amdgcn_s_setprio(0); } while (0)
#define PG8_WAIT_V(n) asm volatile("s_waitcnt vmcnt(" #n ")" ::: "memory")
#define PG8_WAIT_L(n) asm volatile("s_waitcnt lgkmcnt(" #n ")" ::: "memory")
#define PG8_BAR __builtin_amdgcn_s_barrier()
#define PG8_SCHED __builtin_amdgcn_sched_barrier(0)
    Unit cur, nxt; int ui = 0;
    if (!S.next(0, cur)) return;
    f32x4 acc[2][2][4][2];
#pragma unroll
    for (int a = 0; a < 2; ++a)
#pragma unroll
        for (int b = 0; b < 2; ++b)
#pragma unroll
            for (int m = 0; m < 4; ++m)
#pragma unroll
                for (int n = 0; n < 2; ++n) acc[a][b][m][n] = (f32x4){0.f, 0.f, 0.f, 0.f};
    bf16x8 At[4][2], B0[2][2], B1[2][2];
    const char* cA = cur.A; const char* cB = cur.B;
    PG8_STAGE(PG8_SB(0, 0), cB, voffB); PG8_STAGE(PG8_SB(0, 1), cB + hstepB, voffB); PG8_STAGE(PG8_SA(0, 0), cA, voffA); PG8_STAGE(PG8_SA(0, 1), cA + hstepA, voffA);
    if (wr == 1) PG8_BAR;
    PG8_WAIT_V(2); PG8_BAR;
    PG8_STAGE(PG8_SB(1, 0), cB + kstep, voffB); PG8_STAGE(PG8_SA(1, 0), cA + kstep, voffA); PG8_STAGE(PG8_SB(1, 1), cB + hstepB + kstep, voffB);
    PG8_WAIT_V(6); PG8_BAR;
    for (;;) {
        const bool has_next = S.next(ui + 1, nxt);
        const char* nA = has_next ? nxt.A : cA; const char* nB = has_next ? nxt.B : cB;
        const int nt = cur.nt;
        for (int t = 0; t < nt; t += 2) {
            const bool last = (t == nt - 2);
            const char* a1 = cA + (size_t)(t + 1) * kstep;
            const char* a2 = last ? nA : cA + (size_t)(t + 2) * kstep; const char* b2 = last ? nB : cB + (size_t)(t + 2) * kstep;
            const char* a3 = a2 + kstep; const char* b3 = b2 + kstep;
            PG8_LDB(B0, 0, 0); PG8_LDB(B1, 0, 1); PG8_SCHED; PG8_LDA(At, 0, 0); PG8_STAGE(PG8_SA(1, 1), a1 + hstepA, voffA);
            PG8_WAIT_V(8); PG8_WAIT_L(0); PG8_BAR; PG8_MMA(0, 0, At, B0); PG8_MMA(0, 1, At, B1); PG8_BAR; PG8_SCHED;
            PG8_LDA(At, 0, 1); PG8_STAGE(PG8_SB(0, 0), b2, voffB); PG8_STAGE(PG8_SB(0, 1), b2 + hstepB, voffB); PG8_STAGE(PG8_SA(0, 0), a2, voffA);
            PG8_WAIT_V(8); PG8_WAIT_L(0); PG8_BAR; PG8_MMA(1, 0, At, B0); PG8_MMA(1, 1, At, B1); PG8_BAR; PG8_SCHED;
            PG8_LDB(B0, 1, 0); PG8_LDB(B1, 1, 1); PG8_SCHED; PG8_LDA(At, 1, 0); PG8_STAGE(PG8_SA(0, 1), a2 + hstepA, voffA);
            PG8_WAIT_V(8); PG8_WAIT_L(0); PG8_BAR; PG8_MMA(0, 0, At, B0); PG8_MMA(0, 1, At, B1); PG8_BAR; PG8_SCHED;
            PG8_LDA(At, 1, 1); PG8_STAGE(PG8_SB(1, 0), b3, voffB); PG8_STAGE(PG8_SB(1, 1), b3 + hstepB, voffB); PG8_STAGE(PG8_SA(1, 0), a3, voffA);
            PG8_WAIT_V(8); PG8_WAIT_L(0); PG8_BAR; PG8_MMA(1, 0, At, B0); PG8_MMA(1, 1, At, B1); PG8_BAR; PG8_SCHED;
        }
        if constexpr (ALIGN_EPI) { if (wr == 0) PG8_BAR; }
        E(acc, cur, wr, wc, fr, fq);
        if (!has_next) break;
#pragma unroll
        for (int a = 0; a < 2; ++a)
#pragma unroll
            for (int b = 0; b < 2; ++b)
#pragma unroll
                for (int m = 0; m < 4; ++m)
#pragma unroll
                    for (int n = 0; n < 2; ++n) acc[a][b][m][n] = (f32x4){0.f, 0.f, 0.f, 0.f};
        cur = nxt; cA = nA; cB = nB; ++ui;
        if constexpr (ALIGN_EPI) { if (wr == 1) PG8_BAR; }
    }
    PG8_WAIT_V(0);
    if constexpr (!ALIGN_EPI) { if (wr == 0) PG8_BAR; }
    PG8_BAR;
#undef PG8_SA
#undef PG8_SB
#undef PG8_STAGE
#undef PG8_LDA
#undef PG8_LDB
#undef PG8_MMA
#undef PG8_WAIT_V
#undef PG8_WAIT_L
#undef PG8_BAR
#undef PG8_SCHED
}
}

struct SchedGrid {
    int nM, nN, nwg, G, c, nt; const char* Ab; const char* Bb; size_t tA, tB;
    __device__ __forceinline__ bool next(int i, pg8::Unit& u) const {
        const long L = (long)i * G + c; if (L >= nwg) return false;
        pg8::map_tile((int)L, nM, nN, u.pm, u.pn); u.kind = 0; u.nt = nt; u.A = Ab + (size_t)u.pm * tA; u.B = Bb + (size_t)u.pn * tB; return true;
    }
};
struct SchedInProj {
    int nM, nN, nwg, G, c; const char* Ab; const char* Bb; const char* Am; const char* Bm;
    __device__ __forceinline__ bool next(int i, pg8::Unit& u) const {
        const long L = (long)i * G + c; if (L >= nwg + 8) return false;
        u.nt = DM / 64;
        if (L < nwg) { pg8::map_tile((int)L, nM, nN, u.pm, u.pn); u.kind = 0; u.A = Ab + (size_t)u.pm * (256 * DM * 2); u.B = Bb + (size_t)u.pn * (256 * DM * 2); }
        else { const int e = (int)(L - nwg); u.pm = e >> 1; u.pn = e & 1; u.kind = 1; u.A = Am + (size_t)u.pm * (256 * DM * 2); u.B = Bm + (size_t)u.pn * (256 * DM * 2); }
        return true;
    }
};
struct SchedMerge {
    int G, c; const char* Ab; const char* Bb;
    __device__ __forceinline__ bool next(int i, pg8::Unit& u) const {
        const int round = i / 3, br = i - 3 * round; const long L = (long)round * G + c; if (L >= 512) return false;
        pg8::map_tile((int)L, 128, 4, u.pm, u.pn); u.kind = br; u.nt = br == 0 ? 8 : 4;
        const int koff = br == 0 ? 0 : (br == 1 ? 512 : 768);
        u.A = Ab + (size_t)u.pm * (256 * DM * 2) + koff * 2; u.B = Bb + (size_t)u.pn * (256 * DM * 2) + koff * 2; return true;
    }
};

__device__ __forceinline__ float sigmoidf_fast(float x) { return __builtin_amdgcn_rcpf(1.0f + __builtin_amdgcn_exp2f(-x * LOG2E)); }

struct EpiInProj {
    static constexpr bool PERM = true;
    const float* inv_rms; const float* inv_rms_mem; const float* cs; const float* b_gate;
    bf16_t *q_s, *k_s, *v_s, *q_d, *k_d, *v_d, *q_i, *k_i, *q_m, *gates, *mk, *mv; float* w_i;
    __device__ __forceinline__ void operator()(const f32x4 (&acc)[2][2][4][2], const pg8::Unit& u, int wr, int wc, int fr, int fq) const {
        if (u.kind == 1) {
            bf16_t* dst = u.pn == 0 ? mk : mv;
#pragma unroll
            for (int ai = 0; ai < 2; ++ai)
#pragma unroll
                for (int m = 0; m < 4; ++m) { const int row = u.pm * 256 + ai * 128 + wr * 64 + m * 16 + fr; const float s = inv_rms_mem[row];
#pragma unroll
                    for (int bj = 0; bj < 2; ++bj) { const f32x4 v0 = acc[ai][bj][m][0] * s, v1 = acc[ai][bj][m][1] * s;
                        u32x4 w; w.x = cvtpk(v0[0], v0[1]); w.y = cvtpk(v0[2], v0[3]); w.z = cvtpk(v1[0], v1[1]); w.w = cvtpk(v1[2], v1[3]);
                        *(u32x4*)(dst + (size_t)row * 256 + bj * 128 + wc * 32 + 8 * fq) = w; } }
            return;
        }
#pragma unroll
        for (int bj = 0; bj < 2; ++bj) {
            const int pos0 = u.pn * 256 + bj * 128 + wc * 32;
            const int p = pos0 + 8 * fq;
            int kind; bf16_t* dst; int ld, sec0; float scl = 1.f;
            if (pos0 < P_KS)        { kind = 0; dst = q_s; ld = 512; sec0 = P_QS; scl = QSCALE; }
            else if (pos0 < P_VS)   { kind = 0; dst = k_s; ld = 128; sec0 = P_KS; }
            else if (pos0 < P_QD)   { kind = 1; dst = v_s; ld = 128; sec0 = P_VS; }
            else if (pos0 < P_KD)   { kind = 0; dst = q_d; ld = 256; sec0 = P_QD; scl = QSCALE; }
            else if (pos0 < P_VD)   { kind = 0; dst = k_d; ld = 64;  sec0 = P_KD; }
            else if (pos0 < P_QI)   { kind = 1; dst = v_d; ld = 64;  sec0 = P_VD; }
            else if (pos0 < P_KI)   { kind = 0; dst = q_i; ld = 256; sec0 = P_QI; }
            else if (pos0 < P_QM)   { kind = 0; dst = k_i; ld = 64;  sec0 = P_KI; }
            else if (pos0 < P_GATE) { kind = 1; dst = q_m; ld = 256; sec0 = P_QM; scl = QSCALE; }
            else if (pos0 < P_WI)   { kind = 2; dst = gates; ld = 3072; sec0 = P_GATE; }
            else                    { kind = 3; dst = nullptr; ld = 0; sec0 = P_WI; }
            const int lp = p - sec0;
            if (kind == 0) {
                const int head = lp >> 6, i0 = (lp & 63) >> 1;
#pragma unroll
                for (int ai = 0; ai < 2; ++ai)
#pragma unroll
                    for (int m = 0; m < 4; ++m) { const int row = u.pm * 256 + ai * 128 + wr * 64 + m * 16 + fr; const float s = inv_rms[row] * scl;
                        const f32x4 v0 = acc[ai][bj][m][0] * s, v1 = acc[ai][bj][m][1] * s;
                        const f32x4 ca = *(const f32x4*)(cs + (size_t)row * 64 + 2 * i0), cb = *(const f32x4*)(cs + (size_t)row * 64 + 2 * i0 + 4);
                        const float a0 = v0[0] * ca[0] - v0[1] * ca[1], b0 = v0[1] * ca[0] + v0[0] * ca[1];
                        const float a1 = v0[2] * ca[2] - v0[3] * ca[3], b1 = v0[3] * ca[2] + v0[2] * ca[3];
                        const float a2 = v1[0] * cb[0] - v1[1] * cb[1], b2 = v1[1] * cb[0] + v1[0] * cb[1];
                        const float a3 = v1[2] * cb[2] - v1[3] * cb[3], b3 = v1[3] * cb[2] + v1[2] * cb[3];
                        bf16_t* o = dst + (size_t)row * ld + head * 64 + i0;
                        u32x2 wa, wb; wa.x = cvtpk(a0, a1); wa.y = cvtpk(a2, a3); wb.x = cvtpk(b0, b1); wb.y = cvtpk(b2, b3);
                        *(u32x2*)o = wa; *(u32x2*)(o + 32) = wb; }
            } else if (kind == 1) {
#pragma unroll
                for (int ai = 0; ai < 2; ++ai)
#pragma unroll
                    for (int m = 0; m < 4; ++m) { const int row = u.pm * 256 + ai * 128 + wr * 64 + m * 16 + fr; const float s = inv_rms[row] * scl;
                        const f32x4 v0 = acc[ai][bj][m][0] * s, v1 = acc[ai][bj][m][1] * s;
                        u32x4 w; w.x = cvtpk(v0[0], v0[1]); w.y = cvtpk(v0[2], v0[3]); w.z = cvtpk(v1[0], v1[1]); w.w = cvtpk(v1[2], v1[3]);
                        *(u32x4*)(dst + (size_t)row * ld + lp) = w; }
            } else if (kind == 2) {
                const f32x4 g0 = *(const f32x4*)(b_gate + lp), g1 = *(const f32x4*)(b_gate + lp + 4);
#pragma unroll
                for (int ai = 0; ai < 2; ++ai)
#pragma unroll
                    for (int m = 0; m < 4; ++m) { const int row = u.pm * 256 + ai * 128 + wr * 64 + m * 16 + fr; const float s = inv_rms[row];
                        const f32x4 v0 = acc[ai][bj][m][0] * s + g0, v1 = acc[ai][bj][m][1] * s + g1;
                        u32x4 w; w.x = cvtpk(sigmoidf_fast(v0[0]), sigmoidf_fast(v0[1])); w.y = cvtpk(sigmoidf_fast(v0[2]), sigmoidf_fast(v0[3]));
                        w.z = cvtpk(sigmoidf_fast(v1[0]), sigmoidf_fast(v1[1])); w.w = cvtpk(sigmoidf_fast(v1[2]), sigmoidf_fast(v1[3]));
                        *(u32x4*)(dst + (size_t)row * ld + lp) = w; }
            } else {
                if (pos0 == P_WI && fq == 0) {
#pragma unroll
                    for (int ai = 0; ai < 2; ++ai)
#pragma unroll
                        for (int m = 0; m < 4; ++m) { const int row = u.pm * 256 + ai * 128 + wr * 64 + m * 16 + fr; const float s = inv_rms[row] * IDX_SCALE;
                            *(f32x4*)(w_i + (size_t)row * 4) = acc[ai][bj][m][0] * s; }
                }
            }
        }
    }
};

struct EpiMerge {
    static constexpr bool PERM = true;
    const bf16_t* gates; bf16_t* merged;
    __device__ __forceinline__ void operator()(const f32x4 (&acc)[2][2][4][2], const pg8::Unit& u, int wr, int wc, int fr, int fq) const {
        const int br = u.kind;
#pragma unroll
        for (int ai = 0; ai < 2; ++ai)
#pragma unroll
            for (int m = 0; m < 4; ++m) { const int row = u.pm * 256 + ai * 128 + wr * 64 + m * 16 + fr;
#pragma unroll
                for (int bj = 0; bj < 2; ++bj) { const int col = u.pn * 256 + bj * 128 + wc * 32 + 8 * fq;
                    const u32x4 g = *(const u32x4*)(gates + (size_t)row * 3072 + br * 1024 + col);
                    f32x4 v0 = acc[ai][bj][m][0], v1 = acc[ai][bj][m][1];
                    v0[0] *= bf_lo(g.x); v0[1] *= bf_hi(g.x); v0[2] *= bf_lo(g.y); v0[3] *= bf_hi(g.y); v1[0] *= bf_lo(g.z); v1[1] *= bf_hi(g.z); v1[2] *= bf_lo(g.w); v1[3] *= bf_hi(g.w);
                    bf16_t* o = merged + (size_t)row * 1024 + col;
                    if (br > 0) { const u32x4 pv = *(const u32x4*)o;
                        v0[0] += bf_lo(pv.x); v0[1] += bf_hi(pv.x); v0[2] += bf_lo(pv.y); v0[3] += bf_hi(pv.y); v1[0] += bf_lo(pv.z); v1[1] += bf_hi(pv.z); v1[2] += bf_lo(pv.w); v1[3] += bf_hi(pv.w); }
                    u32x4 w; w.x = cvtpk(v0[0], v0[1]); w.y = cvtpk(v0[2], v0[3]); w.z = cvtpk(v1[0], v1[1]); w.w = cvtpk(v1[2], v1[3]);
                    *(u32x4*)o = w; } }
    }
};

template <bool WRITE_BF> struct EpiResid {
    static constexpr bool PERM = false;
    const float* base; float* out; bf16_t* outb; float* ssq;
    __device__ __forceinline__ void operator()(const f32x4 (&acc)[2][2][4][2], const pg8::Unit& u, int wr, int wc, int fr, int fq) const {
#pragma unroll
        for (int ai = 0; ai < 2; ++ai)
#pragma unroll
            for (int m = 0; m < 4; ++m) { const int row = u.pm * 256 + ai * 128 + wr * 64 + m * 16 + fr; float q = 0.f;
#pragma unroll
                for (int bj = 0; bj < 2; ++bj)
#pragma unroll
                    for (int n = 0; n < 2; ++n) { const size_t off = (size_t)row * DM + u.pn * 256 + bj * 128 + wc * 32 + n * 16 + 4 * fq;
                        const f32x4 o = *(const f32x4*)(base + off) + acc[ai][bj][m][n];
                        *(f32x4*)(out + off) = o; q += (o[0] * o[0] + o[1] * o[1]) + (o[2] * o[2] + o[3] * o[3]);
                        if (WRITE_BF) { u32x2 w; w.x = cvtpk(o[0], o[1]); w.y = cvtpk(o[2], o[3]); *(u32x2*)(outb + off) = w; } }
                q += __shfl_xor(q, 16); q += __shfl_xor(q, 32);
                if (fq == 0) ssq[(size_t)row * 16 + u.pn * 4 + wc] = q; }
    }
};

struct EpiMlpIn {
    static constexpr bool PERM = true;
    const float* ssq; bf16_t* hid;
    __device__ __forceinline__ void operator()(const f32x4 (&acc)[2][2][4][2], const pg8::Unit& u, int wr, int wc, int fr, int fq) const {
#pragma unroll
        for (int ai = 0; ai < 2; ++ai)
#pragma unroll
            for (int m = 0; m < 4; ++m) { const int row = u.pm * 256 + ai * 128 + wr * 64 + m * 16 + fr;
                const f32x4* sp = (const f32x4*)(ssq + (size_t)row * 16); const f32x4 s0 = sp[0], s1 = sp[1], s2 = sp[2], s3 = sp[3];
                const float tot = ((s0[0] + s0[1]) + (s0[2] + s0[3])) + ((s1[0] + s1[1]) + (s1[2] + s1[3])) + ((s2[0] + s2[1]) + (s2[2] + s2[3])) + ((s3[0] + s3[1]) + (s3[2] + s3[3]));
                const float s = 1.0f / sqrtf(tot * (1.0f / DM) + EPS);
#pragma unroll
                for (int bj = 0; bj < 2; ++bj) { f32x4 v0 = acc[ai][bj][m][0] * s, v1 = acc[ai][bj][m][1] * s;
#pragma unroll
                    for (int e = 0; e < 4; ++e) { const float a = fmaxf(v0[e], 0.f), b = fmaxf(v1[e], 0.f); v0[e] = a * a; v1[e] = b * b; }
                    u32x4 w; w.x = cvtpk(v0[0], v0[1]); w.y = cvtpk(v0[2], v0[3]); w.z = cvtpk(v1[0], v1[1]); w.w = cvtpk(v1[2], v1[3]);
                    *(u32x4*)(hid + (size_t)row * DFF + u.pn * 256 + bj * 128 + wc * 32 + 8 * fq) = w; } }
    }
};

#define XB_TMO      128
#define XB_XCNT(j)  (256  + 64 * (j))
#define XB_XSUB(j)  (1280 + 64 * (j))
#define XB_XGEN(j)  (2304 + 64 * (j))
#define XB_TOP      3328
#define XB_TOPGEN   3392
#define XCD_BAR_WORDS 3456
#define XB_SPIN_CAP (1u << 20)
__device__ __forceinline__ unsigned xb_ld(unsigned* p)              { return __hip_atomic_load(p, __ATOMIC_RELAXED, __HIP_MEMORY_SCOPE_AGENT); }
__device__ __forceinline__ unsigned xb_add(unsigned* p, unsigned v) { return __hip_atomic_fetch_add(p, v, __ATOMIC_RELAXED, __HIP_MEMORY_SCOPE_AGENT); }
__device__ __forceinline__ unsigned xb_xcc_id() { return (unsigned)__builtin_amdgcn_s_getreg((3 << 11) | 20) & 0xFu; }
#define XB_SPIN(cond, bar) do { unsigned _sp = 0; while (cond) { __builtin_amdgcn_s_sleep(1); \
    if ((++_sp & 255u) == 0u) { if (xb_ld(&(bar)[XB_TMO])) break; if (_sp > XB_SPIN_CAP) { atomicAdd(&(bar)[XB_TMO], 1u); break; } } } } while (0)
struct XcdBarrier { unsigned* bar; unsigned x; volatile LAS unsigned* st; };
__device__ __forceinline__ XcdBarrier xcd_barrier_post(unsigned* bar, volatile LAS unsigned* st) {
    XcdBarrier b; b.bar = bar; b.x = xb_xcc_id(); b.st = st;
    if (threadIdx.x == 0) (void)xb_add(&bar[XB_XCNT(b.x)], 1u);
    return b;
}
__device__ __forceinline__ void xcd_barrier_complete(unsigned* bar, unsigned x, unsigned& nloc, unsigned& nx) {
    const unsigned G = gridDim.x * gridDim.y * gridDim.z;
    unsigned sum, cnt, mine, sp = 0u;
    for (;;) {
        sum = 0u; cnt = 0u; mine = 0u;
#pragma unroll
        for (unsigned j = 0; j < 16; ++j) { const unsigned c = xb_ld(&bar[XB_XCNT(j)]); sum += c; cnt += (c > 0u) ? 1u : 0u; mine = (j == x) ? c : mine; }
        if (sum == G) break;
        __builtin_amdgcn_s_sleep(1);
        if ((++sp & 255u) == 0u) { if (xb_ld(&bar[XB_TMO])) break; if (sp > XB_SPIN_CAP) { atomicAdd(&bar[XB_TMO], 1u); break; } }
    }
    nloc = mine > 0u ? mine : 1u; nx = cnt > 0u ? cnt : 1u;
}
__device__ __forceinline__ void xcd_barrier(const XcdBarrier& b) {
    asm volatile("s_waitcnt vmcnt(0)" ::: "memory");
    __syncthreads();
    if (threadIdx.x == 0) {
        unsigned* bar = b.bar;
        __builtin_amdgcn_s_waitcnt(0);
        unsigned nloc = b.st[0], nx = b.st[1];
        if (nloc == 0u) { xcd_barrier_complete(bar, b.x, nloc, nx); b.st[0] = nloc; b.st[1] = nx; }
        const unsigned old = xb_add(&bar[XB_XSUB(b.x)], 1u);
        const unsigned gen = old / nloc;
        if (old + 1u == (gen + 1u) * nloc) {
            __builtin_amdgcn_fence(__ATOMIC_RELEASE, "agent");
            asm volatile("s_waitcnt vmcnt(0)" ::: "memory");
            const unsigned og = xb_add(&bar[XB_TOP], 1u);
            const unsigned tg = og / nx;
            if (og + 1u == (tg + 1u) * nx) xb_add(&bar[XB_TOPGEN], 1u);
            else XB_SPIN(xb_ld(&bar[XB_TOPGEN]) == tg, bar);
            __builtin_amdgcn_fence(__ATOMIC_ACQUIRE, "agent");
            xb_add(&bar[XB_XGEN(b.x)], 1u);
            asm volatile("s_waitcnt vmcnt(0)" ::: "memory");
        } else {
            XB_SPIN(xb_ld(&bar[XB_XGEN(b.x)]) == gen, bar);
            __builtin_amdgcn_fence(__ATOMIC_ACQUIRE, "agent");
            asm volatile("s_waitcnt vmcnt(0)" ::: "memory");
        }
    }
    __syncthreads();
}

struct Frame {
    LAS unsigned char* lds;
    volatile LAS unsigned* MISC;
    unsigned* ctl;
    int tid, lane, wave, vcu, G;
    unsigned char* ws;
    const float *x, *mem; const int* positions; const float *g_mix, *w_in, *b_gate, *sinks, *g_mem, *w_mem_kv, *w_proj_swa, *w_proj_dsa, *w_proj_mem, *w_out, *g_mlp, *w_mlp_in, *w_mlp_out, *g_final;
    float* out;
};
#define WSP(T_, off) ((T_*)(F.ws + (off)))

__device__ __forceinline__ int rope_src(int base, int lp) { return base + (lp & ~63) + ((lp & 1) ? 32 + ((lp & 63) >> 1) : ((lp & 63) >> 1)); }
__device__ __forceinline__ int win_src(int pos) {
    if (pos < P_KS) return rope_src(0, pos);
    if (pos < P_VS) return rope_src(512, pos - P_KS);
    if (pos < P_QD) return pos;
    if (pos < P_KD) return rope_src(768, pos - P_QD);
    if (pos < P_VD) return rope_src(1024, pos - P_KD);
    if (pos < P_QI) return pos;
    if (pos < P_KI) return rope_src(1152, pos - P_QI);
    if (pos < P_QM) return rope_src(1408, pos - P_KI);
    if (pos < P_GATE) return 1476 + (pos - P_QM);
    if (pos < P_WI) return 1732 + (pos - P_GATE);
    if (pos < P_END) return 1472 + (pos - P_WI);
    return -1;
}
template <bool MAP> __device__ __forceinline__ void p0_transpose_item(const float* W, int ldw, int k0, int n0, const float* gk, bf16_t* WT, int ldwt, LAS float* scr, int lane) {
    const int j = lane & 31; const int sc = MAP ? win_src(n0 + j) : n0 + j;
#pragma unroll 8
    for (int i = 0; i < 32; ++i) { const int kk = 2 * i + (lane >> 5); float v = sc >= 0 ? W[(size_t)(k0 + kk) * ldw + sc] : 0.f; if (gk) v *= gk[k0 + kk]; scr[kk * 33 + j] = v; }
    LDS_WAIT(); asm volatile("" ::: "memory");
    const int c = lane & 7;
#pragma unroll
    for (int jj = 0; jj < 4; ++jj) { const int n = (lane >> 3) + 8 * jj; const LAS float* s = scr + (8 * c) * 33 + n;
        u32x4 o; o.x = cvtpk(s[0 * 33], s[1 * 33]); o.y = cvtpk(s[2 * 33], s[3 * 33]); o.z = cvtpk(s[4 * 33], s[5 * 33]); o.w = cvtpk(s[6 * 33], s[7 * 33]);
        *(u32x4*)(WT + (size_t)(n0 + n) * ldwt + k0 + 8 * c) = o; }
    LDS_WAIT(); asm volatile("" ::: "memory");
}
__device__ __forceinline__ void row_to_bf16(const float* xrow, bf16_t* orow, float* inv, int lane) {
    const f32x4* xr = (const f32x4*)xrow + lane;
    f32x4 v[4]; float s = 0.f;
#pragma unroll
    for (int j = 0; j < 4; ++j) { v[j] = xr[64 * j]; s += (v[j][0] * v[j][0] + v[j][1] * v[j][1]) + (v[j][2] * v[j][2] + v[j][3] * v[j][3]); }
    s = wave_sum(s);
    if (lane == 0) *inv = 1.0f / sqrtf(s * (1.0f / DM) + EPS);
    u32x2* o8 = (u32x2*)orow + lane;
#pragma unroll
    for (int j = 0; j < 4; ++j) { u32x2 w; w.x = cvtpk(v[j][0], v[j][1]); w.y = cvtpk(v[j][2], v[j][3]); o8[64 * j] = w; }
}
__device__ __forceinline__ void p0_prologue(Frame& F) {
    LAS float* scr = (LAS float*)(F.lds + RING_OFF + F.wave * 16384);
    const int gw = F.vcu * NWAVES + F.wave, NGW = F.G * NWAVES;
    constexpr int I_IN = 16 * (NPOS / 32), I_MEM = 16 * 16, I_PS = 8 * 32, I_PD = 4 * 32, I_PM = 4 * 32, I_OUT = 16 * 32, I_1 = 16 * 128, I_2 = 64 * 32;
    constexpr int NITEMS = I_IN + I_MEM + I_PS + I_PD + I_PM + I_OUT + I_1 + I_2;
    for (int it = gw; it < NITEMS; it += NGW) {
        int r = it;
        if (r < I_IN) { const int nb = NPOS / 32; p0_transpose_item<true>(F.w_in, DIN, 64 * (r / nb), 32 * (r % nb), F.g_mix, WSP(bf16_t, WS_WIN), DM, scr, F.lane); continue; } r -= I_IN;
        if (r < I_MEM) { p0_transpose_item<false>(F.w_mem_kv, 512, 64 * (r / 16), 32 * (r % 16), F.g_mem, WSP(bf16_t, WS_WMEM), DM, scr, F.lane); continue; } r -= I_MEM;
        if (r < I_PS) { p0_transpose_item<false>(F.w_proj_swa, DM, 64 * (r / 32), 32 * (r % 32), nullptr, WSP(bf16_t, WS_WPROJ), DM, scr, F.lane); continue; } r -= I_PS;
        if (r < I_PD) { p0_transpose_item<false>(F.w_proj_dsa, DM, 64 * (r / 32), 32 * (r % 32), nullptr, WSP(bf16_t, WS_WPROJ) + 512, DM, scr, F.lane); continue; } r -= I_PD;
        if (r < I_PM) { p0_transpose_item<false>(F.w_proj_mem, DM, 64 * (r / 32), 32 * (r % 32), nullptr, WSP(bf16_t, WS_WPROJ) + 768, DM, scr, F.lane); continue; } r -= I_PM;
        if (r < I_OUT) { p0_transpose_item<false>(F.w_out, DM, 64 * (r / 32), 32 * (r % 32), nullptr, WSP(bf16_t, WS_WOUT), DM, scr, F.lane); continue; } r -= I_OUT;
        if (r < I_1) { p0_transpose_item<false>(F.w_mlp_in, DFF, 64 * (r / 128), 32 * (r % 128), F.g_mlp, WSP(bf16_t, WS_W1), DM, scr, F.lane); continue; } r -= I_1;
        p0_transpose_item<false>(F.w_mlp_out, DM, 64 * (r / 32), 32 * (r % 32), nullptr, WSP(bf16_t, WS_W2), DFF, scr, F.lane);
    }
    for (int m = gw; m < T; m += NGW) row_to_bf16(F.x + (size_t)m * DM, WSP(bf16_t, WS_XB) + (size_t)m * DM, WSP(float, WS_INVRMS0) + m, F.lane);
    for (int m = gw; m < MROWS; m += NGW) row_to_bf16(F.mem + (size_t)m * DM, WSP(bf16_t, WS_MEMB) + (size_t)m * DM, WSP(float, WS_INVRMSM) + m, F.lane);
    { const int gt = gw * 64 + F.lane, NGT = NGW * 64; const int i = gt & 31;
      const float invf = (float)exp2((double)(-i) * (13.287712379549449 / 32.0));
      float* cs = WSP(float, WS_CS);
      for (int idx = gt; idx < T * 32; idx += NGT) { const float ang = (float)F.positions[idx >> 5] * invf; float s, c; sincosf(ang, &s, &c); *(f32x2*)(cs + (size_t)idx * 2) = (f32x2){c, s}; } }
}

__device__ __forceinline__ void p7_final_norm(Frame& F) {
    const int gw = F.vcu * NWAVES + F.wave, NGW = F.G * NWAVES;
    const float* ssq = WSP(float, WS_SSQ2);
    f32x4 g[4];
#pragma unroll
    for (int j = 0; j < 4; ++j) g[j] = ((const f32x4*)F.g_final)[F.lane + 64 * j];
    for (int m = gw; m < T; m += NGW) {
        float p = F.lane < 16 ? ssq[(size_t)m * 16 + F.lane] : 0.f;
        p = wave_sum(p);
        const float s = 1.0f / sqrtf(p * (1.0f / DM) + EPS);
        f32x4* o = (f32x4*)(F.out + (size_t)m * DM) + F.lane;
#pragma unroll
        for (int j = 0; j < 4; ++j) { const f32x4 v = o[64 * j]; o[64 * j] = v * s * g[j]; }
    }
}

__device__ __forceinline__ int crow(int r, int hi) { return (r & 3) + 8 * (r >> 2) + 4 * hi; }
__device__ __forceinline__ float xor32f(float v) { return __shfl_xor(v, 32); }

template <int MODE> __device__ __forceinline__ void attn32(const bf16_t* Qp, int ldq, const bf16_t* Kp, int ldk, const bf16_t* Vp, int ldv, int jlo, int jhi, int qpos0, float sink_l2, bf16_t* Op, int ldo, int lane) {
    const int r32 = lane & 31, hi = lane >> 5;
    bf16x8 qf[4];
#pragma unroll
    for (int s = 0; s < 4; ++s) qf[s] = *(const bf16x8*)(Qp + (size_t)r32 * ldq + 16 * s + 8 * hi);
    float m = MODE == 1 ? sink_l2 : -INFINITY, l = MODE == 1 ? 1.0f : 0.0f;
    f32x16 o0 = {}, o1 = {};
    const int qp = qpos0 + r32;
    for (int j = jlo; j < jhi; ++j) {
        const bf16_t* kr = Kp + (size_t)(32 * j + r32) * ldk + 8 * hi;
        f32x16 sc = {};
#pragma unroll
        for (int s = 0; s < 4; ++s) { const bf16x8 kf = *(const bf16x8*)(kr + 16 * s); sc = __builtin_amdgcn_mfma_f32_32x32x16_bf16(kf, qf[s], sc, 0, 0, 0); }
        if (MODE == 1) { const int dq = qp - 32 * j - 4 * hi;
#pragma unroll
            for (int i = 0; i < 16; ++i) { const int dk = (i & 3) + 8 * (i >> 2); if (dk > dq || dq - dk >= 128) sc[i] = -INFINITY; }
        }
        float tm = sc[0];
#pragma unroll
        for (int i = 1; i < 16; ++i) tm = fmaxf(tm, sc[i]);
        tm = fmaxf(tm, xor32f(tm));
        const float mn = fmaxf(m, tm);
        const float alpha = (mn == -INFINITY) ? 1.0f : __builtin_amdgcn_exp2f(m - mn);
        const float msub = (mn == -INFINITY) ? 0.0f : mn;
        float rs = 0.f;
#pragma unroll
        for (int i = 0; i < 16; ++i) { sc[i] = __builtin_amdgcn_exp2f(sc[i] - msub); rs += sc[i]; }
        rs += xor32f(rs);
        l = l * alpha + rs; m = mn;
#pragma unroll
        for (int i = 0; i < 16; ++i) { o0[i] *= alpha; o1[i] *= alpha; }
        u32x4 pw[2];
#pragma unroll
        for (int s = 0; s < 2; ++s) { pw[s].x = cvtpk(sc[8 * s + 0], sc[8 * s + 1]); pw[s].y = cvtpk(sc[8 * s + 2], sc[8 * s + 3]); pw[s].z = cvtpk(sc[8 * s + 4], sc[8 * s + 5]); pw[s].w = cvtpk(sc[8 * s + 6], sc[8 * s + 7]); }
#pragma unroll
        for (int s = 0; s < 2; ++s) {
            bf16x8 a0, a1;
#pragma unroll
            for (int jj = 0; jj < 8; ++jj) { const bf16_t* vr = Vp + (size_t)(32 * j + 16 * s + 8 * (jj >> 2) + 4 * hi + (jj & 3)) * ldv + r32; a0[jj] = (short)vr[0]; a1[jj] = (short)vr[32]; }
            const bf16x8 pb = __builtin_bit_cast(bf16x8, pw[s]);
            o0 = __builtin_amdgcn_mfma_f32_32x32x16_bf16(a0, pb, o0, 0, 0, 0);
            o1 = __builtin_amdgcn_mfma_f32_32x32x16_bf16(a1, pb, o1, 0, 0, 0);
        }
    }
    const float rl = 1.0f / l;
    bf16_t* orow = Op + (size_t)r32 * ldo;
#pragma unroll
    for (int g = 0; g < 4; ++g) {
        u32x2 w0, w1; w0.x = cvtpk(o0[4 * g] * rl, o0[4 * g + 1] * rl); w0.y = cvtpk(o0[4 * g + 2] * rl, o0[4 * g + 3] * rl);
        w1.x = cvtpk(o1[4 * g] * rl, o1[4 * g + 1] * rl); w1.y = cvtpk(o1[4 * g + 2] * rl, o1[4 * g + 3] * rl);
        *(u32x2*)(orow + 8 * g + 4 * hi) = w0; *(u32x2*)(orow + 32 + 8 * g + 4 * hi) = w1;
    }
}

__device__ __forceinline__ void swa_item(Frame& F, int b, int qb) {
    const int h = F.wave, kvh = h >> 2;
    const float sink = F.sinks[h] * LOG2E;
    const bf16_t* Kp = WSP(const bf16_t, WS_KS) + (size_t)b * SEQ * 128 + kvh * 64;
    const bf16_t* Vp = WSP(const bf16_t, WS_VS) + (size_t)b * SEQ * 128 + kvh * 64;
    for (int sub = 0; sub < 4; ++sub) {
        const int q0 = qb * 128 + 32 * sub; const int jhi = q0 / 32 + 1; int jlo = jhi - 5; if (jlo < 0) jlo = 0;
        attn32<1>(WSP(const bf16_t, WS_QS) + ((size_t)b * SEQ + q0) * 512 + h * 64, 512, Kp, 128, Vp, 128, jlo, jhi, q0, sink, WSP(bf16_t, WS_OCAT) + ((size_t)b * SEQ + q0) * DM + h * 64, DM, F.lane);
    }
}
__device__ __forceinline__ void mem_item(Frame& F, int b, int qb) {
    const int h = F.wave & 3, half = F.wave >> 2;
    const bf16_t* Kp = WSP(const bf16_t, WS_MK) + (size_t)b * MEMLEN * 256 + h * 64;
    const bf16_t* Vp = WSP(const bf16_t, WS_MV) + (size_t)b * MEMLEN * 256 + h * 64;
    for (int sub = 0; sub < 2; ++sub) {
        const int q0 = qb * 128 + 64 * half + 32 * sub;
        attn32<0>(WSP(const bf16_t, WS_QM) + ((size_t)b * SEQ + q0) * 256 + h * 64, 256, Kp, 256, Vp, 256, 0, MEMLEN / 32, 0, 0.f, WSP(bf16_t, WS_OCAT) + ((size_t)b * SEQ + q0) * DM + 768 + h * 64, DM, F.lane);
    }
}


constexpr int DSA_CAP = 512;
constexpr int MAXLD = 1026;
constexpr int CKLD = 513, CILD = 514;
constexpr int DL_MAX = 0;
constexpr int DL_CKEY = 0;
constexpr int DL_CIDX = 65664;
constexpr int DL_VS = 0;
constexpr int DL_CNT = 98560;
constexpr int DL_HIST = 99584;
constexpr int DL_SEL = 107776;
typedef short v4i16_t __attribute__((ext_vector_type(4)));
__device__ __forceinline__ unsigned fkey(float f) { const unsigned u = __float_as_uint(f); return (u & 0x80000000u) ? ~u : (u | 0x80000000u); }
__device__ __forceinline__ float fkey_inv(unsigned k) { return __uint_as_float((k & 0x80000000u) ? (k & 0x7fffffffu) : ~k); }
__device__ __forceinline__ void glds16(const void* gsrc, unsigned lds_dst) { unsigned keep;
    asm volatile("s_mov_b32 %0, m0\n\ts_mov_b32 m0, %2\n\ts_nop 0\n\tglobal_load_lds_dwordx4 %1, off\n\ts_mov_b32 m0, %0" : "=&s"(keep) : "v"(gsrc), "s"(lds_dst) : "memory"); }

template <int NV, int ROUNDS> __device__ __forceinline__ unsigned radix_kth(const unsigned (&v)[NV], int count, LAS unsigned* hist, int k, int lane, int& k_out, int& ceq_out) {
    unsigned prefix = 0u; int ceq = 0;
#pragma unroll
    for (int r = ROUNDS - 1; r >= 0; --r) {
        const int shift = 8 * r;
        *(LAS u32x4*)(hist + 4 * lane) = (u32x4){0u, 0u, 0u, 0u};
        LDS_WAIT();
#pragma unroll
        for (int i = 0; i < NV; ++i) { const bool ok = (lane + 64 * i < count) && (r == ROUNDS - 1 || (v[i] >> (shift + 8)) == (prefix >> (shift + 8)));
            if (ok) __hip_atomic_fetch_add(hist + ((v[i] >> shift) & 255u), 1u, __ATOMIC_RELAXED, __HIP_MEMORY_SCOPE_WORKGROUP); }
        LDS_WAIT();
        const u32x4 h = *(const LAS u32x4*)(hist + 4 * lane);
        const unsigned s = (h.x + h.y) + (h.z + h.w);
        unsigned Tl = s;
#pragma unroll
        for (int o = 1; o < 64; o <<= 1) { const unsigned t = __shfl_down(Tl, o); if (lane + o < 64) Tl += t; }
        const unsigned long long bal = __ballot(Tl >= (unsigned)k);
        const int ls = bal ? 63 - __clzll(bal) : 0;
        const unsigned above = Tl - s, c3 = above + h.w, c2 = c3 + h.z, c1 = c2 + h.y;
        unsigned bin, kk, cb;
        if (c3 >= (unsigned)k) { bin = 3; kk = k - above; cb = h.w; } else if (c2 >= (unsigned)k) { bin = 2; kk = k - c3; cb = h.z; } else if (c1 >= (unsigned)k) { bin = 1; kk = k - c2; cb = h.y; } else { bin = 0; kk = k - c1; cb = h.x; }
        const unsigned digit = (unsigned)__builtin_amdgcn_readlane((int)(bin + 4u * lane), ls);
        k = __builtin_amdgcn_readlane((int)kk, ls); ceq = __builtin_amdgcn_readlane((int)cb, ls);
        prefix |= digit << shift;
    }
    k_out = k; ceq_out = ceq; return prefix;
}

__device__ __forceinline__ void dsa_item(Frame& F, int b, int t0) {
    const int lane = F.lane, wid = F.wave, r32 = lane & 31, hi = lane >> 5;
    LAS unsigned short* maxbuf = (LAS unsigned short*)(F.lds + DL_MAX);
    LAS unsigned* ckey = (LAS unsigned*)(F.lds + DL_CKEY);
    LAS unsigned short* cidx = (LAS unsigned short*)(F.lds + DL_CIDX);
    LAS unsigned* ccnt = (LAS unsigned*)(F.lds + DL_CNT);
    LAS unsigned* ctau = ccnt + 32;
    LAS unsigned* hist = (LAS unsigned*)(F.lds + DL_HIST) + wid * 256;
    LAS unsigned short* sel = (LAS unsigned short*)(F.lds + DL_SEL);
    const size_t rowb = (size_t)b * SEQ;
    unsigned char* wsl = F.ws; asm volatile("" : "+s"(wsl));
#define WSL(T_, off) ((GAS T_*)(wsl + (off)))
    __syncthreads();
#ifndef REP_SEL
#define REP_SEL 1
#endif
#ifndef REP_GATHER
#define REP_GATHER 1
#endif
    for (int rep_ = 0; rep_ < REP_SEL; ++rep_) {
    if (rep_) __syncthreads();
    if (t0 >= TOPK) {
        const int nkt = t0 / 32 + 1, nmax = t0 + 32;
        int lg = 0; while ((1024 << lg) < nmax) ++lg;
        const int npl = 16 >> lg;
        bf16x8 qf[4][4]; float wq[4];
        { const GAS bf16_t* qrow = WSL(const bf16_t, WS_QI) + (rowb + t0 + r32) * 256 + 8 * hi;
#pragma unroll
          for (int h = 0; h < 4; ++h)
#pragma unroll
              for (int s = 0; s < 4; ++s) qf[h][s] = *(const GAS bf16x8*)(qrow + h * 64 + 16 * s);
          const f32x4 w4 = *(const GAS f32x4*)(WSL(const float, WS_WI) + (rowb + t0 + r32) * 4); wq[0] = w4[0]; wq[1] = w4[1]; wq[2] = w4[2]; wq[3] = w4[3]; }
        if (F.tid < 32) ccnt[F.tid] = 0u;
        const GAS bf16_t* kbase = WSL(const bf16_t, WS_KI) + (rowb + r32) * 64 + 8 * hi;
        float thrf = 0.f;
        for (int pass = 0; pass < 2; ++pass) {
            if (pass == 1) thrf = fkey_inv(ctau[r32] << 16);
            bf16x8 kn[4];
            if (wid < nkt) {
#pragma unroll
                for (int s = 0; s < 4; ++s) kn[s] = *(const GAS bf16x8*)(kbase + (size_t)(32 * wid) * 64 + 16 * s);
            }
            for (int j = wid; j < nkt; j += NWAVES) {
                bf16x8 kf[4];
#pragma unroll
                for (int s = 0; s < 4; ++s) kf[s] = kn[s];
                if (j + NWAVES < nkt) {
#pragma unroll
                    for (int s = 0; s < 4; ++s) kn[s] = *(const GAS bf16x8*)(kbase + (size_t)(32 * (j + NWAVES)) * 64 + 16 * s);
                }
                float sc[16];
                {
                    f32x16 da = {}, db = {};
#pragma unroll
                    for (int s = 0; s < 4; ++s) da = __builtin_amdgcn_mfma_f32_32x32x16_bf16(kf[s], qf[0][s], da, 0, 0, 0);
#pragma unroll
                    for (int s = 0; s < 4; ++s) db = __builtin_amdgcn_mfma_f32_32x32x16_bf16(kf[s], qf[1][s], db, 0, 0, 0);
#pragma unroll
                    for (int i = 0; i < 16; ++i) { const int di = __float_as_int(da[i]); sc[i] = __int_as_float(di > 0 ? di : 0) * wq[0]; }
                    da = (f32x16){};
#pragma unroll
                    for (int s = 0; s < 4; ++s) da = __builtin_amdgcn_mfma_f32_32x32x16_bf16(kf[s], qf[2][s], da, 0, 0, 0);
#pragma unroll
                    for (int i = 0; i < 16; ++i) { const int di = __float_as_int(db[i]); sc[i] = fmaf(__int_as_float(di > 0 ? di : 0), wq[1], sc[i]); }
                    db = (f32x16){};
#pragma unroll
                    for (int s = 0; s < 4; ++s) db = __builtin_amdgcn_mfma_f32_32x32x16_bf16(kf[s], qf[3][s], db, 0, 0, 0);
#pragma unroll
                    for (int i = 0; i < 16; ++i) { const int di = __float_as_int(da[i]); sc[i] = fmaf(__int_as_float(di > 0 ? di : 0), wq[2], sc[i]); }
#pragma unroll
                    for (int i = 0; i < 16; ++i) { const int di = __float_as_int(db[i]); sc[i] = fmaf(__int_as_float(di > 0 ? di : 0), wq[3], sc[i]); }
                }
                if (j == nkt - 1) { const int dlim = r32 - 4 * hi;
#pragma unroll
                    for (int i = 0; i < 16; ++i) if ((i & 3) + 8 * (i >> 2) > dlim) sc[i] = -INFINITY;
                }
                if (pass == 0) {
                    LAS unsigned short* mb = maxbuf + r32 * MAXLD + (j * 2 + hi) * npl;
                    if (lg == 0) {
#pragma unroll
                        for (int i = 0; i < 16; ++i) mb[i] = (unsigned short)(fkey(sc[i]) >> 16);
                    } else {
                        float m2[8];
#pragma unroll
                        for (int i = 0; i < 8; ++i) m2[i] = fmaxf(sc[2 * i], sc[2 * i + 1]);
                        if (lg == 1) {
#pragma unroll
                            for (int i = 0; i < 8; ++i) mb[i] = (unsigned short)(fkey(m2[i]) >> 16);
                        } else if (lg == 2) {
#pragma unroll
                            for (int i = 0; i < 4; ++i) mb[i] = (unsigned short)(fkey(fmaxf(m2[2 * i], m2[2 * i + 1])) >> 16);
                        } else {
                            mb[0] = (unsigned short)(fkey(fmaxf(fmaxf(m2[0], m2[1]), fmaxf(m2[2], m2[3]))) >> 16);
                            mb[1] = (unsigned short)(fkey(fmaxf(fmaxf(m2[4], m2[5]), fmaxf(m2[6], m2[7]))) >> 16);
                        }
                    }
                } else {
                    int cntl = 0;
#pragma unroll
                    for (int i = 0; i < 16; ++i) cntl += (sc[i] >= thrf) ? 1 : 0;
                    if (__ballot(cntl > 0)) {
                        unsigned slot = 0u;
                        if (cntl > 0) slot = __hip_atomic_fetch_add(ccnt + r32, (unsigned)cntl, __ATOMIC_RELAXED, __HIP_MEMORY_SCOPE_WORKGROUP);
                        LAS unsigned* ck = ckey + r32 * CKLD; LAS unsigned short* ci = cidx + r32 * CILD; const int ib = 32 * j + 4 * hi;
#pragma unroll
                        for (int i = 0; i < 16; ++i) {
                            if (sc[i] >= thrf) { const unsigned sl = slot < (unsigned)(DSA_CAP - 1) ? slot : (unsigned)(DSA_CAP - 1);
                                ck[sl] = fkey(sc[i]); ci[sl] = (unsigned short)(ib + ((i & 3) + 8 * (i >> 2))); ++slot; }
                        }
                    }
                }
            }
            __syncthreads();
            if (pass == 0) {
                const int G = nmax >> lg;
                for (int jq = 0; jq < 4; ++jq) { const int q = wid * 4 + jq;
                    unsigned v[16];
#pragma unroll
                    for (int i = 0; i < 16; ++i) { const int e = lane + 64 * i; v[i] = e < G ? (unsigned)maxbuf[q * MAXLD + e] : 0u; }
                    int ko, ce; const unsigned tau = radix_kth<16, 2>(v, G, hist, TOPK, lane, ko, ce);
                    if (lane == 0) ctau[q] = tau;
                }
                __syncthreads();
            }
        }
        for (int jq = 0; jq < 4; ++jq) { const int q = wid * 4 + jq;
            int c = (int)ccnt[q]; if (c > DSA_CAP) c = DSA_CAP;
            unsigned kv[8], ix[8];
#pragma unroll
            for (int i = 0; i < 8; ++i) { const int e = lane + 64 * i; kv[i] = e < c ? ckey[q * CKLD + e] : 0u; ix[i] = e < c ? (unsigned)cidx[q * CILD + e] : 0xffffu; }
            int k, ceq; const unsigned thr = radix_kth<8, 4>(kv, c, hist, TOPK, lane, k, ceq);
            unsigned ti = 0xffffu;
            if (ceq > k) {
                unsigned pi = 0u; int kk = k;
                for (int bit = 15; bit >= 0; --bit) { const unsigned test = pi >> bit; int cnt = 0;
#pragma unroll
                    for (int i = 0; i < 8; ++i) cnt += __popcll(__ballot(kv[i] == thr && (ix[i] >> bit) == test));
                    if (cnt < kk) { kk -= cnt; pi |= (1u << bit); } }
                ti = pi;
            }
            *(LAS u32x4*)(hist + 4 * lane) = (u32x4){0u, 0u, 0u, 0u};
            LDS_WAIT();
#pragma unroll
            for (int i = 0; i < 8; ++i) if (kv[i] > thr || (kv[i] == thr && ix[i] <= ti)) __hip_atomic_fetch_or(hist + (ix[i] >> 5), 1u << (ix[i] & 31), __ATOMIC_RELAXED, __HIP_MEMORY_SCOPE_WORKGROUP);
            LDS_WAIT();
            const u32x4 w4 = *(const LAS u32x4*)(hist + 4 * lane);
            const unsigned w[4] = {w4.x, w4.y, w4.z, w4.w};
            const int n = (__popc(w[0]) + __popc(w[1])) + (__popc(w[2]) + __popc(w[3]));
            int pos = n;
#pragma unroll
            for (int o = 1; o < 64; o <<= 1) { const int t = __shfl_up(pos, o); if (lane >= o) pos += t; }
            pos -= n;
#pragma unroll
            for (int i = 0; i < 4; ++i) { unsigned ww = w[i]; while (ww) { const int bpos = __ffs((int)ww) - 1; ww &= ww - 1; if (pos < TOPK) sel[q * 256 + pos] = (unsigned short)(lane * 128 + i * 32 + bpos); ++pos; } }
            LDS_WAIT();
        }
    } else {
        for (int e = F.tid; e < 32 * 256; e += NWAVES * 64) sel[e] = (unsigned short)(e & 255);
    }
    }
    __syncthreads();
    const int c16 = lane & 15, g4 = lane >> 4;
    const GAS bf16_t* Kd = WSL(const bf16_t, WS_KD) + rowb * 64;
    const GAS bf16_t* Vd = WSL(const bf16_t, WS_VD) + rowb * 64;
    const unsigned vs_base = (unsigned)(uintptr_t)(F.lds + DL_VS) + (unsigned)wid * 12288u;
    const LAS unsigned char* vs_ptr = F.lds + DL_VS + wid * 12288;
    const int tr_off = (4 * g4 + (c16 >> 2)) * 128 + (c16 & 3) * 8;
    for (int rep_ = 0; rep_ < REP_GATHER; ++rep_)
    for (int jq = 0; jq < 4; ++jq) { const int q = wid * 4 + jq, t = t0 + q; const int nsel = t + 1 < TOPK ? t + 1 : TOPK;
        const LAS unsigned short* selq = sel + q * 256;
#define DSA_VDMA(u) do { _Pragma("unroll") for (int p_ = 0; p_ < 4; ++p_) { const int kidx_ = (int)selq[32 * (u) + 8 * p_ + (lane >> 3)]; \
            glds16((const void*)(Vd + (size_t)kidx_ * 64 + (lane & 7) * 8), (unsigned)__builtin_amdgcn_readfirstlane(vs_base + (unsigned)(((u) % 3) * 4096 + p_ * 1024))); } } while (0)
        asm volatile("s_waitcnt lgkmcnt(0)" ::: "memory");
        DSA_VDMA(0); DSA_VDMA(1); DSA_VDMA(2);
        bf16x8 qf[2];
        { const GAS bf16_t* qrow = WSL(const bf16_t, WS_QD) + (rowb + t) * 256 + (c16 & 3) * 64 + 8 * g4;
          qf[0] = *(const GAS bf16x8*)qrow; qf[1] = *(const GAS bf16x8*)(qrow + 32);
          if (c16 >= 4) { qf[0] = (bf16x8){0, 0, 0, 0, 0, 0, 0, 0}; qf[1] = qf[0]; } }
        bf16x8 kf[4][2], kn[4][2];
#define DSA_KLOAD(dst, ch_) do { _Pragma("unroll") for (int kb = 0; kb < 4; ++kb) { const int kidx = (int)selq[64 * (ch_) + 16 * kb + c16]; const GAS bf16_t* kr = Kd + (size_t)kidx * 64 + 8 * g4; dst[kb][0] = *(const GAS bf16x8*)kr; dst[kb][1] = *(const GAS bf16x8*)(kr + 32); } } while (0)
        DSA_KLOAD(kf, 0);
        float mrun = -INFINITY, l = 0.f;
        f32x4 O[4];
#pragma unroll
        for (int db = 0; db < 4; ++db) O[db] = (f32x4){0.f, 0.f, 0.f, 0.f};
#pragma unroll
        for (int ch = 0; ch < 4; ++ch) {
            if (ch + 1 < 4) DSA_KLOAD(kn, ch + 1);
            asm volatile("" ::: "memory");
            f32x4 S[4];
#pragma unroll
            for (int kb = 0; kb < 4; ++kb) { f32x4 a = {0.f, 0.f, 0.f, 0.f};
                a = __builtin_amdgcn_mfma_f32_16x16x32_bf16(kf[kb][0], qf[0], a, 0, 0, 0); a = __builtin_amdgcn_mfma_f32_16x16x32_bf16(kf[kb][1], qf[1], a, 0, 0, 0); S[kb] = a; }
            if (nsel < TOPK) { const int nlim = nsel - 4 * g4;
#pragma unroll
                for (int kb = 0; kb < 4; ++kb)
#pragma unroll
                    for (int r = 0; r < 4; ++r) if (64 * ch + 16 * kb + r >= nlim) S[kb][r] = -INFINITY;
            }
            float cm = fmaxf(fmaxf(S[0][0], S[0][1]), fmaxf(S[0][2], S[0][3]));
#pragma unroll
            for (int kb = 1; kb < 4; ++kb) cm = fmaxf(cm, fmaxf(fmaxf(S[kb][0], S[kb][1]), fmaxf(S[kb][2], S[kb][3])));
            cm = fmaxf(cm, __shfl_xor(cm, 16)); cm = fmaxf(cm, __shfl_xor(cm, 32));
            const float mn = fmaxf(mrun, cm);
            const float alpha = __builtin_amdgcn_exp2f(mrun - mn);
            mrun = mn;
            float ps = 0.f;
#pragma unroll
            for (int kb = 0; kb < 4; ++kb)
#pragma unroll
                for (int r = 0; r < 4; ++r) { S[kb][r] = __builtin_amdgcn_exp2f(S[kb][r] - mn); ps += S[kb][r]; }
            l = l * alpha + ps;
#pragma unroll
            for (int db = 0; db < 4; ++db) O[db] = O[db] * alpha;
#pragma unroll
            for (int u2 = 0; u2 < 2; ++u2) { const int u = 2 * ch + u2;
                u32x4 pw; pw.x = cvtpk(S[2 * u2][0], S[2 * u2][1]); pw.y = cvtpk(S[2 * u2][2], S[2 * u2][3]); pw.z = cvtpk(S[2 * u2 + 1][0], S[2 * u2 + 1][1]); pw.w = cvtpk(S[2 * u2 + 1][2], S[2 * u2 + 1][3]);
                const bf16x8 pb = __builtin_bit_cast(bf16x8, pw);
                if (u == 3) asm volatile("s_waitcnt vmcnt(12)" ::: "memory");
                else if (u == 5) asm volatile("s_waitcnt vmcnt(16)" ::: "memory");
                else if (u == 6) asm volatile("s_waitcnt vmcnt(12)" ::: "memory");
                else if (u == 7) asm volatile("s_waitcnt vmcnt(0)" ::: "memory");
                const LAS unsigned char* sp = vs_ptr + (u % 3) * 4096 + tr_off;
#pragma unroll
                for (int db = 0; db < 4; ++db) {
                    const v4i16_t lo = __builtin_amdgcn_ds_read_tr16_b64_v4i16((LAS v4i16_t*)(sp + db * 32));
                    const v4i16_t hv = __builtin_amdgcn_ds_read_tr16_b64_v4i16((LAS v4i16_t*)(sp + db * 32 + 2048));
                    const bf16x8 va = (bf16x8){lo[0], lo[1], lo[2], lo[3], hv[0], hv[1], hv[2], hv[3]};
                    O[db] = __builtin_amdgcn_mfma_f32_16x16x32_bf16(va, pb, O[db], 0, 0, 0);
                }
                if (u + 3 < 8) { asm volatile("s_waitcnt lgkmcnt(0)" ::: "memory"); DSA_VDMA(u + 3); }
            }
#pragma unroll
            for (int kb = 0; kb < 4; ++kb) { kf[kb][0] = kn[kb][0]; kf[kb][1] = kn[kb][1]; }
        }
        l += __shfl_xor(l, 16); l += __shfl_xor(l, 32);
#undef DSA_KLOAD
#undef DSA_VDMA
        if (c16 < 4) {
            const float rl = 1.0f / l;
            GAS bf16_t* orow = WSL(bf16_t, WS_OCAT) + (rowb + t) * DM + 512 + c16 * 64 + 4 * g4;
#pragma unroll
            for (int db = 0; db < 4; ++db) { u32x2 w; w.x = cvtpk(O[db][0] * rl, O[db][1] * rl); w.y = cvtpk(O[db][2] * rl, O[db][3] * rl); *(GAS u32x2*)(orow + 16 * db) = w; }
        }
    }
}
#undef WSL

__device__ __forceinline__ void p2_attention(Frame& F) {
    const int NIT = NB * (SEQ / 32);
#ifndef REP_DSA
#define REP_DSA 1
#endif
#ifndef REP_SWAMEM
#define REP_SWAMEM 1
#endif
    for (int rep = 0; rep < REP_DSA; ++rep)
    for (int r = 0; r < (NIT + F.G - 1) / F.G; ++r) {
        int b, tile;
        if (F.G == 256) { const int j = F.vcu & 63; b = F.vcu >> 6; tile = r == 0 ? j : (r == 1 ? 127 - j : (r == 2 ? 128 + j : 255 - j)); }
        else { const int it = r * F.G + F.vcu; if (it >= NIT) break; b = it / (SEQ / 32); tile = it % (SEQ / 32); }
        dsa_item(F, b, tile * 32);
    }
    for (int rep = 0; rep < REP_SWAMEM; ++rep) {
    for (int it = F.vcu; it < NB * (SEQ / 128); it += F.G) swa_item(F, it / (SEQ / 128), it % (SEQ / 128));
    for (int it = F.vcu; it < NB * (SEQ / 128); it += F.G) mem_item(F, it / (SEQ / 128), it % (SEQ / 128));
    }
}

#ifndef MK_N_LAUNCHES
#define MK_N_LAUNCHES 1
#endif
constexpr int N_PHASES = 8;
struct Args { const void* in[17]; float* out; unsigned char* ws; int ph_lo, ph_hi, li, pad; };

__global__ void __launch_bounds__(NWAVES * 64, 2) hybrid_fwd(Args args) {
    extern __shared__ __attribute__((aligned(16))) unsigned char lds[];
    Frame F;
    F.lds = (LAS unsigned char*)lds;
    F.MISC = (volatile LAS unsigned*)(F.lds + MISC_OFF);
    F.tid = threadIdx.x; F.lane = F.tid & 63; F.wave = __builtin_amdgcn_readfirstlane(F.tid >> 6);
    F.G = gridDim.x; { const int bx = blockIdx.x; F.vcu = (F.G % 8 == 0) ? (bx % 8) * (F.G / 8) + bx / 8 : bx; }
    F.ws = args.ws; F.ctl = (unsigned*)(args.ws + WS_CTL);
    F.x = (const float*)args.in[0]; F.mem = (const float*)args.in[1]; F.positions = (const int*)args.in[2]; F.g_mix = (const float*)args.in[3]; F.w_in = (const float*)args.in[4];
    F.b_gate = (const float*)args.in[5]; F.sinks = (const float*)args.in[6]; F.g_mem = (const float*)args.in[7]; F.w_mem_kv = (const float*)args.in[8]; F.w_proj_swa = (const float*)args.in[9];
    F.w_proj_dsa = (const float*)args.in[10]; F.w_proj_mem = (const float*)args.in[11]; F.w_out = (const float*)args.in[12]; F.g_mlp = (const float*)args.in[13]; F.w_mlp_in = (const float*)args.in[14];
    F.w_mlp_out = (const float*)args.in[15]; F.g_final = (const float*)args.in[16]; F.out = args.out;
    for (int u = F.tid; u < (LDS_BYTES - LDSCTL_OFF) / 4; u += NWAVES * 64) ((LAS unsigned*)(F.lds + LDSCTL_OFF))[u] = 0u;
    __syncthreads();
    XcdBarrier bar; bar.bar = F.ctl + CW_BAR + args.li * XCD_BAR_WORDS; bar.x = 0; bar.st = nullptr;
    if (args.ph_hi - args.ph_lo > 1) bar = xcd_barrier_post(F.ctl + CW_BAR + args.li * XCD_BAR_WORDS, F.MISC + 8);
    const int lo = args.ph_lo, hi = args.ph_hi;
#ifndef PHASE_MASK
#define PHASE_MASK 0xff
#endif
#define IN(k) (((PHASE_MASK >> (k)) & 1) && lo <= (k) && (k) < hi)
#define BOTH(k) (IN(k) && IN((k) + 1))
#define GRID_BAR() xcd_barrier(bar)
    const int bx = (int)blockIdx.x;

    if (IN(0)) { p0_prologue(F); if (BOTH(0)) GRID_BAR(); }

    if (IN(1)) {
        SchedInProj S; S.nM = T / 256; S.nN = NPOS / 256; S.nwg = S.nM * S.nN; S.G = F.G; S.c = bx;
        S.Ab = (const char*)WSP(bf16_t, WS_XB); S.Bb = (const char*)WSP(bf16_t, WS_WIN); S.Am = (const char*)WSP(bf16_t, WS_MEMB); S.Bm = (const char*)WSP(bf16_t, WS_WMEM);
        EpiInProj E; E.inv_rms = WSP(float, WS_INVRMS0); E.inv_rms_mem = WSP(float, WS_INVRMSM); E.cs = WSP(float, WS_CS); E.b_gate = F.b_gate;
        E.q_s = WSP(bf16_t, WS_QS); E.k_s = WSP(bf16_t, WS_KS); E.v_s = WSP(bf16_t, WS_VS); E.q_d = WSP(bf16_t, WS_QD); E.k_d = WSP(bf16_t, WS_KD); E.v_d = WSP(bf16_t, WS_VD);
        E.q_i = WSP(bf16_t, WS_QI); E.k_i = WSP(bf16_t, WS_KI); E.q_m = WSP(bf16_t, WS_QM); E.gates = WSP(bf16_t, WS_GATES); E.mk = WSP(bf16_t, WS_MK); E.mv = WSP(bf16_t, WS_MV); E.w_i = WSP(float, WS_WI);
        pg8::gemm_phase<EpiInProj, SchedInProj, true>(F.lds + RING_OFF, DM, DM, S, E);
        if (BOTH(1)) GRID_BAR();
    }

    if (IN(2)) { p2_attention(F); if (BOTH(2)) GRID_BAR(); }

    if (IN(3)) {
        SchedMerge S; S.G = F.G; S.c = bx; S.Ab = (const char*)WSP(bf16_t, WS_OCAT); S.Bb = (const char*)WSP(bf16_t, WS_WPROJ);
        EpiMerge E; E.gates = WSP(bf16_t, WS_GATES); E.merged = WSP(bf16_t, WS_MERGED);
        pg8::gemm_phase<EpiMerge, SchedMerge, true>(F.lds + RING_OFF, DM, DM, S, E);
        if (BOTH(3)) GRID_BAR();
    }

    if (IN(4)) {
        SchedGrid S; S.nM = T / 256; S.nN = DM / 256; S.nwg = S.nM * S.nN; S.G = F.G; S.c = bx; S.nt = DM / 64;
        S.Ab = (const char*)WSP(bf16_t, WS_MERGED); S.Bb = (const char*)WSP(bf16_t, WS_WOUT); S.tA = (size_t)256 * DM * 2; S.tB = (size_t)256 * DM * 2;
        EpiResid<true> E; E.base = F.x; E.out = F.out; E.outb = WSP(bf16_t, WS_XB); E.ssq = WSP(float, WS_SSQ1);
        pg8::gemm_phase<EpiResid<true>, SchedGrid, true>(F.lds + RING_OFF, DM, DM, S, E);
        if (BOTH(4)) GRID_BAR();
    }

    if (IN(5)) {
        SchedGrid S; S.nM = T / 256; S.nN = DFF / 256; S.nwg = S.nM * S.nN; S.G = F.G; S.c = bx; S.nt = DM / 64;
        S.Ab = (const char*)WSP(bf16_t, WS_XB); S.Bb = (const char*)WSP(bf16_t, WS_W1); S.tA = (size_t)256 * DM * 2; S.tB = (size_t)256 * DM * 2;
        EpiMlpIn E; E.ssq = WSP(float, WS_SSQ1); E.hid = WSP(bf16_t, WS_HID);
        pg8::gemm_phase<EpiMlpIn, SchedGrid, true>(F.lds + RING_OFF, DM, DM, S, E);
        if (BOTH(5)) GRID_BAR();
    }

    if (IN(6)) {
        SchedGrid S; S.nM = T / 256; S.nN = DM / 256; S.nwg = S.nM * S.nN; S.G = F.G; S.c = bx; S.nt = DFF / 64;
        S.Ab = (const char*)WSP(bf16_t, WS_HID); S.Bb = (const char*)WSP(bf16_t, WS_W2); S.tA = (size_t)256 * DFF * 2; S.tB = (size_t)256 * DFF * 2;
        EpiResid<false> E; E.base = F.out; E.out = F.out; E.outb = nullptr; E.ssq = WSP(float, WS_SSQ2);
        pg8::gemm_phase<EpiResid<false>, SchedGrid, true>(F.lds + RING_OFF, DFF, DFF, S, E);
        if (BOTH(6)) GRID_BAR();
    }

    if (IN(7)) p7_final_norm(F);
#undef IN
#undef BOTH
#undef GRID_BAR
}

extern "C" void kernel_launch(void* const* d_in, const int* in_sizes, int n_in, void* d_out, int out_size, void* d_ws, size_t ws_size, hipStream_t stream) {
    static int grid = 0;
    if (grid == 0) {
        if (n_in != 17 || in_sizes[0] != T * DM || out_size != T * DM || ws_size < WS_END) { fprintf(stderr, "kernel_launch: unexpected shapes (n_in %d, in0 %d, out %d, ws %zu < %zu); nothing launched\n", n_in, n_in > 0 ? in_sizes[0] : -1, out_size, ws_size, (size_t)WS_END); grid = -1; return; }
        int dev = 0, cus = 0, per_cu = 0;
        if (hipGetDevice(&dev) != hipSuccess || hipDeviceGetAttribute(&cus, hipDeviceAttributeMultiprocessorCount, dev) != hipSuccess) { grid = -1; return; }
        if (hipFuncSetAttribute((const void*)hybrid_fwd, hipFuncAttributeMaxDynamicSharedMemorySize, LDS_BYTES) != hipSuccess) { fprintf(stderr, "kernel_launch: hipFuncSetAttribute failed\n"); grid = -1; return; }
        if (hipOccupancyMaxActiveBlocksPerMultiprocessor(&per_cu, (const void*)hybrid_fwd, NWAVES * 64, LDS_BYTES) != hipSuccess || per_cu < 1) { fprintf(stderr, "kernel_launch: occupancy query reports %d workgroups per CU; nothing launched\n", per_cu); (void)hipGetLastError(); grid = -1; return; }
        (void)hipGetLastError();
        grid = cus;
    }
    if (grid < 0) return;
    if (hipMemsetAsync((char*)d_ws + WS_CTL, 0, CTL_ZERO_BYTES, stream) != hipSuccess) return;
    Args a{};
    for (int i = 0; i < 17; ++i) a.in[i] = d_in[i];
    a.out = (float*)d_out; a.ws = (unsigned char*)d_ws;
    if (MK_N_LAUNCHES == 1) { a.ph_lo = 0; a.ph_hi = N_PHASES; a.li = 0; hipLaunchKernelGGL(hybrid_fwd, dim3(grid), dim3(NWAVES * 64), LDS_BYTES, stream, a); }
    else { for (int p = 0; p < N_PHASES; ++p) { a.ph_lo = p; a.ph_hi = p + 1; a.li = 0; hipLaunchKernelGGL(hybrid_fwd, dim3(grid), dim3(NWAVES * 64), LDS_BYTES, stream, a); } }
}
```

```cpp
#include <hip/hip_runtime.h>
#include <cstdio>
#include <cstdint>

#define LAS __attribute__((address_space(3)))
#define GAS __attribute__((address_space(1)))
typedef unsigned short bf16_t;
typedef short bf16x8 __attribute__((ext_vector_type(8)));
typedef float f32x2 __attribute__((ext_vector_type(2)));
typedef float f32x4 __attribute__((ext_vector_type(4)));
typedef float f32x16 __attribute__((ext_vector_type(16)));
typedef unsigned u32x2 __attribute__((ext_vector_type(2)));
typedef unsigned u32x4 __attribute__((ext_vector_type(4)));
typedef __bf16 bf16x2_t __attribute__((ext_vector_type(2)));

constexpr int NB = 4, SEQ = 8192, T = NB * SEQ, DM = 1024, DFF = 4096, DIN = 4804, NPOS = 4864, MEMLEN = 256, MROWS = NB * MEMLEN;
constexpr float EPS = 1e-6f;
constexpr float LOG2E = 1.4426950408889634f;
constexpr float QSCALE = 0.125f * LOG2E;
constexpr float IDX_SCALE = 0.0625f;
constexpr int TOPK = 256;
constexpr int P_QS = 0, P_KS = 512, P_VS = 640, P_QD = 768, P_KD = 1024, P_VD = 1088, P_QI = 1152, P_KI = 1408, P_QM = 1472, P_GATE = 1728, P_WI = 4800, P_END = 4804;

constexpr size_t MiB = 1u << 20;
constexpr size_t WS_CTL = 0, CTL_ZERO_BYTES = 1 * MiB;
constexpr size_t WS_WIN = 1 * MiB, WS_WMEM = 11 * MiB, WS_WPROJ = 12 * MiB, WS_WOUT = 14 * MiB, WS_W1 = 16 * MiB, WS_W2 = 24 * MiB;
constexpr size_t WS_INVRMS0 = 32 * MiB, WS_INVRMSM = 32 * MiB + 128 * 1024, WS_WI = 32 * MiB + 256 * 1024;
constexpr size_t WS_SSQ1 = 33 * MiB, WS_SSQ2 = 35 * MiB, WS_CS = 37 * MiB, WS_MEMB = 45 * MiB, WS_MK = 47 * MiB, WS_MV = 47 * MiB + 512 * 1024;
constexpr size_t WS_XB = 48 * MiB;
constexpr size_t WS_OCAT = 112 * MiB;
constexpr size_t WS_QS = 176 * MiB, WS_KS = 208 * MiB, WS_VS = 216 * MiB, WS_QD = 224 * MiB, WS_KD = 240 * MiB, WS_VD = 244 * MiB, WS_QI = 248 * MiB, WS_KI = 264 * MiB, WS_QM = 268 * MiB;
constexpr size_t WS_GATES = 284 * MiB;
constexpr size_t WS_MERGED = 176 * MiB;
constexpr size_t WS_HID = 176 * MiB;
constexpr size_t WS_END = 476 * MiB;
static_assert(WS_WIN + (size_t)NPOS * DM * 2 <= WS_WMEM && WS_GATES + (size_t)T * 3072 * 2 <= WS_END && WS_HID + (size_t)T * DFF * 2 <= WS_END, "d_ws map");
constexpr int CW_TMO = 0, CW_CODE = 1, CW_BAR = 4096;

constexpr int RING_OFF = 0, RING_BYTES = 131072;
constexpr int LDSCTL_OFF = RING_BYTES, MISC_OFF = LDSCTL_OFF + 320;
constexpr int LDS_BYTES = 147456;
constexpr int NWAVES = 8;

#define LDS_WAIT() asm volatile("s_waitcnt lgkmcnt(0)" ::: "memory")
#define VM_WAIT() asm volatile("s_waitcnt vmcnt(0)" ::: "memory")
#define RLX_AGENT __ATOMIC_RELAXED, __HIP_MEMORY_SCOPE_AGENT

__device__ __forceinline__ unsigned cvtpk(float lo, float hi) { f32x2 v = {lo, hi}; bf16x2_t b = __builtin_convertvector(v, bf16x2_t); return __builtin_bit_cast(unsigned, b); }
__device__ __forceinline__ float bf_lo(unsigned w) { return __uint_as_float(w << 16); }
__device__ __forceinline__ float bf_hi(unsigned w) { return __uint_as_float(w & 0xffff0000u); }
__device__ __forceinline__ float wave_sum(float v) {
#pragma unroll
    for (int o = 1; o < 64; o <<= 1) v += __shfl_xor(v, o);
    return v;
}
__device__ __forceinline__ float wave_max(float v) {
#pragma unroll
    for (int o = 1; o < 64; o <<= 1) v = fmaxf(v, __shfl_xor(v, o));
    return v;
}

namespace pg8 {
constexpr int BM = 256, BK = 64, HALF = 128, HTB = HALF * BK * 2  , STAGE_BYTES = 8 * HTB, NXCD = 8, WGM = 8;
__host__ __device__ __forceinline__ int lds_byte(int r, int c) { const int st = (r >> 4) * 2 + (c >> 5), rr = r & 15, cc = c & 31, ob = rr * 64 + cc * 2; return st * 1024 + (ob ^ (((ob >> 9) & 1) << 5)); }
__host__ __device__ __forceinline__ void stage_rc(int b, int& R, int& C) { const int st = b / 1024, sb = b % 1024, swz = sb ^ (((sb >> 9) & 1) << 5); R = (st >> 1) * 16 + swz / 64; C = (st & 1) * 32 + (swz % 64) / 2; }
__host__ __device__ __forceinline__ int perm32(int rho) { const int n = rho >> 4, i = rho & 15; return 8 * (i >> 2) + 4 * n + (i & 3); }

struct Unit { int pm, pn, kind, nt; const char* A; const char* B; };

__device__ __forceinline__ void map_tile(int L, int nM, int nN, int& pm, int& pn) {
    const int nwg = nM * nN;
    int wgid = L; { const int q = nwg / NXCD, r = nwg % NXCD, xcd = wgid % NXCD, off = wgid / NXCD; wgid = (xcd < r ? xcd * (q + 1) : r * (q + 1) + (xcd - r) * q) + off; }
    const int nig = WGM * nN, gid = wgid / nig, fm = gid * WGM, gsz = (nM - fm) < WGM ? (nM - fm) : WGM;
    pm = fm + ((wgid % nig) % gsz); pn = (wgid % nig) / gsz;
}

template <class Epi, class Sched, bool ALIGN_EPI>
__device__ __forceinline__ void gemm_phase(LAS unsigned char* lds, const int lda, const int ldb, const Sched& S, const Epi& E) {
    const int tid = threadIdx.x, wid = __builtin_amdgcn_readfirstlane(tid >> 6), lane = tid & 63, wr = wid >> 2, wc = wid & 3, fr = lane & 15, fq = lane >> 4;
    unsigned voffA[2], voffB[2];
#pragma unroll
    for (int i = 0; i < 2; ++i) { int R, C; stage_rc(tid * 16 + i * 8192, R, C); const int Rb = Epi::PERM ? ((R & ~31) + perm32(R & 31)) : R;
        voffA[i] = (unsigned)(R * lda + C) * 2u; voffB[i] = (unsigned)(Rb * ldb + C) * 2u; }
    const size_t kstep = (size_t)(BK * 2);
    const size_t hstepA = (size_t)HALF * lda * 2, hstepB = (size_t)HALF * ldb * 2;
    const unsigned ldsw = (unsigned)wid * 1024u;
    const int aoff = lds_byte(wr * 64 + fr, fq * 8), boff = lds_byte(wc * 32 + fr, fq * 8);
#define PG8_SA(b, h) (((b) * 2 + (h)) * HTB)
#define PG8_SB(b, h) ((4 + (b) * 2 + (h)) * HTB)
#define PG8_STAGE(bufoff, gbase, voff) do { _Pragma("unroll") for (int _i = 0; _i < 2; ++_i) \
        __builtin_amdgcn_global_load_lds((const unsigned*)((const char*)(gbase) + (voff)[_i]), (LAS unsigned*)(lds + (bufoff) + ldsw + _i * 8192), 16, 0, 0); } while (0)
#define PG8_LDA(dst, b, h) do { _Pragma("unroll") for (int m = 0; m < 4; ++m) _Pragma("unroll") for (int k = 0; k < 2; ++k) dst[m][k] = *(const LAS bf16x8*)(lds + PG8_SA(b, h) + aoff + m * 2048 + k * 1024); } while (0)
#define PG8_LDB(dst, b, h) do { _Pragma("unroll") for (int n = 0; n < 2; ++n) _Pragma("unroll") for (int k = 0; k < 2; ++k) dst[n][k] = *(const LAS bf16x8*)(lds + PG8_SB(b, h) + boff + n * 2048 + k * 1024); } while (0)
#define PG8_MMA(ai, bj, At, Bt) do { __builtin_amdgcn_s_setprio(1); _Pragma("unroll") for (int m = 0; m < 4; ++m) _Pragma("unroll") for (int n = 0; n < 2; ++n) _Pragma("unroll") for (int k = 0; k < 2; ++k) \
        acc[ai][bj][m][n] = __builtin_amdgcn_mfma_f32_16x16x32_bf16(Bt[n][k], At[m][k], acc[ai][bj][m][n], 0, 0, 0); __builtin_amdgcn_s_setprio(0); } while (0)
#define PG8_WAIT_V(n) asm volatile("s_waitcnt vmcnt(" #n ")" ::: "memory")
#define PG8_WAIT_L(n) asm volatile("s_waitcnt lgkmcnt(" #n ")" ::: "memory")
#define PG8_BAR __builtin_amdgcn_s_barrier()
#define PG8_SCHED __builtin_amdgcn_sched_barrier(0)
    Unit cur, nxt; int ui = 0;
    if (!S.next(0, cur)) return;
    f32x4 acc[2][2][4][2];
#pragma unroll
    for (int a = 0; a < 2; ++a)
#pragma unroll
        for (int b = 0; b < 2; ++b)
#pragma unroll
            for (int m = 0; m < 4; ++m)
#pragma unroll
                for (int n = 0; n < 2; ++n) acc[a][b][m][n] = (f32x4){0.f, 0.f, 0.f, 0.f};
    bf16x8 At[4][2], B0[2][2], B1[2][2];
    const char* cA = cur.A; const char* cB = cur.B;
    PG8_STAGE(PG8_SB(0, 0), cB, voffB); PG8_STAGE(PG8_SB(0, 1), cB + hstepB, voffB); PG8_STAGE(PG8_SA(0, 0), cA, voffA); PG8_STAGE(PG8_SA(0, 1), cA + hstepA, voffA);
    if (wr == 1) PG8_BAR;
    PG8_WAIT_V(2); PG8_BAR;
    PG8_STAGE(PG8_SB(1, 0), cB + kstep, voffB); PG8_STAGE(PG8_SA(1, 0), cA + kstep, voffA); PG8_STAGE(PG8_SB(1, 1), cB + hstepB + kstep, voffB);
    PG8_WAIT_V(6); PG8_BAR;
    for (;;) {
        const bool has_next = S.next(ui + 1, nxt);
        const char* nA = has_next ? nxt.A : cA; const char* nB = has_next ? nxt.B : cB;
        const int nt = cur.nt;
        for (int t = 0; t < nt; t += 2) {
            const bool last = (t == nt - 2);
            const char* a1 = cA + (size_t)(t + 1) * kstep;
            const char* a2 = last ? nA : cA + (size_t)(t + 2) * kstep; const char* b2 = last ? nB : cB + (size_t)(t + 2) * kstep;
            const char* a3 = a2 + kstep; const char* b3 = b2 + kstep;
            PG8_LDB(B0, 0, 0); PG8_LDB(B1, 0, 1); PG8_SCHED; PG8_LDA(At, 0, 0); PG8_STAGE(PG8_SA(1, 1), a1 + hstepA, voffA);
            PG8_WAIT_V(8); PG8_WAIT_L(0); PG8_BAR; PG8_MMA(0, 0, At, B0); PG8_MMA(0, 1, At, B1); PG8_BAR; PG8_SCHED;
            PG8_LDA(At, 0, 1); PG8_STAGE(PG8_SB(0, 0), b2, voffB); PG8_STAGE(PG8_SB(0, 1), b2 + hstepB, voffB); PG8_STAGE(PG8_SA(0, 0), a2, voffA);
            PG8_WAIT_V(8); PG8_WAIT_L(0); PG8_BAR; PG8_MMA(1, 0, At, B0); PG8_MMA(1, 1, At, B1); PG8_BAR; PG8_SCHED;
            PG8_LDB(B0, 1, 0); PG8_LDB(B1, 1, 1); PG8_SCHED; PG8_LDA(At, 1, 0); PG8_STAGE(PG8_SA(0, 1), a2 + hstepA, voffA);
            PG8_WAIT_V(8); PG8_WAIT_L(0); PG8_BAR; PG8_MMA(0, 0, At, B0); PG8_MMA(0, 1, At, B1); PG8_BAR; PG8_SCHED;
            PG8_LDA(At, 1, 1); PG8_STAGE(PG8_SB(1, 0), b3, voffB); PG8_STAGE(PG8_SB(1, 1), b3 + hstepB, voffB); PG8_STAGE(PG8_SA(1, 0), a3, voffA);
            PG8_WAIT_V(8); PG8_WAIT_L(0); PG8_BAR; PG8_MMA(1, 0, At, B0); PG8_MMA(1, 1, At, B1); PG8_BAR; PG8_SCHED;
        }
        if constexpr (ALIGN_EPI) { if (wr == 0) PG8_BAR; }
        E(acc, cur, wr, wc, fr, fq);
        if (!has_next) break;
#pragma unroll
        for (int a = 0; a < 2; ++a)
#pragma unroll
            for (int b = 0; b < 2; ++b)
#pragma unroll
                for (int m = 0; m < 4; ++m)
#pragma unroll
                    for (int n = 0; n < 2; ++n) acc[a][b][m][n] = (f32x4){0.f, 0.f, 0.f, 0.f};
        cur = nxt; cA = nA; cB = nB; ++ui;
        if constexpr (ALIGN_EPI) { if (wr == 1) PG8_BAR; }
    }
    PG8_WAIT_V(0);
    if constexpr (!ALIGN_EPI) { if (wr == 0) PG8_BAR; }
    PG8_BAR;
#undef PG8_SA
#undef PG8_SB
#undef PG8_STAGE
#undef PG8_LDA
#undef PG8_LDB
#undef PG8_MMA
#undef PG8_WAIT_V
#undef PG8_WAIT_L
#undef PG8_BAR
#undef PG8_SCHED
}
}

struct SchedGrid {
    int nM, nN, nwg, G, c, nt; const char* Ab; const char* Bb; size_t tA, tB;
    __device__ __forceinline__ bool next(int i, pg8::Unit& u) const {
        const long L = (long)i * G + c; if (L >= nwg) return false;
        pg8::map_tile((int)L, nM, nN, u.pm, u.pn); u.kind = 0; u.nt = nt; u.A = Ab + (size_t)u.pm * tA; u.B = Bb + (size_t)u.pn * tB; return true;
    }
};
struct SchedInProj {
    int nM, nN, nwg, G, c; const char* Ab; const char* Bb; const char* Am; const char* Bm;
    __device__ __forceinline__ bool next(int i, pg8::Unit& u) const {
        const long L = (long)i * G + c; if (L >= nwg + 8) return false;
        u.nt = DM / 64;
        if (L < nwg) { pg8::map_tile((int)L, nM, nN, u.pm, u.pn); u.kind = 0; u.A = Ab + (size_t)u.pm * (256 * DM * 2); u.B = Bb + (size_t)u.pn * (256 * DM * 2); }
        else { const int e = (int)(L - nwg); u.pm = e >> 1; u.pn = e & 1; u.kind = 1; u.A = Am + (size_t)u.pm * (256 * DM * 2); u.B = Bm + (size_t)u.pn * (256 * DM * 2); }
        return true;
    }
};
struct SchedMerge {
    int G, c; const char* Ab; const char* Bb;
    __device__ __forceinline__ bool next(int i, pg8::Unit& u) const {
        const int round = i / 3, br = i - 3 * round; const long L = (long)round * G + c; if (L >= 512) return false;
        pg8::map_tile((int)L, 128, 4, u.pm, u.pn); u.kind = br; u.nt = br == 0 ? 8 : 4;
        const int koff = br == 0 ? 0 : (br == 1 ? 512 : 768);
        u.A = Ab + (size_t)u.pm * (256 * DM * 2) + koff * 2; u.B = Bb + (size_t)u.pn * (256 * DM * 2) + koff * 2; return true;
    }
};

__device__ __forceinline__ float sigmoidf_fast(float x) { return __builtin_amdgcn_rcpf(1.0f + __builtin_amdgcn_exp2f(-x * LOG2E)); }

struct EpiInProj {
    static constexpr bool PERM = true;
    const float* inv_rms; const float* inv_rms_mem; const float* cs; const float* b_gate;
    bf16_t *q_s, *k_s, *v_s, *q_d, *k_d, *v_d, *q_i, *k_i, *q_m, *gates, *mk, *mv; float* w_i;
    __device__ __forceinline__ void operator()(const f32x4 (&acc)[2][2][4][2], const pg8::Unit& u, int wr, int wc, int fr, int fq) const {
        if (u.kind == 1) {
            bf16_t* dst = u.pn == 0 ? mk : mv;
#pragma unroll
            for (int ai = 0; ai < 2; ++ai)
#pragma unroll
                for (int m = 0; m < 4; ++m) { const int row = u.pm * 256 + ai * 128 + wr * 64 + m * 16 + fr; const float s = inv_rms_mem[row];
#pragma unroll
                    for (int bj = 0; bj < 2; ++bj) { const f32x4 v0 = acc[ai][bj][m][0] * s, v1 = acc[ai][bj][m][1] * s;
                        u32x4 w; w.x = cvtpk(v0[0], v0[1]); w.y = cvtpk(v0[2], v0[3]); w.z = cvtpk(v1[0], v1[1]); w.w = cvtpk(v1[2], v1[3]);
                        *(u32x4*)(dst + (size_t)row * 256 + bj * 128 + wc * 32 + 8 * fq) = w; } }
            return;
        }
#pragma unroll
        for (int bj = 0; bj < 2; ++bj) {
            const int pos0 = u.pn * 256 + bj * 128 + wc * 32;
            const int p = pos0 + 8 * fq;
            int kind; bf16_t* dst; int ld, sec0; float scl = 1.f;
            if (pos0 < P_KS)        { kind = 0; dst = q_s; ld = 512; sec0 = P_QS; scl = QSCALE; }
            else if (pos0 < P_VS)   { kind = 0; dst = k_s; ld = 128; sec0 = P_KS; }
            else if (pos0 < P_QD)   { kind = 1; dst = v_s; ld = 128; sec0 = P_VS; }
            else if (pos0 < P_KD)   { kind = 0; dst = q_d; ld = 256; sec0 = P_QD; scl = QSCALE; }
            else if (pos0 < P_VD)   { kind = 0; dst = k_d; ld = 64;  sec0 = P_KD; }
            else if (pos0 < P_QI)   { kind = 1; dst = v_d; ld = 64;  sec0 = P_VD; }
            else if (pos0 < P_KI)   { kind = 0; dst = q_i; ld = 256; sec0 = P_QI; }
            else if (pos0 < P_QM)   { kind = 0; dst = k_i; ld = 64;  sec0 = P_KI; }
            else if (pos0 < P_GATE) { kind = 1; dst = q_m; ld = 256; sec0 = P_QM; scl = QSCALE; }
            else if (pos0 < P_WI)   { kind = 2; dst = gates; ld = 3072; sec0 = P_GATE; }
            else                    { kind = 3; dst = nullptr; ld = 0; sec0 = P_WI; }
            const int lp = p - sec0;
            if (kind == 0) {
                const int head = lp >> 6, i0 = (lp & 63) >> 1;
#pragma unroll
                for (int ai = 0; ai < 2; ++ai)
#pragma unroll
                    for (int m = 0; m < 4; ++m) { const int row = u.pm * 256 + ai * 128 + wr * 64 + m * 16 + fr; const float s = inv_rms[row] * scl;
                        const f32x4 v0 = acc[ai][bj][m][0] * s, v1 = acc[ai][bj][m][1] * s;
                        const f32x4 ca = *(const f32x4*)(cs + (size_t)row * 64 + 2 * i0), cb = *(const f32x4*)(cs + (size_t)row * 64 + 2 * i0 + 4);
                        const float a0 = v0[0] * ca[0] - v0[1] * ca[1], b0 = v0[1] * ca[0] + v0[0] * ca[1];
                        const float a1 = v0[2] * ca[2] - v0[3] * ca[3], b1 = v0[3] * ca[2] + v0[2] * ca[3];
                        const float a2 = v1[0] * cb[0] - v1[1] * cb[1], b2 = v1[1] * cb[0] + v1[0] * cb[1];
                        const float a3 = v1[2] * cb[2] - v1[3] * cb[3], b3 = v1[3] * cb[2] + v1[2] * cb[3];
                        bf16_t* o = dst + (size_t)row * ld + head * 64 + i0;
                        u32x2 wa, wb; wa.x = cvtpk(a0, a1); wa.y = cvtpk(a2, a3); wb.x = cvtpk(b0, b1); wb.y = cvtpk(b2, b3);
                        *(u32x2*)o = wa; *(u32x2*)(o + 32) = wb; }
            } else if (kind == 1) {
#pragma unroll
                for (int ai = 0; ai < 2; ++ai)
#pragma unroll
                    for (int m = 0; m < 4; ++m) { const int row = u.pm * 256 + ai * 128 + wr * 64 + m * 16 + fr; const float s = inv_rms[row] * scl;
                        const f32x4 v0 = acc[ai][bj][m][0] * s, v1 = acc[ai][bj][m][1] * s;
                        u32x4 w; w.x = cvtpk(v0[0], v0[1]); w.y = cvtpk(v0[2], v0[3]); w.z = cvtpk(v1[0], v1[1]); w.w = cvtpk(v1[2], v1[3]);
                        *(u32x4*)(dst + (size_t)row * ld + lp) = w; }
            } else if (kind == 2) {
                const f32x4 g0 = *(const f32x4*)(b_gate + lp), g1 = *(const f32x4*)(b_gate + lp + 4);
#pragma unroll
                for (int ai = 0; ai < 2; ++ai)
#pragma unroll
                    for (int m = 0; m < 4; ++m) { const int row = u.pm * 256 + ai * 128 + wr * 64 + m * 16 + fr; const float s = inv_rms[row];
                        const f32x4 v0 = acc[ai][bj][m][0] * s + g0, v1 = acc[ai][bj][m][1] * s + g1;
                        u32x4 w; w.x = cvtpk(sigmoidf_fast(v0[0]), sigmoidf_fast(v0[1])); w.y = cvtpk(sigmoidf_fast(v0[2]), sigmoidf_fast(v0[3]));
                        w.z = cvtpk(sigmoidf_fast(v1[0]), sigmoidf_fast(v1[1])); w.w = cvtpk(sigmoidf_fast(v1[2]), sigmoidf_fast(v1[3]));
                        *(u32x4*)(dst + (size_t)row * ld + lp) = w; }
            } else {
                if (pos0 == P_WI && fq == 0) {
#pragma unroll
                    for (int ai = 0; ai < 2; ++ai)
#pragma unroll
                        for (int m = 0; m < 4; ++m) { const int row = u.pm * 256 + ai * 128 + wr * 64 + m * 16 + fr; const float s = inv_rms[row] * IDX_SCALE;
                            *(f32x4*)(w_i + (size_t)row * 4) = acc[ai][bj][m][0] * s; }
                }
            }
        }
    }
};

struct EpiMerge {
    static constexpr bool PERM = true;
    const bf16_t* gates; bf16_t* merged;
    __device__ __forceinline__ void operator()(const f32x4 (&acc)[2][2][4][2], const pg8::Unit& u, int wr, int wc, int fr, int fq) const {
        const int br = u.kind;
#pragma unroll
        for (int ai = 0; ai < 2; ++ai)
#pragma unroll
            for (int m = 0; m < 4; ++m) { const int row = u.pm * 256 + ai * 128 + wr * 64 + m * 16 + fr;
#pragma unroll
                for (int bj = 0; bj < 2; ++bj) { const int col = u.pn * 256 + bj * 128 + wc * 32 + 8 * fq;
                    const u32x4 g = *(const u32x4*)(gates + (size_t)row * 3072 + br * 1024 + col);
                    f32x4 v0 = acc[ai][bj][m][0], v1 = acc[ai][bj][m][1];
                    v0[0] *= bf_lo(g.x); v0[1] *= bf_hi(g.x); v0[2] *= bf_lo(g.y); v0[3] *= bf_hi(g.y); v1[0] *= bf_lo(g.z); v1[1] *= bf_hi(g.z); v1[2] *= bf_lo(g.w); v1[3] *= bf_hi(g.w);
                    bf16_t* o = merged + (size_t)row * 1024 + col;
                    if (br > 0) { const u32x4 pv = *(const u32x4*)o;
                        v0[0] += bf_lo(pv.x); v0[1] += bf_hi(pv.x); v0[2] += bf_lo(pv.y); v0[3] += bf_hi(pv.y); v1[0] += bf_lo(pv.z); v1[1] += bf_hi(pv.z); v1[2] += bf_lo(pv.w); v1[3] += bf_hi(pv.w); }
                    u32x4 w; w.x = cvtpk(v0[0], v0[1]); w.y = cvtpk(v0[2], v0[3]); w.z = cvtpk(v1[0], v1[1]); w.w = cvtpk(v1[2], v1[3]);
                    *(u32x4*)o = w; } }
    }
};

template <bool WRITE_BF> struct EpiResid {
    static constexpr bool PERM = false;
    const float* base; float* out; bf16_t* outb; float* ssq;
    __device__ __forceinline__ void operator()(const f32x4 (&acc)[2][2][4][2], const pg8::Unit& u, int wr, int wc, int fr, int fq) const {
#pragma unroll
        for (int ai = 0; ai < 2; ++ai)
#pragma unroll
            for (int m = 0; m < 4; ++m) { const int row = u.pm * 256 + ai * 128 + wr * 64 + m * 16 + fr; float q = 0.f;
#pragma unroll
                for (int bj = 0; bj < 2; ++bj)
#pragma unroll
                    for (int n = 0; n < 2; ++n) { const size_t off = (size_t)row * DM + u.pn * 256 + bj * 128 + wc * 32 + n * 16 + 4 * fq;
                        const f32x4 o = *(const f32x4*)(base + off) + acc[ai][bj][m][n];
                        *(f32x4*)(out + off) = o; q += (o[0] * o[0] + o[1] * o[1]) + (o[2] * o[2] + o[3] * o[3]);
                        if (WRITE_BF) { u32x2 w; w.x = cvtpk(o[0], o[1]); w.y = cvtpk(o[2], o[3]); *(u32x2*)(outb + off) = w; } }
                q += __shfl_xor(q, 16); q += __shfl_xor(q, 32);
                if (fq == 0) ssq[(size_t)row * 16 + u.pn * 4 + wc] = q; }
    }
};

struct EpiMlpIn {
    static constexpr bool PERM = true;
    const float* ssq; bf16_t* hid;
    __device__ __forceinline__ void operator()(const f32x4 (&acc)[2][2][4][2], const pg8::Unit& u, int wr, int wc, int fr, int fq) const {
#pragma unroll
        for (int ai = 0; ai < 2; ++ai)
#pragma unroll
            for (int m = 0; m < 4; ++m) { const int row = u.pm * 256 + ai * 128 + wr * 64 + m * 16 + fr;
                const f32x4* sp = (const f32x4*)(ssq + (size_t)row * 16); const f32x4 s0 = sp[0], s1 = sp[1], s2 = sp[2], s3 = sp[3];
                const float tot = ((s0[0] + s0[1]) + (s0[2] + s0[3])) + ((s1[0] + s1[1]) + (s1[2] + s1[3])) + ((s2[0] + s2[1]) + (s2[2] + s2[3])) + ((s3[0] + s3[1]) + (s3[2] + s3[3]));
                const float s = 1.0f / sqrtf(tot * (1.0f / DM) + EPS);
#pragma unroll
                for (int bj = 0; bj < 2; ++bj) { f32x4 v0 = acc[ai][bj][m][0] * s, v1 = acc[ai][bj][m][1] * s;
#pragma unroll
                    for (int e = 0; e < 4; ++e) { const float a = fmaxf(v0[e], 0.f), b = fmaxf(v1[e], 0.f); v0[e] = a * a; v1[e] = b * b; }
                    u32x4 w; w.x = cvtpk(v0[0], v0[1]); w.y = cvtpk(v0[2], v0[3]); w.z = cvtpk(v1[0], v1[1]); w.w = cvtpk(v1[2], v1[3]);
                    *(u32x4*)(hid + (size_t)row * DFF + u.pn * 256 + bj * 128 + wc * 32 + 8 * fq) = w; } }
    }
};

#define XB_TMO      128
#define XB_XCNT(j)  (256  + 64 * (j))
#define XB_XSUB(j)  (1280 + 64 * (j))
#define XB_XGEN(j)  (2304 + 64 * (j))
#define XB_TOP      3328
#define XB_TOPGEN   3392
#define XCD_BAR_WORDS 3456
#define XB_SPIN_CAP (1u << 20)
__device__ __forceinline__ unsigned xb_ld(unsigned* p)              { return __hip_atomic_load(p, __ATOMIC_RELAXED, __HIP_MEMORY_SCOPE_AGENT); }
__device__ __forceinline__ unsigned xb_add(unsigned* p, unsigned v) { return __hip_atomic_fetch_add(p, v, __ATOMIC_RELAXED, __HIP_MEMORY_SCOPE_AGENT); }
__device__ __forceinline__ unsigned xb_xcc_id() { return (unsigned)__builtin_amdgcn_s_getreg((3 << 11) | 20) & 0xFu; }
#define XB_SPIN(cond, bar) do { unsigned _sp = 0; while (cond) { __builtin_amdgcn_s_sleep(1); \
    if ((++_sp & 255u) == 0u) { if (xb_ld(&(bar)[XB_TMO])) break; if (_sp > XB_SPIN_CAP) { atomicAdd(&(bar)[XB_TMO], 1u); break; } } } } while (0)
struct XcdBarrier { unsigned* bar; unsigned x; volatile LAS unsigned* st; };
__device__ __forceinline__ XcdBarrier xcd_barrier_post(unsigned* bar, volatile LAS unsigned* st) {
    XcdBarrier b; b.bar = bar; b.x = xb_xcc_id(); b.st = st;
    if (threadIdx.x == 0) (void)xb_add(&bar[XB_XCNT(b.x)], 1u);
    return b;
}
__device__ __forceinline__ void xcd_barrier_complete(unsigned* bar, unsigned x, unsigned& nloc, unsigned& nx) {
    const unsigned G = gridDim.x * gridDim.y * gridDim.z;
    unsigned sum, cnt, mine, sp = 0u;
    for (;;) {
        sum = 0u; cnt = 0u; mine = 0u;
#pragma unroll
        for (unsigned j = 0; j < 16; ++j) { const unsigned c = xb_ld(&bar[XB_XCNT(j)]); sum += c; cnt += (c > 0u) ? 1u : 0u; mine = (j == x) ? c : mine; }
        if (sum == G) break;
        __builtin_amdgcn_s_sleep(1);
        if ((++sp & 255u) == 0u) { if (xb_ld(&bar[XB_TMO])) break; if (sp > XB_SPIN_CAP) { atomicAdd(&bar[XB_TMO], 1u); break; } }
    }
    nloc = mine > 0u ? mine : 1u; nx = cnt > 0u ? cnt : 1u;
}
__device__ __forceinline__ void xcd_barrier(const XcdBarrier& b) {
    asm volatile("s_waitcnt vmcnt(0)" ::: "memory");
    __syncthreads();
    if (threadIdx.x == 0) {
        unsigned* bar = b.bar;
        __builtin_amdgcn_s_waitcnt(0);
        unsigned nloc = b.st[0], nx = b.st[1];
        if (nloc == 0u) { xcd_barrier_complete(bar, b.x, nloc, nx); b.st[0] = nloc; b.st[1] = nx; }
        const unsigned old = xb_add(&bar[XB_XSUB(b.x)], 1u);
        const unsigned gen = old / nloc;
        if (old + 1u == (gen + 1u) * nloc) {
            __builtin_amdgcn_fence(__ATOMIC_RELEASE, "agent");
            asm volatile("s_waitcnt vmcnt(0)" ::: "memory");
            const unsigned og = xb_add(&bar[XB_TOP], 1u);
            const unsigned tg = og / nx;
            if (og + 1u == (tg + 1u) * nx) xb_add(&bar[XB_TOPGEN], 1u);
            else XB_SPIN(xb_ld(&bar[XB_TOPGEN]) == tg, bar);
            __builtin_amdgcn_fence(__ATOMIC_ACQUIRE, "agent");
            xb_add(&bar[XB_XGEN(b.x)], 1u);
            asm volatile("s_waitcnt vmcnt(0)" ::: "memory");
        } else {
            XB_SPIN(xb_ld(&bar[XB_XGEN(b.x)]) == gen, bar);
            __builtin_amdgcn_fence(__ATOMIC_ACQUIRE, "agent");
            asm volatile("s_waitcnt vmcnt(0)" ::: "memory");
        }
    }
    __syncthreads();
}

struct Frame {
    LAS unsigned char* lds;
    volatile LAS unsigned* MISC;
    unsigned* ctl;
    int tid, lane, wave, vcu, G;
    unsigned char* ws;
    const float *x, *mem; const int* positions; const float *g_mix, *w_in, *b_gate, *sinks, *g_mem, *w_mem_kv, *w_proj_swa, *w_proj_dsa, *w_proj_mem, *w_out, *g_mlp, *w_mlp_in, *w_mlp_out, *g_final;
    float* out;
};
#define WSP(T_, off) ((T_*)(F.ws + (off)))

__device__ __forceinline__ int rope_src(int base, int lp) { return base + (lp & ~63) + ((lp & 1) ? 32 + ((lp & 63) >> 1) : ((lp & 63) >> 1)); }
__device__ __forceinline__ int win_src(int pos) {
    if (pos < P_KS) return rope_src(0, pos);
    if (pos < P_VS) return rope_src(512, pos - P_KS);
    if (pos < P_QD) return pos;
    if (pos < P_KD) return rope_src(768, pos - P_QD);
    if (pos < P_VD) return rope_src(1024, pos - P_KD);
    if (pos < P_QI) return pos;
    if (pos < P_KI) return rope_src(1152, pos - P_QI);
    if (pos < P_QM) return rope_src(1408, pos - P_KI);
    if (pos < P_GATE) return 1476 + (pos - P_QM);
    if (pos < P_WI) return 1732 + (pos - P_GATE);
    if (pos < P_END) return 1472 + (pos - P_WI);
    return -1;
}
template <bool MAP> __device__ __forceinline__ void p0_transpose_item(const float* W, int ldw, int k0, int n0, const float* gk, bf16_t* WT, int ldwt, LAS float* scr, int lane) {
    const int j = lane & 31; const int sc = MAP ? win_src(n0 + j) : n0 + j;
#pragma unroll 8
    for (int i = 0; i < 32; ++i) { const int kk = 2 * i + (lane >> 5); float v = sc >= 0 ? W[(size_t)(k0 + kk) * ldw + sc] : 0.f; if (gk) v *= gk[k0 + kk]; scr[kk * 33 + j] = v; }
    LDS_WAIT(); asm volatile("" ::: "memory");
    const int c = lane & 7;
#pragma unroll
    for (int jj = 0; jj < 4; ++jj) { const int n = (lane >> 3) + 8 * jj; const LAS float* s = scr + (8 * c) * 33 + n;
        u32x4 o; o.x = cvtpk(s[0 * 33], s[1 * 33]); o.y = cvtpk(s[2 * 33], s[3 * 33]); o.z = cvtpk(s[4 * 33], s[5 * 33]); o.w = cvtpk(s[6 * 33], s[7 * 33]);
        *(u32x4*)(WT + (size_t)(n0 + n) * ldwt + k0 + 8 * c) = o; }
    LDS_WAIT(); asm volatile("" ::: "memory");
}
__device__ __forceinline__ void row_to_bf16(const float* xrow, bf16_t* orow, float* inv, int lane) {
    const f32x4* xr = (const f32x4*)xrow + lane;
    f32x4 v[4]; float s = 0.f;
#pragma unroll
    for (int j = 0; j < 4; ++j) { v[j] = xr[64 * j]; s += (v[j][0] * v[j][0] + v[j][1] * v[j][1]) + (v[j][2] * v[j][2] + v[j][3] * v[j][3]); }
    s = wave_sum(s);
    if (lane == 0) *inv = 1.0f / sqrtf(s * (1.0f / DM) + EPS);
    u32x2* o8 = (u32x2*)orow + lane;
#pragma unroll
    for (int j = 0; j < 4; ++j) { u32x2 w; w.x = cvtpk(v[j][0], v[j][1]); w.y = cvtpk(v[j][2], v[j][3]); o8[64 * j] = w; }
}
__device__ __forceinline__ void p0_prologue(Frame& F) {
    LAS float* scr = (LAS float*)(F.lds + RING_OFF + F.wave * 16384);
    const int gw = F.vcu * NWAVES + F.wave, NGW = F.G * NWAVES;
    constexpr int I_IN = 16 * (NPOS / 32), I_MEM = 16 * 16, I_PS = 8 * 32, I_PD = 4 * 32, I_PM = 4 * 32, I_OUT = 16 * 32, I_1 = 16 * 128, I_2 = 64 * 32;
    constexpr int NITEMS = I_IN + I_MEM + I_PS + I_PD + I_PM + I_OUT + I_1 + I_2;
    for (int it = gw; it < NITEMS; it += NGW) {
        int r = it;
        if (r < I_IN) { const int nb = NPOS / 32; p0_transpose_item<true>(F.w_in, DIN, 64 * (r / nb), 32 * (r % nb), F.g_mix, WSP(bf16_t, WS_WIN), DM, scr, F.lane); continue; } r -= I_IN;
        if (r < I_MEM) { p0_transpose_item<false>(F.w_mem_kv, 512, 64 * (r / 16), 32 * (r % 16), F.g_mem, WSP(bf16_t, WS_WMEM), DM, scr, F.lane); continue; } r -= I_MEM;
        if (r < I_PS) { p0_transpose_item<false>(F.w_proj_swa, DM, 64 * (r / 32), 32 * (r % 32), nullptr, WSP(bf16_t, WS_WPROJ), DM, scr, F.lane); continue; } r -= I_PS;
        if (r < I_PD) { p0_transpose_item<false>(F.w_proj_dsa, DM, 64 * (r / 32), 32 * (r % 32), nullptr, WSP(bf16_t, WS_WPROJ) + 512, DM, scr, F.lane); continue; } r -= I_PD;
        if (r < I_PM) { p0_transpose_item<false>(F.w_proj_mem, DM, 64 * (r / 32), 32 * (r % 32), nullptr, WSP(bf16_t, WS_WPROJ) + 768, DM, scr, F.lane); continue; } r -= I_PM;
        if (r < I_OUT) { p0_transpose_item<false>(F.w_out, DM, 64 * (r / 32), 32 * (r % 32), nullptr, WSP(bf16_t, WS_WOUT), DM, scr, F.lane); continue; } r -= I_OUT;
        if (r < I_1) { p0_transpose_item<false>(F.w_mlp_in, DFF, 64 * (r / 128), 32 * (r % 128), F.g_mlp, WSP(bf16_t, WS_W1), DM, scr, F.lane); continue; } r -= I_1;
        p0_transpose_item<false>(F.w_mlp_out, DM, 64 * (r / 32), 32 * (r % 32), nullptr, WSP(bf16_t, WS_W2), DFF, scr, F.lane);
    }
    for (int m = gw; m < T; m += NGW) row_to_bf16(F.x + (size_t)m * DM, WSP(bf16_t, WS_XB) + (size_t)m * DM, WSP(float, WS_INVRMS0) + m, F.lane);
    for (int m = gw; m < MROWS; m += NGW) row_to_bf16(F.mem + (size_t)m * DM, WSP(bf16_t, WS_MEMB) + (size_t)m * DM, WSP(float, WS_INVRMSM) + m, F.lane);
    { const int gt = gw * 64 + F.lane, NGT = NGW * 64; const int i = gt & 31;
      const float invf = (float)exp2((double)(-i) * (13.287712379549449 / 32.0));
      float* cs = WSP(float, WS_CS);
      for (int idx = gt; idx < T * 32; idx += NGT) { const float ang = (float)F.positions[idx >> 5] * invf; float s, c; sincosf(ang, &s, &c); *(f32x2*)(cs + (size_t)idx * 2) = (f32x2){c, s}; } }
}

__device__ __forceinline__ void p7_final_norm(Frame& F) {
    const int gw = F.vcu * NWAVES + F.wave, NGW = F.G * NWAVES;
    const float* ssq = WSP(float, WS_SSQ2);
    f32x4 g[4];
#pragma unroll
    for (int j = 0; j < 4; ++j) g[j] = ((const f32x4*)F.g_final)[F.lane + 64 * j];
    for (int m = gw; m < T; m += NGW) {
        float p = F.lane < 16 ? ssq[(size_t)m * 16 + F.lane] : 0.f;
        p = wave_sum(p);
        const float s = 1.0f / sqrtf(p * (1.0f / DM) + EPS);
        f32x4* o = (f32x4*)(F.out + (size_t)m * DM) + F.lane;
#pragma unroll
        for (int j = 0; j < 4; ++j) { const f32x4 v = o[64 * j]; o[64 * j] = v * s * g[j]; }
    }
}

__device__ __forceinline__ int crow(int r, int hi) { return (r & 3) + 8 * (r >> 2) + 4 * hi; }
__device__ __forceinline__ float xor32f(float v) { return __shfl_xor(v, 32); }

template <int MODE> __device__ __forceinline__ void attn32(const bf16_t* Qp, int ldq, const bf16_t* Kp, int ldk, const bf16_t* Vp, int ldv, int jlo, int jhi, int qpos0, float sink_l2, bf16_t* Op, int ldo, int lane) {
    const int r32 = lane & 31, hi = lane >> 5;
    bf16x8 qf[4];
#pragma unroll
    for (int s = 0; s < 4; ++s) qf[s] = *(const bf16x8*)(Qp + (size_t)r32 * ldq + 16 * s + 8 * hi);
    float m = MODE == 1 ? sink_l2 : -INFINITY, l = MODE == 1 ? 1.0f : 0.0f;
    f32x16 o0 = {}, o1 = {};
    const int qp = qpos0 + r32;
    for (int j = jlo; j < jhi; ++j) {
        const bf16_t* kr = Kp + (size_t)(32 * j + r32) * ldk + 8 * hi;
        f32x16 sc = {};
#pragma unroll
        for (int s = 0; s < 4; ++s) { const bf16x8 kf = *(const bf16x8*)(kr + 16 * s); sc = __builtin_amdgcn_mfma_f32_32x32x16_bf16(kf, qf[s], sc, 0, 0, 0); }
        if (MODE == 1) { const int dq = qp - 32 * j - 4 * hi;
#pragma unroll
            for (int i = 0; i < 16; ++i) { const int dk = (i & 3) + 8 * (i >> 2); if (dk > dq || dq - dk >= 128) sc[i] = -INFINITY; }
        }
        float tm = sc[0];
#pragma unroll
        for (int i = 1; i < 16; ++i) tm = fmaxf(tm, sc[i]);
        tm = fmaxf(tm, xor32f(tm));
        const float mn = fmaxf(m, tm);
        const float alpha = (mn == -INFINITY) ? 1.0f : __builtin_amdgcn_exp2f(m - mn);
        const float msub = (mn == -INFINITY) ? 0.0f : mn;
        float rs = 0.f;
#pragma unroll
        for (int i = 0; i < 16; ++i) { sc[i] = __builtin_amdgcn_exp2f(sc[i] - msub); rs += sc[i]; }
        rs += xor32f(rs);
        l = l * alpha + rs; m = mn;
#pragma unroll
        for (int i = 0; i < 16; ++i) { o0[i] *= alpha; o1[i] *= alpha; }
        u32x4 pw[2];
#pragma unroll
        for (int s = 0; s < 2; ++s) { pw[s].x = cvtpk(sc[8 * s + 0], sc[8 * s + 1]); pw[s].y = cvtpk(sc[8 * s + 2], sc[8 * s + 3]); pw[s].z = cvtpk(sc[8 * s + 4], sc[8 * s + 5]); pw[s].w = cvtpk(sc[8 * s + 6], sc[8 * s + 7]); }
#pragma unroll
        for (int s = 0; s < 2; ++s) {
            bf16x8 a0, a1;
#pragma unroll
            for (int jj = 0; jj < 8; ++jj) { const bf16_t* vr = Vp + (size_t)(32 * j + 16 * s + 8 * (jj >> 2) + 4 * hi + (jj & 3)) * ldv + r32; a0[jj] = (short)vr[0]; a1[jj] = (short)vr[32]; }
            const bf16x8 pb = __builtin_bit_cast(bf16x8, pw[s]);
            o0 = __builtin_amdgcn_mfma_f32_32x32x16_bf16(a0, pb, o0, 0, 0, 0);
            o1 = __builtin_amdgcn_mfma_f32_32x32x16_bf16(a1, pb, o1, 0, 0, 0);
        }
    }
    const float rl = 1.0f / l;
    bf16_t* orow = Op + (size_t)r32 * ldo;
#pragma unroll
    for (int g = 0; g < 4; ++g) {
        u32x2 w0, w1; w0.x = cvtpk(o0[4 * g] * rl, o0[4 * g + 1] * rl); w0.y = cvtpk(o0[4 * g + 2] * rl, o0[4 * g + 3] * rl);
        w1.x = cvtpk(o1[4 * g] * rl, o1[4 * g + 1] * rl); w1.y = cvtpk(o1[4 * g + 2] * rl, o1[4 * g + 3] * rl);
        *(u32x2*)(orow + 8 * g + 4 * hi) = w0; *(u32x2*)(orow + 32 + 8 * g + 4 * hi) = w1;
    }
}

__device__ __forceinline__ void swa_item(Frame& F, int b, int qb) {
    const int h = F.wave, kvh = h >> 2;
    const float sink = F.sinks[h] * LOG2E;
    const bf16_t* Kp = WSP(const bf16_t, WS_KS) + (size_t)b * SEQ * 128 + kvh * 64;
    const bf16_t* Vp = WSP(const bf16_t, WS_VS) + (size_t)b * SEQ * 128 + kvh * 64;
    for (int sub = 0; sub < 4; ++sub) {
        const int q0 = qb * 128 + 32 * sub; const int jhi = q0 / 32 + 1; int jlo = jhi - 5; if (jlo < 0) jlo = 0;
        attn32<1>(WSP(const bf16_t, WS_QS) + ((size_t)b * SEQ + q0) * 512 + h * 64, 512, Kp, 128, Vp, 128, jlo, jhi, q0, sink, WSP(bf16_t, WS_OCAT) + ((size_t)b * SEQ + q0) * DM + h * 64, DM, F.lane);
    }
}
__device__ __forceinline__ void mem_item(Frame& F, int b, int qb) {
    const int h = F.wave & 3, half = F.wave >> 2;
    const bf16_t* Kp = WSP(const bf16_t, WS_MK) + (size_t)b * MEMLEN * 256 + h * 64;
    const bf16_t* Vp = WSP(const bf16_t, WS_MV) + (size_t)b * MEMLEN * 256 + h * 64;
    for (int sub = 0; sub < 2; ++sub) {
        const int q0 = qb * 128 + 64 * half + 32 * sub;
        attn32<0>(WSP(const bf16_t, WS_QM) + ((size_t)b * SEQ + q0) * 256 + h * 64, 256, Kp, 256, Vp, 256, 0, MEMLEN / 32, 0, 0.f, WSP(bf16_t, WS_OCAT) + ((size_t)b * SEQ + q0) * DM + 768 + h * 64, DM, F.lane);
    }
}


constexpr int DSA_CAP = 512;
constexpr int MAXLD = 1026;
constexpr int CKLD = 513, CILD = 514;
constexpr int DL_MAX = 0;
constexpr int DL_CKEY = 0;
constexpr int DL_CIDX = 65664;
constexpr int DL_VS = 0;
constexpr int DL_CNT = 98560;
constexpr int DL_HIST = 99584;
constexpr int DL_SEL = 107776;
typedef short v4i16_t __attribute__((ext_vector_type(4)));
__device__ __forceinline__ unsigned fkey(float f) { const unsigned u = __float_as_uint(f); return (u & 0x80000000u) ? ~u : (u | 0x80000000u); }
__device__ __forceinline__ float fkey_inv(unsigned k) { return __uint_as_float((k & 0x80000000u) ? (k & 0x7fffffffu) : ~k); }
__device__ __forceinline__ void glds16(const void* gsrc, unsigned lds_dst) { unsigned keep;
    asm volatile("s_mov_b32 %0, m0\n\ts_mov_b32 m0, %2\n\ts_nop 0\n\tglobal_load_lds_dwordx4 %1, off\n\ts_mov_b32 m0, %0" : "=&s"(keep) : "v"(gsrc), "s"(lds_dst) : "memory"); }

template <int NV, int ROUNDS> __device__ __forceinline__ unsigned radix_kth(const unsigned (&v)[NV], int count, LAS unsigned* hist, int k, int lane, int& k_out, int& ceq_out) {
    unsigned prefix = 0u; int ceq = 0;
#pragma unroll
    for (int r = ROUNDS - 1; r >= 0; --r) {
        const int shift = 8 * r;
        *(LAS u32x4*)(hist + 4 * lane) = (u32x4){0u, 0u, 0u, 0u};
        LDS_WAIT();
#pragma unroll
        for (int i = 0; i < NV; ++i) { const bool ok = (lane + 64 * i < count) && (r == ROUNDS - 1 || (v[i] >> (shift + 8)) == (prefix >> (shift + 8)));
            if (ok) __hip_atomic_fetch_add(hist + ((v[i] >> shift) & 255u), 1u, __ATOMIC_RELAXED, __HIP_MEMORY_SCOPE_WORKGROUP); }
        LDS_WAIT();
        const u32x4 h = *(const LAS u32x4*)(hist + 4 * lane);
        const unsigned s = (h.x + h.y) + (h.z + h.w);
        unsigned Tl = s;
#pragma unroll
        for (int o = 1; o < 64; o <<= 1) { const unsigned t = __shfl_down(Tl, o); if (lane + o < 64) Tl += t; }
        const unsigned long long bal = __ballot(Tl >= (unsigned)k);
        const int ls = bal ? 63 - __clzll(bal) : 0;
        const unsigned above = Tl - s, c3 = above + h.w, c2 = c3 + h.z, c1 = c2 + h.y;
        unsigned bin, kk, cb;
        if (c3 >= (unsigned)k) { bin = 3; kk = k - above; cb = h.w; } else if (c2 >= (unsigned)k) { bin = 2; kk = k - c3; cb = h.z; } else if (c1 >= (unsigned)k) { bin = 1; kk = k - c2; cb = h.y; } else { bin = 0; kk = k - c1; cb = h.x; }
        const unsigned digit = (unsigned)__builtin_amdgcn_readlane((int)(bin + 4u * lane), ls);
        k = __builtin_amdgcn_readlane((int)kk, ls); ceq = __builtin_amdgcn_readlane((int)cb, ls);
        prefix |= digit << shift;
    }
    k_out = k; ceq_out = ceq; return prefix;
}

__device__ __forceinline__ void dsa_item(Frame& F, int b, int t0) {
    const int lane = F.lane, wid = F.wave, r32 = lane & 31, hi = lane >> 5;
    LAS unsigned short* maxbuf = (LAS unsigned short*)(F.lds + DL_MAX);
    LAS unsigned* ckey = (LAS unsigned*)(F.lds + DL_CKEY);
    LAS unsigned short* cidx = (LAS unsigned short*)(F.lds + DL_CIDX);
    LAS unsigned* ccnt = (LAS unsigned*)(F.lds + DL_CNT);
    LAS unsigned* ctau = ccnt + 32;
    LAS unsigned* hist = (LAS unsigned*)(F.lds + DL_HIST) + wid * 256;
    LAS unsigned short* sel = (LAS unsigned short*)(F.lds + DL_SEL);
    const size_t rowb = (size_t)b * SEQ;
    unsigned char* wsl = F.ws; asm volatile("" : "+s"(wsl));
#define WSL(T_, off) ((GAS T_*)(wsl + (off)))
    __syncthreads();
#ifndef REP_SEL
#define REP_SEL 1
#endif
#ifndef REP_GATHER
#define REP_GATHER 1
#endif
    for (int rep_ = 0; rep_ < REP_SEL; ++rep_) {
    if (rep_) __syncthreads();
    if (t0 >= TOPK) {
        const int nkt = t0 / 32 + 1, nmax = t0 + 32;
        int lg = 0; while ((1024 << lg) < nmax) ++lg;
        const int npl = 16 >> lg;
        bf16x8 qf[4][4]; float wq[4];
        { const GAS bf16_t* qrow = WSL(const bf16_t, WS_QI) + (rowb + t0 + r32) * 256 + 8 * hi;
#pragma unroll
          for (int h = 0; h < 4; ++h)
#pragma unroll
              for (int s = 0; s < 4; ++s) qf[h][s] = *(const GAS bf16x8*)(qrow + h * 64 + 16 * s);
          const f32x4 w4 = *(const GAS f32x4*)(WSL(const float, WS_WI) + (rowb + t0 + r32) * 4); wq[0] = w4[0]; wq[1] = w4[1]; wq[2] = w4[2]; wq[3] = w4[3]; }
        if (F.tid < 32) ccnt[F.tid] = 0u;
        const GAS bf16_t* kbase = WSL(const bf16_t, WS_KI) + (rowb + r32) * 64 + 8 * hi;
        float thrf = 0.f;
#ifndef X_PASS0
#define X_PASS0 0
#endif
#ifndef X_RADIX16
#define X_RADIX16 1
#endif
#ifndef X_EXACT
#define X_EXACT 1
#endif
        for (int pp = -X_PASS0; pp < 2; ++pp) { const int pass = pp < 0 ? 0 : pp;
            if (pass == 1) thrf = fkey_inv(ctau[r32] << 16);
            bf16x8 kn[4];
            if (wid < nkt) {
#pragma unroll
                for (int s = 0; s < 4; ++s) kn[s] = *(const GAS bf16x8*)(kbase + (size_t)(32 * wid) * 64 + 16 * s);
            }
            for (int j = wid; j < nkt; j += NWAVES) {
                bf16x8 kf[4];
#pragma unroll
                for (int s = 0; s < 4; ++s) kf[s] = kn[s];
                if (j + NWAVES < nkt) {
#pragma unroll
                    for (int s = 0; s < 4; ++s) kn[s] = *(const GAS bf16x8*)(kbase + (size_t)(32 * (j + NWAVES)) * 64 + 16 * s);
                }
                float sc[16];
                {
                    f32x16 da = {}, db = {};
#pragma unroll
                    for (int s = 0; s < 4; ++s) da = __builtin_amdgcn_mfma_f32_32x32x16_bf16(kf[s], qf[0][s], da, 0, 0, 0);
#pragma unroll
                    for (int s = 0; s < 4; ++s) db = __builtin_amdgcn_mfma_f32_32x32x16_bf16(kf[s], qf[1][s], db, 0, 0, 0);
#pragma unroll
                    for (int i = 0; i < 16; ++i) { const int di = __float_as_int(da[i]); sc[i] = __int_as_float(di > 0 ? di : 0) * wq[0]; }
                    da = (f32x16){};
#pragma unroll
                    for (int s = 0; s < 4; ++s) da = __builtin_amdgcn_mfma_f32_32x32x16_bf16(kf[s], qf[2][s], da, 0, 0, 0);
#pragma unroll
                    for (int i = 0; i < 16; ++i) { const int di = __float_as_int(db[i]); sc[i] = fmaf(__int_as_float(di > 0 ? di : 0), wq[1], sc[i]); }
                    db = (f32x16){};
#pragma unroll
                    for (int s = 0; s < 4; ++s) db = __builtin_amdgcn_mfma_f32_32x32x16_bf16(kf[s], qf[3][s], db, 0, 0, 0);
#pragma unroll
                    for (int i = 0; i < 16; ++i) { const int di = __float_as_int(da[i]); sc[i] = fmaf(__int_as_float(di > 0 ? di : 0), wq[2], sc[i]); }
#pragma unroll
                    for (int i = 0; i < 16; ++i) { const int di = __float_as_int(db[i]); sc[i] = fmaf(__int_as_float(di > 0 ? di : 0), wq[3], sc[i]); }
                }
                if (j == nkt - 1) { const int dlim = r32 - 4 * hi;
#pragma unroll
                    for (int i = 0; i < 16; ++i) if ((i & 3) + 8 * (i >> 2) > dlim) sc[i] = -INFINITY;
                }
                if (pass == 0) {
                    LAS unsigned short* mb = maxbuf + r32 * MAXLD + (j * 2 + hi) * npl;
                    if (lg == 0) {
#pragma unroll
                        for (int i = 0; i < 16; ++i) mb[i] = (unsigned short)(fkey(sc[i]) >> 16);
                    } else {
                        float m2[8];
#pragma unroll
                        for (int i = 0; i < 8; ++i) m2[i] = fmaxf(sc[2 * i], sc[2 * i + 1]);
                        if (lg == 1) {
#pragma unroll
                            for (int i = 0; i < 8; ++i) mb[i] = (unsigned short)(fkey(m2[i]) >> 16);
                        } else if (lg == 2) {
#pragma unroll
                            for (int i = 0; i < 4; ++i) mb[i] = (unsigned short)(fkey(fmaxf(m2[2 * i], m2[2 * i + 1])) >> 16);
                        } else {
                            mb[0] = (unsigned short)(fkey(fmaxf(fmaxf(m2[0], m2[1]), fmaxf(m2[2], m2[3]))) >> 16);
                            mb[1] = (unsigned short)(fkey(fmaxf(fmaxf(m2[4], m2[5]), fmaxf(m2[6], m2[7]))) >> 16);
                        }
                    }
                } else {
                    int cntl = 0;
#pragma unroll
                    for (int i = 0; i < 16; ++i) cntl += (sc[i] >= thrf) ? 1 : 0;
                    if (__ballot(cntl > 0)) {
                        unsigned slot = 0u;
                        if (cntl > 0) slot = __hip_atomic_fetch_add(ccnt + r32, (unsigned)cntl, __ATOMIC_RELAXED, __HIP_MEMORY_SCOPE_WORKGROUP);
                        LAS unsigned* ck = ckey + r32 * CKLD; LAS unsigned short* ci = cidx + r32 * CILD; const int ib = 32 * j + 4 * hi;
#pragma unroll
                        for (int i = 0; i < 16; ++i) {
                            if (sc[i] >= thrf) { const unsigned sl = slot < (unsigned)(DSA_CAP - 1) ? slot : (unsigned)(DSA_CAP - 1);
                                ck[sl] = fkey(sc[i]); ci[sl] = (unsigned short)(ib + ((i & 3) + 8 * (i >> 2))); ++slot; }
                        }
                    }
                }
            }
            __syncthreads();
            if (pp == 0) {
                const int G = nmax >> lg;
                for (int xr_ = 0; xr_ < X_RADIX16; ++xr_)
                for (int jq = 0; jq < 4; ++jq) { const int q = wid * 4 + jq;
                    asm volatile("" ::: "memory");
                    unsigned v[16];
#pragma unroll
                    for (int i = 0; i < 16; ++i) { const int e = lane + 64 * i; v[i] = e < G ? (unsigned)maxbuf[q * MAXLD + e] : 0u; }
                    unsigned mloc = v[0];
#pragma unroll
                    for (int i = 1; i < 16; ++i) mloc = mloc > v[i] ? mloc : v[i];
                    int pivot = __builtin_amdgcn_readlane((int)mloc, 0);
                    { const int p1 = __builtin_amdgcn_readlane((int)mloc, 21), p2 = __builtin_amdgcn_readlane((int)mloc, 42), p3 = __builtin_amdgcn_readlane((int)mloc, 63);
                      pivot = pivot > p1 ? pivot : p1; pivot = pivot > p2 ? pivot : p2; pivot = pivot > p3 ? pivot : p3; }
                    *(LAS u32x4*)(hist + 4 * lane) = (u32x4){0u, 0u, 0u, 0u};
                    LDS_WAIT();
#pragma unroll
                    for (int i = 0; i < 16; ++i) { if (lane + 64 * i < G) { int d = (pivot - (int)v[i]) >> 1; d = d < 0 ? 0 : (d > 255 ? 255 : d);
                            __hip_atomic_fetch_add(hist + d, 1u, __ATOMIC_RELAXED, __HIP_MEMORY_SCOPE_WORKGROUP); } }
                    LDS_WAIT();
                    unsigned tau;
                    { const u32x4 h = *(const LAS u32x4*)(hist + 4 * lane);
                      const unsigned sh = (h.x + h.y) + (h.z + h.w);
                      unsigned Pl = sh;
#pragma unroll
                      for (int o = 1; o < 64; o <<= 1) { const unsigned t = __shfl_up(Pl, o); if (lane >= o) Pl += t; }
                      const unsigned long long bal = __ballot(Pl >= (unsigned)TOPK);
                      const int ls = bal ? __ffsll((long long)bal) - 1 : 63;
                      const unsigned below = Pl - sh, c0 = below + h.x, c1 = c0 + h.y, c2 = c1 + h.z;
                      const unsigned bin = c0 >= (unsigned)TOPK ? 0u : (c1 >= (unsigned)TOPK ? 1u : (c2 >= (unsigned)TOPK ? 2u : 3u));
                      const int jstar = bal ? __builtin_amdgcn_readlane((int)(bin + 4u * lane), ls) : 255;
                      if (jstar < 255) { const int tl = pivot - (2 * jstar + 1); tau = tl < 0 ? 0u : (unsigned)tl; }
                      else { int ko, ce; tau = radix_kth<16, 2>(v, G, hist, TOPK, lane, ko, ce); } }
                    if (lane == 0) ctau[q] = tau;
                }
                __syncthreads();
            }
        }
        for (int xe_ = 0; xe_ < X_EXACT; ++xe_)
        for (int jq = 0; jq < 4; ++jq) { const int q = wid * 4 + jq;
            asm volatile("" ::: "memory");
            int c = (int)ccnt[q]; if (c > DSA_CAP) c = DSA_CAP;
            unsigned kv[8], ix[8];
#pragma unroll
            for (int i = 0; i < 8; ++i) { const int e = lane + 64 * i; kv[i] = e < c ? ckey[q * CKLD + e] : 0u; ix[i] = e < c ? (unsigned)cidx[q * CILD + e] : 0xffffu; }
            unsigned thr, ti = 0xffffu;
            { const unsigned tau16 = (unsigned)__builtin_amdgcn_readfirstlane((int)ctau[q]);
              *(LAS u32x4*)(hist + 4 * lane) = (u32x4){0u, 0u, 0u, 0u};
              LDS_WAIT();
              unsigned dg[8];
#pragma unroll
              for (int i = 0; i < 8; ++i) { const int d0 = (int)(kv[i] >> 16) - (int)tau16; dg[i] = (unsigned)(d0 < 0 ? 0 : (d0 > 255 ? 255 : d0));
                  if (lane + 64 * i < c) __hip_atomic_fetch_add(hist + dg[i], 1u, __ATOMIC_RELAXED, __HIP_MEMORY_SCOPE_WORKGROUP); }
              LDS_WAIT();
              const u32x4 h = *(const LAS u32x4*)(hist + 4 * lane);
              const unsigned sh = (h.x + h.y) + (h.z + h.w);
              unsigned Tl = sh;
#pragma unroll
              for (int o = 1; o < 64; o <<= 1) { const unsigned t = __shfl_down(Tl, o); if (lane + o < 64) Tl += t; }
              const unsigned long long bal = __ballot(Tl >= (unsigned)TOPK);
              const int ls = bal ? 63 - __clzll(bal) : 0;
              const unsigned above = Tl - sh, c3 = above + h.w, c2 = c3 + h.z, c1 = c2 + h.y;
              unsigned bin, kkv, cbv;
              if (c3 >= (unsigned)TOPK) { bin = 3; kkv = TOPK - above; cbv = h.w; } else if (c2 >= (unsigned)TOPK) { bin = 2; kkv = TOPK - c3; cbv = h.z; } else if (c1 >= (unsigned)TOPK) { bin = 1; kkv = TOPK - c2; cbv = h.y; } else { bin = 0; kkv = TOPK - c1; cbv = h.x; }
              const unsigned jstar = (unsigned)__builtin_amdgcn_readlane((int)(bin + 4u * lane), ls);
              const int kk = __builtin_amdgcn_readlane((int)kkv, ls), cb = __builtin_amdgcn_readlane((int)cbv, ls);
              if (jstar < 255u && cb <= 64) {
                  LAS unsigned* lk = hist; LAS unsigned* li = hist + 64;
                  int base = 0;
#pragma unroll
                  for (int i = 0; i < 8; ++i) { const bool mt = (lane + 64 * i < c) && dg[i] == jstar; const unsigned long long mk = __ballot(mt);
                      if (mt) { const int slot = base + (int)__builtin_amdgcn_mbcnt_hi((unsigned)(mk >> 32), __builtin_amdgcn_mbcnt_lo((unsigned)mk, 0u)); lk[slot] = kv[i]; li[slot] = ix[i]; }
                      base += __popcll(mk); }
                  LDS_WAIT();
                  const unsigned mkey = lane < cb ? lk[lane] : 0u, midx = lane < cb ? li[lane] : 0xffffu;
                  int rank = 0;
                  for (int t = 0; t < cb; ++t) { const unsigned xk = (unsigned)__builtin_amdgcn_readlane((int)mkey, t), xi = (unsigned)__builtin_amdgcn_readlane((int)midx, t);
                      rank += (xk > mkey || (xk == mkey && xi < midx)) ? 1 : 0; }
                  const unsigned long long b2 = __ballot(lane < cb && rank == kk - 1);
                  const int lt = b2 ? __ffsll((long long)b2) - 1 : 0;
                  thr = (unsigned)__builtin_amdgcn_readlane((int)mkey, lt); ti = (unsigned)__builtin_amdgcn_readlane((int)midx, lt);
              } else {
                  int k, ceq; thr = radix_kth<8, 4>(kv, c, hist, TOPK, lane, k, ceq);
                  if (ceq > k) {
                      unsigned pi = 0u; int kq = k;
                      for (int bit = 15; bit >= 0; --bit) { const unsigned test = pi >> bit; int cnt = 0;
#pragma unroll
                          for (int i = 0; i < 8; ++i) cnt += __popcll(__ballot(kv[i] == thr && (ix[i] >> bit) == test));
                          if (cnt < kq) { kq -= cnt; pi |= (1u << bit); } }
                      ti = pi;
                  }
              } }
            *(LAS u32x4*)(hist + 4 * lane) = (u32x4){0u, 0u, 0u, 0u};
            LDS_WAIT();
#pragma unroll
            for (int i = 0; i < 8; ++i) if (kv[i] > thr || (kv[i] == thr && ix[i] <= ti)) __hip_atomic_fetch_or(hist + (ix[i] >> 5), 1u << (ix[i] & 31), __ATOMIC_RELAXED, __HIP_MEMORY_SCOPE_WORKGROUP);
            LDS_WAIT();
            const u32x4 w4 = *(const LAS u32x4*)(hist + 4 * lane);
            const unsigned w[4] = {w4.x, w4.y, w4.z, w4.w};
            const int n = (__popc(w[0]) + __popc(w[1])) + (__popc(w[2]) + __popc(w[3]));
            int pos = n;
#pragma unroll
            for (int o = 1; o < 64; o <<= 1) { const int t = __shfl_up(pos, o); if (lane >= o) pos += t; }
            pos -= n;
#pragma unroll
            for (int i = 0; i < 4; ++i) { unsigned ww = w[i]; while (ww) { const int bpos = __ffs((int)ww) - 1; ww &= ww - 1; if (pos < TOPK) sel[q * 256 + pos] = (unsigned short)(lane * 128 + i * 32 + bpos); ++pos; } }
            LDS_WAIT();
        }
    } else {
        for (int e = F.tid; e < 32 * 256; e += NWAVES * 64) sel[e] = (unsigned short)(e & 255);
    }
    }
    __syncthreads();
    const int c16 = lane & 15, g4 = lane >> 4;
    const GAS bf16_t* Kd = WSL(const bf16_t, WS_KD) + rowb * 64;
    const GAS bf16_t* Vd = WSL(const bf16_t, WS_VD) + rowb * 64;
    const unsigned vs_base = (unsigned)(uintptr_t)(F.lds + DL_VS) + (unsigned)wid * 12288u;
    const LAS unsigned char* vs_ptr = F.lds + DL_VS + wid * 12288;
    const int tr_off = (4 * g4 + (c16 >> 2)) * 128 + (c16 & 3) * 8;
    for (int rep_ = 0; rep_ < REP_GATHER; ++rep_)
    for (int jq = 0; jq < 4; ++jq) { const int q = wid * 4 + jq, t = t0 + q; const int nsel = t + 1 < TOPK ? t + 1 : TOPK;
        const LAS unsigned short* selq = sel + q * 256;
#define DSA_VDMA(u) do { _Pragma("unroll") for (int p_ = 0; p_ < 4; ++p_) { const int kidx_ = (int)selq[32 * (u) + 8 * p_ + (lane >> 3)]; \
            glds16((const void*)(Vd + (size_t)kidx_ * 64 + (lane & 7) * 8), (unsigned)__builtin_amdgcn_readfirstlane(vs_base + (unsigned)(((u) % 3) * 4096 + p_ * 1024))); } } while (0)
        asm volatile("s_waitcnt lgkmcnt(0)" ::: "memory");
        DSA_VDMA(0); DSA_VDMA(1); DSA_VDMA(2);
        bf16x8 qf[2];
        { const GAS bf16_t* qrow = WSL(const bf16_t, WS_QD) + (rowb + t) * 256 + (c16 & 3) * 64 + 8 * g4;
          qf[0] = *(const GAS bf16x8*)qrow; qf[1] = *(const GAS bf16x8*)(qrow + 32);
          if (c16 >= 4) { qf[0] = (bf16x8){0, 0, 0, 0, 0, 0, 0, 0}; qf[1] = qf[0]; } }
        bf16x8 kf[4][2], kn[4][2];
#define DSA_KLOAD(dst, ch_) do { _Pragma("unroll") for (int kb = 0; kb < 4; ++kb) { const int kidx = (int)selq[64 * (ch_) + 16 * kb + c16]; const GAS bf16_t* kr = Kd + (size_t)kidx * 64 + 8 * g4; dst[kb][0] = *(const GAS bf16x8*)kr; dst[kb][1] = *(const GAS bf16x8*)(kr + 32); } } while (0)
        DSA_KLOAD(kf, 0);
        float mrun = -INFINITY, l = 0.f;
        f32x4 O[4];
#pragma unroll
        for (int db = 0; db < 4; ++db) O[db] = (f32x4){0.f, 0.f, 0.f, 0.f};
#pragma unroll
        for (int ch = 0; ch < 4; ++ch) {
            if (ch + 1 < 4) DSA_KLOAD(kn, ch + 1);
            asm volatile("" ::: "memory");
            f32x4 S[4];
#pragma unroll
            for (int kb = 0; kb < 4; ++kb) { f32x4 a = {0.f, 0.f, 0.f, 0.f};
                a = __builtin_amdgcn_mfma_f32_16x16x32_bf16(kf[kb][0], qf[0], a, 0, 0, 0); a = __builtin_amdgcn_mfma_f32_16x16x32_bf16(kf[kb][1], qf[1], a, 0, 0, 0); S[kb] = a; }
            if (nsel < TOPK) { const int nlim = nsel - 4 * g4;
#pragma unroll
                for (int kb = 0; kb < 4; ++kb)
#pragma unroll
                    for (int r = 0; r < 4; ++r) if (64 * ch + 16 * kb + r >= nlim) S[kb][r] = -INFINITY;
            }
            float cm = fmaxf(fmaxf(S[0][0], S[0][1]), fmaxf(S[0][2], S[0][3]));
#pragma unroll
            for (int kb = 1; kb < 4; ++kb) cm = fmaxf(cm, fmaxf(fmaxf(S[kb][0], S[kb][1]), fmaxf(S[kb][2], S[kb][3])));
            cm = fmaxf(cm, __shfl_xor(cm, 16)); cm = fmaxf(cm, __shfl_xor(cm, 32));
            const float mn = fmaxf(mrun, cm);
            const float alpha = __builtin_amdgcn_exp2f(mrun - mn);
            mrun = mn;
            float ps = 0.f;
#pragma unroll
            for (int kb = 0; kb < 4; ++kb)
#pragma unroll
                for (int r = 0; r < 4; ++r) { S[kb][r] = __builtin_amdgcn_exp2f(S[kb][r] - mn); ps += S[kb][r]; }
            l = l * alpha + ps;
#pragma unroll
            for (int db = 0; db < 4; ++db) O[db] = O[db] * alpha;
#pragma unroll
            for (int u2 = 0; u2 < 2; ++u2) { const int u = 2 * ch + u2;
                u32x4 pw; pw.x = cvtpk(S[2 * u2][0], S[2 * u2][1]); pw.y = cvtpk(S[2 * u2][2], S[2 * u2][3]); pw.z = cvtpk(S[2 * u2 + 1][0], S[2 * u2 + 1][1]); pw.w = cvtpk(S[2 * u2 + 1][2], S[2 * u2 + 1][3]);
                const bf16x8 pb = __builtin_bit_cast(bf16x8, pw);
                if (u == 3) asm volatile("s_waitcnt vmcnt(12)" ::: "memory");
                else if (u == 5) asm volatile("s_waitcnt vmcnt(16)" ::: "memory");
                else if (u == 6) asm volatile("s_waitcnt vmcnt(12)" ::: "memory");
                else if (u == 7) asm volatile("s_waitcnt vmcnt(0)" ::: "memory");
                const LAS unsigned char* sp = vs_ptr + (u % 3) * 4096 + tr_off;
#pragma unroll
                for (int db = 0; db < 4; ++db) {
                    const v4i16_t lo = __builtin_amdgcn_ds_read_tr16_b64_v4i16((LAS v4i16_t*)(sp + db * 32));
                    const v4i16_t hv = __builtin_amdgcn_ds_read_tr16_b64_v4i16((LAS v4i16_t*)(sp + db * 32 + 2048));
                    const bf16x8 va = (bf16x8){lo[0], lo[1], lo[2], lo[3], hv[0], hv[1], hv[2], hv[3]};
                    O[db] = __builtin_amdgcn_mfma_f32_16x16x32_bf16(va, pb, O[db], 0, 0, 0);
                }
                if (u + 3 < 8) { asm volatile("s_waitcnt lgkmcnt(0)" ::: "memory"); DSA_VDMA(u + 3); }
            }
#pragma unroll
            for (int kb = 0; kb < 4; ++kb) { kf[kb][0] = kn[kb][0]; kf[kb][1] = kn[kb][1]; }
        }
        l += __shfl_xor(l, 16); l += __shfl_xor(l, 32);
#undef DSA_KLOAD
#undef DSA_VDMA
        if (c16 < 4) {
            const float rl = 1.0f / l;
            GAS bf16_t* orow = WSL(bf16_t, WS_OCAT) + (rowb + t) * DM + 512 + c16 * 64 + 4 * g4;
#pragma unroll
            for (int db = 0; db < 4; ++db) { u32x2 w; w.x = cvtpk(O[db][0] * rl, O[db][1] * rl); w.y = cvtpk(O[db][2] * rl, O[db][3] * rl); *(GAS u32x2*)(orow + 16 * db) = w; }
        }
    }
}
#undef WSL

__device__ __forceinline__ void p2_attention(Frame& F) {
    const int NIT = NB * (SEQ / 32);
#ifndef REP_DSA
#define REP_DSA 1
#endif
#ifndef REP_SWAMEM
#define REP_SWAMEM 1
#endif
    for (int rep = 0; rep < REP_DSA; ++rep)
    for (int r = 0; r < (NIT + F.G - 1) / F.G; ++r) {
        int b, tile;
        if (F.G == 256) { const int j = F.vcu & 63; b = F.vcu >> 6; tile = r == 0 ? j : (r == 1 ? 127 - j : (r == 2 ? 128 + j : 255 - j)); }
        else { const int it = r * F.G + F.vcu; if (it >= NIT) break; b = it / (SEQ / 32); tile = it % (SEQ / 32); }
        dsa_item(F, b, tile * 32);
    }
    for (int rep = 0; rep < REP_SWAMEM; ++rep) {
    for (int it = F.vcu; it < NB * (SEQ / 128); it += F.G) swa_item(F, it / (SEQ / 128), it % (SEQ / 128));
    for (int it = F.vcu; it < NB * (SEQ / 128); it += F.G) mem_item(F, it / (SEQ / 128), it % (SEQ / 128));
    }
}

#ifndef MK_N_LAUNCHES
#define MK_N_LAUNCHES 1
#endif
constexpr int N_PHASES = 8;
struct Args { const void* in[17]; float* out; unsigned char* ws; int ph_lo, ph_hi, li, pad; };

__global__ void __launch_bounds__(NWAVES * 64, 2) hybrid_fwd(Args args) {
    extern __shared__ __attribute__((aligned(16))) unsigned char lds[];
    Frame F;
    F.lds = (LAS unsigned char*)lds;
    F.MISC = (volatile LAS unsigned*)(F.lds + MISC_OFF);
    F.tid = threadIdx.x; F.lane = F.tid & 63; F.wave = __builtin_amdgcn_readfirstlane(F.tid >> 6);
    F.G = gridDim.x; { const int bx = blockIdx.x; F.vcu = (F.G % 8 == 0) ? (bx % 8) * (F.G / 8) + bx / 8 : bx; }
    F.ws = args.ws; F.ctl = (unsigned*)(args.ws + WS_CTL);
    F.x = (const float*)args.in[0]; F.mem = (const float*)args.in[1]; F.positions = (const int*)args.in[2]; F.g_mix = (const float*)args.in[3]; F.w_in = (const float*)args.in[4];
    F.b_gate = (const float*)args.in[5]; F.sinks = (const float*)args.in[6]; F.g_mem = (const float*)args.in[7]; F.w_mem_kv = (const float*)args.in[8]; F.w_proj_swa = (const float*)args.in[9];
    F.w_proj_dsa = (const float*)args.in[10]; F.w_proj_mem = (const float*)args.in[11]; F.w_out = (const float*)args.in[12]; F.g_mlp = (const float*)args.in[13]; F.w_mlp_in = (const float*)args.in[14];
    F.w_mlp_out = (const float*)args.in[15]; F.g_final = (const float*)args.in[16]; F.out = args.out;
    for (int u = F.tid; u < (LDS_BYTES - LDSCTL_OFF) / 4; u += NWAVES * 64) ((LAS unsigned*)(F.lds + LDSCTL_OFF))[u] = 0u;
    __syncthreads();
    XcdBarrier bar; bar.bar = F.ctl + CW_BAR + args.li * XCD_BAR_WORDS; bar.x = 0; bar.st = nullptr;
    if (args.ph_hi - args.ph_lo > 1) bar = xcd_barrier_post(F.ctl + CW_BAR + args.li * XCD_BAR_WORDS, F.MISC + 8);
    const int lo = args.ph_lo, hi = args.ph_hi;
#ifndef PHASE_MASK
#define PHASE_MASK 0xff
#endif
#define IN(k) (((PHASE_MASK >> (k)) & 1) && lo <= (k) && (k) < hi)
#define BOTH(k) (IN(k) && IN((k) + 1))
#define GRID_BAR() xcd_barrier(bar)
    const int bx = (int)blockIdx.x;

#ifndef REP_P0
#define REP_P0 1
#endif
    if (IN(0)) { for (int rp_ = 0; rp_ < REP_P0; ++rp_) p0_prologue(F); if (BOTH(0)) GRID_BAR(); }

#ifndef REP_GEMM
#define REP_GEMM 1
#endif
    if (IN(1)) for (int rg_ = 0; rg_ < REP_GEMM; ++rg_) {
        SchedInProj S; S.nM = T / 256; S.nN = NPOS / 256; S.nwg = S.nM * S.nN; S.G = F.G; S.c = bx;
        S.Ab = (const char*)WSP(bf16_t, WS_XB); S.Bb = (const char*)WSP(bf16_t, WS_WIN); S.Am = (const char*)WSP(bf16_t, WS_MEMB); S.Bm = (const char*)WSP(bf16_t, WS_WMEM);
        EpiInProj E; E.inv_rms = WSP(float, WS_INVRMS0); E.inv_rms_mem = WSP(float, WS_INVRMSM); E.cs = WSP(float, WS_CS); E.b_gate = F.b_gate;
        E.q_s = WSP(bf16_t, WS_QS); E.k_s = WSP(bf16_t, WS_KS); E.v_s = WSP(bf16_t, WS_VS); E.q_d = WSP(bf16_t, WS_QD); E.k_d = WSP(bf16_t, WS_KD); E.v_d = WSP(bf16_t, WS_VD);
        E.q_i = WSP(bf16_t, WS_QI); E.k_i = WSP(bf16_t, WS_KI); E.q_m = WSP(bf16_t, WS_QM); E.gates = WSP(bf16_t, WS_GATES); E.mk = WSP(bf16_t, WS_MK); E.mv = WSP(bf16_t, WS_MV); E.w_i = WSP(float, WS_WI);
        pg8::gemm_phase<EpiInProj, SchedInProj, true>(F.lds + RING_OFF, DM, DM, S, E);
        if (BOTH(1) && rg_ == REP_GEMM - 1) GRID_BAR();
    }

    if (IN(2)) { p2_attention(F); if (BOTH(2)) GRID_BAR(); }

    if (IN(3)) {
        SchedMerge S; S.G = F.G; S.c = bx; S.Ab = (const char*)WSP(bf16_t, WS_OCAT); S.Bb = (const char*)WSP(bf16_t, WS_WPROJ);
        EpiMerge E; E.gates = WSP(bf16_t, WS_GATES); E.merged = WSP(bf16_t, WS_MERGED);
        pg8::gemm_phase<EpiMerge, SchedMerge, true>(F.lds + RING_OFF, DM, DM, S, E);
        if (BOTH(3)) GRID_BAR();
    }

    if (IN(4)) {
        SchedGrid S; S.nM = T / 256; S.nN = DM / 256; S.nwg = S.nM * S.nN; S.G = F.G; S.c = bx; S.nt = DM / 64;
        S.Ab = (const char*)WSP(bf16_t, WS_MERGED); S.Bb = (const char*)WSP(bf16_t, WS_WOUT); S.tA = (size_t)256 * DM * 2; S.tB = (size_t)256 * DM * 2;
        EpiResid<true> E; E.base = F.x; E.out = F.out; E.outb = WSP(bf16_t, WS_XB); E.ssq = WSP(float, WS_SSQ1);
        pg8::gemm_phase<EpiResid<true>, SchedGrid, true>(F.lds + RING_OFF, DM, DM, S, E);
        if (BOTH(4)) GRID_BAR();
    }

    if (IN(5)) for (int rg_ = 0; rg_ < REP_GEMM; ++rg_) {
        SchedGrid S; S.nM = T / 256; S.nN = DFF / 256; S.nwg = S.nM * S.nN; S.G = F.G; S.c = bx; S.nt = DM / 64;
        S.Ab = (const char*)WSP(bf16_t, WS_XB); S.Bb = (const char*)WSP(bf16_t, WS_W1); S.tA = (size_t)256 * DM * 2; S.tB = (size_t)256 * DM * 2;
        EpiMlpIn E; E.ssq = WSP(float, WS_SSQ1); E.hid = WSP(bf16_t, WS_HID);
        pg8::gemm_phase<EpiMlpIn, SchedGrid, true>(F.lds + RING_OFF, DM, DM, S, E);
        if (BOTH(5) && rg_ == REP_GEMM - 1) GRID_BAR();
    }

    if (IN(6)) {
        SchedGrid S; S.nM = T / 256; S.nN = DM / 256; S.nwg = S.nM * S.nN; S.G = F.G; S.c = bx; S.nt = DFF / 64;
        S.Ab = (const char*)WSP(bf16_t, WS_HID); S.Bb = (const char*)WSP(bf16_t, WS_W2); S.tA = (size_t)256 * DFF * 2; S.tB = (size_t)256 * DFF * 2;
        EpiResid<false> E; E.base = F.out; E.out = F.out; E.outb = nullptr; E.ssq = WSP(float, WS_SSQ2);
        pg8::gemm_phase<EpiResid<false>, SchedGrid, true>(F.lds + RING_OFF, DFF, DFF, S, E);
        if (BOTH(6)) GRID_BAR();
    }

    if (IN(7)) p7_final_norm(F);
#undef IN
#undef BOTH
#undef GRID_BAR
}

extern "C" void kernel_launch(void* const* d_in, const int* in_sizes, int n_in, void* d_out, int out_size, void* d_ws, size_t ws_size, hipStream_t stream) {
    static int grid = 0;
    if (grid == 0) {
        if (n_in != 17 || in_sizes[0] != T * DM || out_size != T * DM || ws_size < WS_END) { fprintf(stderr, "kernel_launch: unexpected shapes (n_in %d, in0 %d, out %d, ws %zu < %zu); nothing launched\n", n_in, n_in > 0 ? in_sizes[0] : -1, out_size, ws_size, (size_t)WS_END); grid = -1; return; }
        int dev = 0, cus = 0, per_cu = 0;
        if (hipGetDevice(&dev) != hipSuccess || hipDeviceGetAttribute(&cus, hipDeviceAttributeMultiprocessorCount, dev) != hipSuccess) { grid = -1; return; }
        if (hipFuncSetAttribute((const void*)hybrid_fwd, hipFuncAttributeMaxDynamicSharedMemorySize, LDS_BYTES) != hipSuccess) { fprintf(stderr, "kernel_launch: hipFuncSetAttribute failed\n"); grid = -1; return; }
        if (hipOccupancyMaxActiveBlocksPerMultiprocessor(&per_cu, (const void*)hybrid_fwd, NWAVES * 64, LDS_BYTES) != hipSuccess || per_cu < 1) { fprintf(stderr, "kernel_launch: occupancy query reports %d workgroups per CU; nothing launched\n", per_cu); (void)hipGetLastError(); grid = -1; return; }
        (void)hipGetLastError();
        grid = cus;
    }
    if (grid < 0) return;
    if (hipMemsetAsync((char*)d_ws + WS_CTL, 0, CTL_ZERO_BYTES, stream) != hipSuccess) return;
    Args a{};
    for (int i = 0; i < 17; ++i) a.in[i] = d_in[i];
    a.out = (float*)d_out; a.ws = (unsigned char*)d_ws;
    if (MK_N_LAUNCHES == 1) { a.ph_lo = 0; a.ph_hi = N_PHASES; a.li = 0; hipLaunchKernelGGL(hybrid_fwd, dim3(grid), dim3(NWAVES * 64), LDS_BYTES, stream, a); }
    else { for (int p = 0; p < N_PHASES; ++p) { a.ph_lo = p; a.ph_hi = p + 1; a.li = 0; hipLaunchKernelGGL(hybrid_fwd, dim3(grid), dim3(NWAVES * 64), LDS_BYTES, stream, a); } }
}
```

```cpp
#include <hip/hip_runtime.h>
#include <cstdio>
#include <cstdint>

#define LAS __attribute__((address_space(3)))
#define GAS __attribute__((address_space(1)))
typedef unsigned short bf16_t;
typedef short bf16x8 __attribute__((ext_vector_type(8)));
typedef float f32x2 __attribute__((ext_vector_type(2)));
typedef float f32x4 __attribute__((ext_vector_type(4)));
typedef float f32x16 __attribute__((ext_vector_type(16)));
typedef unsigned u32x2 __attribute__((ext_vector_type(2)));
typedef unsigned u32x4 __attribute__((ext_vector_type(4)));
typedef __bf16 bf16x2_t __attribute__((ext_vector_type(2)));

constexpr int NB = 4, SEQ = 8192, T = NB * SEQ, DM = 1024, DFF = 4096, DIN = 4804, NPOS = 4864, MEMLEN = 256, MROWS = NB * MEMLEN;
constexpr float EPS = 1e-6f;
constexpr float LOG2E = 1.4426950408889634f;
constexpr float QSCALE = 0.125f * LOG2E;
constexpr float IDX_SCALE = 0.0625f;
constexpr int TOPK = 256;
constexpr int P_QS = 0, P_KS = 512, P_VS = 640, P_QD = 768, P_KD = 1024, P_VD = 1088, P_QI = 1152, P_KI = 1408, P_QM = 1472, P_GATE = 1728, P_WI = 4800, P_END = 4804;

constexpr size_t MiB = 1u << 20;
constexpr size_t WS_CTL = 0, CTL_ZERO_BYTES = 1 * MiB;
constexpr size_t WS_WIN = 1 * MiB, WS_WMEM = 11 * MiB, WS_WPROJ = 12 * MiB, WS_WOUT = 14 * MiB, WS_W1 = 16 * MiB, WS_W2 = 24 * MiB;
constexpr size_t WS_INVRMS0 = 32 * MiB, WS_INVRMSM = 32 * MiB + 128 * 1024, WS_WI = 32 * MiB + 256 * 1024;
constexpr size_t WS_SSQ1 = 33 * MiB, WS_SSQ2 = 35 * MiB, WS_CS = 37 * MiB, WS_MEMB = 45 * MiB, WS_MK = 47 * MiB, WS_MV = 47 * MiB + 512 * 1024;
constexpr size_t WS_XB = 48 * MiB;
constexpr size_t WS_OCAT = 112 * MiB;
constexpr size_t WS_QS = 176 * MiB, WS_KS = 208 * MiB, WS_VS = 216 * MiB, WS_QD = 224 * MiB, WS_KD = 240 * MiB, WS_VD = 244 * MiB, WS_QI = 248 * MiB, WS_KI = 264 * MiB, WS_QM = 268 * MiB;
constexpr size_t WS_GATES = 284 * MiB;
constexpr size_t WS_MERGED = 176 * MiB;
constexpr size_t WS_HID = 176 * MiB;
constexpr size_t WS_END = 476 * MiB;
static_assert(WS_WIN + (size_t)NPOS * DM * 2 <= WS_WMEM && WS_GATES + (size_t)T * 3072 * 2 <= WS_END && WS_HID + (size_t)T * DFF * 2 <= WS_END, "d_ws map");
constexpr int CW_TMO = 0, CW_CODE = 1, CW_BAR = 4096;

constexpr int RING_OFF = 0, RING_BYTES = 131072;
constexpr int LDS_BYTES = 163840;
constexpr int LDSCTL_OFF = LDS_BYTES - 512, MISC_OFF = LDSCTL_OFF + 320;
constexpr int NWAVES = 8;

#define LDS_WAIT() asm volatile("s_waitcnt lgkmcnt(0)" ::: "memory")
#define VM_WAIT() asm volatile("s_waitcnt vmcnt(0)" ::: "memory")
#define RLX_AGENT __ATOMIC_RELAXED, __HIP_MEMORY_SCOPE_AGENT

__device__ __forceinline__ unsigned cvtpk(float lo, float hi) { f32x2 v = {lo, hi}; bf16x2_t b = __builtin_convertvector(v, bf16x2_t); return __builtin_bit_cast(unsigned, b); }
__device__ __forceinline__ float bf_lo(unsigned w) { return __uint_as_float(w << 16); }
__device__ __forceinline__ float bf_hi(unsigned w) { return __uint_as_float(w & 0xffff0000u); }
__device__ __forceinline__ float wave_sum(float v) {
#pragma unroll
    for (int o = 1; o < 64; o <<= 1) v += __shfl_xor(v, o);
    return v;
}
__device__ __forceinline__ float wave_max(float v) {
#pragma unroll
    for (int o = 1; o < 64; o <<= 1) v = fmaxf(v, __shfl_xor(v, o));
    return v;
}

namespace pg8 {
constexpr int BM = 256, BK = 64, HALF = 128, HTB = HALF * BK * 2  , STAGE_BYTES = 8 * HTB, NXCD = 8, WGM = 8;
__host__ __device__ __forceinline__ int lds_byte(int r, int c) { const int st = (r >> 4) * 2 + (c >> 5), rr = r & 15, cc = c & 31, ob = rr * 64 + cc * 2; return st * 1024 + (ob ^ (((ob >> 9) & 1) << 5)); }
__host__ __device__ __forceinline__ void stage_rc(int b, int& R, int& C) { const int st = b / 1024, sb = b % 1024, swz = sb ^ (((sb >> 9) & 1) << 5); R = (st >> 1) * 16 + swz / 64; C = (st & 1) * 32 + (swz % 64) / 2; }
__host__ __device__ __forceinline__ int perm32(int rho) { const int n = rho >> 4, i = rho & 15; return 8 * (i >> 2) + 4 * n + (i & 3); }

struct Unit { int pm, pn, kind, nt; const char* A; const char* B; };

__device__ __forceinline__ void map_tile(int L, int nM, int nN, int& pm, int& pn) {
    const int nwg = nM * nN;
    int wgid = L; { const int q = nwg / NXCD, r = nwg % NXCD, xcd = wgid % NXCD, off = wgid / NXCD; wgid = (xcd < r ? xcd * (q + 1) : r * (q + 1) + (xcd - r) * q) + off; }
    const int nig = WGM * nN, gid = wgid / nig, fm = gid * WGM, gsz = (nM - fm) < WGM ? (nM - fm) : WGM;
    pm = fm + ((wgid % nig) % gsz); pn = (wgid % nig) / gsz;
}

template <class Epi, class Sched, bool ALIGN_EPI>
__device__ __forceinline__ void gemm_phase(LAS unsigned char* lds, const int lda, const int ldb, const Sched& S, const Epi& E) {
    const int tid = threadIdx.x, wid = __builtin_amdgcn_readfirstlane(tid >> 6), lane = tid & 63, wr = wid >> 2, wc = wid & 3, fr = lane & 15, fq = lane >> 4;
    unsigned voffA[2], voffB[2];
#pragma unroll
    for (int i = 0; i < 2; ++i) { int R, C; stage_rc(tid * 16 + i * 8192, R, C); const int Rb = Epi::PERM ? ((R & ~31) + perm32(R & 31)) : R;
        voffA[i] = (unsigned)(R * lda + C) * 2u; voffB[i] = (unsigned)(Rb * ldb + C) * 2u; }
    const size_t kstep = (size_t)(BK * 2);
    const size_t hstepA = (size_t)HALF * lda * 2, hstepB = (size_t)HALF * ldb * 2;
    const unsigned ldsw = (unsigned)wid * 1024u;
    const int aoff = lds_byte(wr * 64 + fr, fq * 8), boff = lds_byte(wc * 32 + fr, fq * 8);
#define PG8_SA(b, h) (((b) * 2 + (h)) * HTB)
#define PG8_SB(b, h) ((4 + (b) * 2 + (h)) * HTB)
#define PG8_STAGE(bufoff, gbase, voff) do { _Pragma("unroll") for (int _i = 0; _i < 2; ++_i) \
        __builtin_amdgcn_global_load_lds((const unsigned*)((const char*)(gbase) + (voff)[_i]), (LAS unsigned*)(lds + (bufoff) + ldsw + _i * 8192), 16, 0, 0); } while (0)
#define PG8_LDA(dst, b, h) do { _Pragma("unroll") for (int m = 0; m < 4; ++m) _Pragma("unroll") for (int k = 0; k < 2; ++k) dst[m][k] = *(const LAS bf16x8*)(lds + PG8_SA(b, h) + aoff + m * 2048 + k * 1024); } while (0)
#define PG8_LDB(dst, b, h) do { _Pragma("unroll") for (int n = 0; n < 2; ++n) _Pragma("unroll") for (int k = 0; k < 2; ++k) dst[n][k] = *(const LAS bf16x8*)(lds + PG8_SB(b, h) + boff + n * 2048 + k * 1024); } while (0)
#define PG8_MMA(ai, bj, At, Bt) do { __builtin_amdgcn_s_setprio(1); _Pragma("unroll") for (int m = 0; m < 4; ++m) _Pragma("unroll") for (int n = 0; n < 2; ++n) _Pragma("unroll") for (int k = 0; k < 2; ++k) \
        acc[ai][bj][m][n] = __builtin_amdgcn_mfma_f32_16x16x32_bf16(Bt[n][k], At[m][k], acc[ai][bj][m][n], 0, 0, 0); __builtin_amdgcn_s_setprio(0); } while (0)
#define PG8_WAIT_V(n) asm volatile("s_waitcnt vmcnt(" #n ")" ::: "memory")
#define PG8_WAIT_L(n) asm volatile("s_waitcnt lgkmcnt(" #n ")" ::: "memory")
#define PG8_BAR __builtin_amdgcn_s_barrier()
#define PG8_SCHED __builtin_amdgcn_sched_barrier(0)
    Unit cur, nxt; int ui = 0;
    if (!S.next(0, cur)) return;
    f32x4 acc[2][2][4][2];
#pragma unroll
    for (int a = 0; a < 2; ++a)
#pragma unroll
        for (int b = 0; b < 2; ++b)
#pragma unroll
            for (int m = 0; m < 4; ++m)
#pragma unroll
                for (int n = 0; n < 2; ++n) acc[a][b][m][n] = (f32x4){0.f, 0.f, 0.f, 0.f};
    bf16x8 At[4][2], B0[2][2], B1[2][2];
    const char* cA = cur.A; const char* cB = cur.B;
    PG8_STAGE(PG8_SB(0, 0), cB, voffB); PG8_STAGE(PG8_SB(0, 1), cB + hstepB, voffB); PG8_STAGE(PG8_SA(0, 0), cA, voffA); PG8_STAGE(PG8_SA(0, 1), cA + hstepA, voffA);
    if (wr == 1) PG8_BAR;
    PG8_WAIT_V(2); PG8_BAR;
    PG8_STAGE(PG8_SB(1, 0), cB + kstep, voffB); PG8_STAGE(PG8_SA(1, 0), cA + kstep, voffA); PG8_STAGE(PG8_SB(1, 1), cB + hstepB + kstep, voffB);
    PG8_WAIT_V(6); PG8_BAR;
    for (;;) {
        const bool has_next = S.next(ui + 1, nxt);
        const char* nA = has_next ? nxt.A : cA; const char* nB = has_next ? nxt.B : cB;
        const int nt = cur.nt;
        for (int t = 0; t < nt; t += 2) {
            const bool last = (t == nt - 2);
            const char* a1 = cA + (size_t)(t + 1) * kstep;
            const char* a2 = last ? nA : cA + (size_t)(t + 2) * kstep; const char* b2 = last ? nB : cB + (size_t)(t + 2) * kstep;
            const char* a3 = a2 + kstep; const char* b3 = b2 + kstep;
            PG8_LDB(B0, 0, 0); PG8_LDB(B1, 0, 1); PG8_SCHED; PG8_LDA(At, 0, 0); PG8_STAGE(PG8_SA(1, 1), a1 + hstepA, voffA);
            PG8_WAIT_V(8); PG8_WAIT_L(0); PG8_BAR; PG8_MMA(0, 0, At, B0); PG8_MMA(0, 1, At, B1); PG8_BAR; PG8_SCHED;
            PG8_LDA(At, 0, 1); PG8_STAGE(PG8_SB(0, 0), b2, voffB); PG8_STAGE(PG8_SB(0, 1), b2 + hstepB, voffB); PG8_STAGE(PG8_SA(0, 0), a2, voffA);
            PG8_WAIT_V(8); PG8_WAIT_L(0); PG8_BAR; PG8_MMA(1, 0, At, B0); PG8_MMA(1, 1, At, B1); PG8_BAR; PG8_SCHED;
            PG8_LDB(B0, 1, 0); PG8_LDB(B1, 1, 1); PG8_SCHED; PG8_LDA(At, 1, 0); PG8_STAGE(PG8_SA(0, 1), a2 + hstepA, voffA);
            PG8_WAIT_V(8); PG8_WAIT_L(0); PG8_BAR; PG8_MMA(0, 0, At, B0); PG8_MMA(0, 1, At, B1); PG8_BAR; PG8_SCHED;
            PG8_LDA(At, 1, 1); PG8_STAGE(PG8_SB(1, 0), b3, voffB); PG8_STAGE(PG8_SB(1, 1), b3 + hstepB, voffB); PG8_STAGE(PG8_SA(1, 0), a3, voffA);
            PG8_WAIT_V(8); PG8_WAIT_L(0); PG8_BAR; PG8_MMA(1, 0, At, B0); PG8_MMA(1, 1, At, B1); PG8_BAR; PG8_SCHED;
        }
        if constexpr (ALIGN_EPI) { if (wr == 0) PG8_BAR; }
        E(acc, cur, wr, wc, fr, fq);
        if (!has_next) break;
#pragma unroll
        for (int a = 0; a < 2; ++a)
#pragma unroll
            for (int b = 0; b < 2; ++b)
#pragma unroll
                for (int m = 0; m < 4; ++m)
#pragma unroll
                    for (int n = 0; n < 2; ++n) acc[a][b][m][n] = (f32x4){0.f, 0.f, 0.f, 0.f};
        cur = nxt; cA = nA; cB = nB; ++ui;
        if constexpr (ALIGN_EPI) { if (wr == 1) PG8_BAR; }
    }
    PG8_WAIT_V(0);
    if constexpr (!ALIGN_EPI) { if (wr == 0) PG8_BAR; }
    PG8_BAR;
#undef PG8_SA
#undef PG8_SB
#undef PG8_STAGE
#undef PG8_LDA
#undef PG8_LDB
#undef PG8_MMA
#undef PG8_WAIT_V
#undef PG8_WAIT_L
#undef PG8_BAR
#undef PG8_SCHED
}
}

struct SchedGrid {
    int nM, nN, nwg, G, c, nt; const char* Ab; const char* Bb; size_t tA, tB;
    __device__ __forceinline__ bool next(int i, pg8::Unit& u) const {
        const long L = (long)i * G + c; if (L >= nwg) return false;
        pg8::map_tile((int)L, nM, nN, u.pm, u.pn); u.kind = 0; u.nt = nt; u.A = Ab + (size_t)u.pm * tA; u.B = Bb + (size_t)u.pn * tB; return true;
    }
};
struct SchedInProj {
    int nM, nN, nwg, G, c; const char* Ab; const char* Bb; const char* Am; const char* Bm;
    __device__ __forceinline__ bool next(int i, pg8::Unit& u) const {
        const long L = (long)i * G + c; if (L >= nwg + 8) return false;
        u.nt = DM / 64;
        if (L < nwg) { pg8::map_tile((int)L, nM, nN, u.pm, u.pn); u.kind = 0; u.A = Ab + (size_t)u.pm * (256 * DM * 2); u.B = Bb + (size_t)u.pn * (256 * DM * 2); }
        else { const int e = (int)(L - nwg); u.pm = e >> 1; u.pn = e & 1; u.kind = 1; u.A = Am + (size_t)u.pm * (256 * DM * 2); u.B = Bm + (size_t)u.pn * (256 * DM * 2); }
        return true;
    }
};
struct SchedMerge {
    int G, c; const char* Ab; const char* Bb;
    __device__ __forceinline__ bool next(int i, pg8::Unit& u) const {
        const int round = i / 3, br = i - 3 * round; const long L = (long)round * G + c; if (L >= 512) return false;
        pg8::map_tile((int)L, 128, 4, u.pm, u.pn); u.kind = br; u.nt = br == 0 ? 8 : 4;
        const int koff = br == 0 ? 0 : (br == 1 ? 512 : 768);
        u.A = Ab + (size_t)u.pm * (256 * DM * 2) + koff * 2; u.B = Bb + (size_t)u.pn * (256 * DM * 2) + koff * 2; return true;
    }
};

__device__ __forceinline__ float sigmoidf_fast(float x) { return __builtin_amdgcn_rcpf(1.0f + __builtin_amdgcn_exp2f(-x * LOG2E)); }

struct EpiInProj {
    static constexpr bool PERM = true;
    const float* inv_rms; const float* inv_rms_mem; const float* cs; const float* b_gate;
    bf16_t *q_s, *k_s, *v_s, *q_d, *k_d, *v_d, *q_i, *k_i, *q_m, *gates, *mk, *mv; float* w_i;
    __device__ __forceinline__ void operator()(const f32x4 (&acc)[2][2][4][2], const pg8::Unit& u, int wr, int wc, int fr, int fq) const {
        if (u.kind == 1) {
            bf16_t* dst = u.pn == 0 ? mk : mv;
#pragma unroll
            for (int ai = 0; ai < 2; ++ai)
#pragma unroll
                for (int m = 0; m < 4; ++m) { const int row = u.pm * 256 + ai * 128 + wr * 64 + m * 16 + fr; const float s = inv_rms_mem[row];
#pragma unroll
                    for (int bj = 0; bj < 2; ++bj) { const f32x4 v0 = acc[ai][bj][m][0] * s, v1 = acc[ai][bj][m][1] * s;
                        u32x4 w; w.x = cvtpk(v0[0], v0[1]); w.y = cvtpk(v0[2], v0[3]); w.z = cvtpk(v1[0], v1[1]); w.w = cvtpk(v1[2], v1[3]);
                        *(u32x4*)(dst + (size_t)row * 256 + bj * 128 + wc * 32 + 8 * fq) = w; } }
            return;
        }
#pragma unroll
        for (int bj = 0; bj < 2; ++bj) {
            const int pos0 = u.pn * 256 + bj * 128 + wc * 32;
            const int p = pos0 + 8 * fq;
            int kind; bf16_t* dst; int ld, sec0; float scl = 1.f;
            if (pos0 < P_KS)        { kind = 0; dst = q_s; ld = 512; sec0 = P_QS; scl = QSCALE; }
            else if (pos0 < P_VS)   { kind = 0; dst = k_s; ld = 128; sec0 = P_KS; }
            else if (pos0 < P_QD)   { kind = 1; dst = v_s; ld = 128; sec0 = P_VS; }
            else if (pos0 < P_KD)   { kind = 0; dst = q_d; ld = 256; sec0 = P_QD; scl = QSCALE; }
            else if (pos0 < P_VD)   { kind = 0; dst = k_d; ld = 64;  sec0 = P_KD; }
            else if (pos0 < P_QI)   { kind = 1; dst = v_d; ld = 64;  sec0 = P_VD; }
            else if (pos0 < P_KI)   { kind = 0; dst = q_i; ld = 256; sec0 = P_QI; }
            else if (pos0 < P_QM)   { kind = 0; dst = k_i; ld = 64;  sec0 = P_KI; }
            else if (pos0 < P_GATE) { kind = 1; dst = q_m; ld = 256; sec0 = P_QM; scl = QSCALE; }
            else if (pos0 < P_WI)   { kind = 2; dst = gates; ld = 3072; sec0 = P_GATE; }
            else                    { kind = 3; dst = nullptr; ld = 0; sec0 = P_WI; }
            const int lp = p - sec0;
            if (kind == 0) {
                const int head = lp >> 6, i0 = (lp & 63) >> 1;
#pragma unroll
                for (int ai = 0; ai < 2; ++ai)
#pragma unroll
                    for (int m = 0; m < 4; ++m) { const int row = u.pm * 256 + ai * 128 + wr * 64 + m * 16 + fr; const float s = inv_rms[row] * scl;
                        const f32x4 v0 = acc[ai][bj][m][0] * s, v1 = acc[ai][bj][m][1] * s;
                        const f32x4 ca = *(const f32x4*)(cs + (size_t)row * 64 + 2 * i0), cb = *(const f32x4*)(cs + (size_t)row * 64 + 2 * i0 + 4);
                        const float a0 = v0[0] * ca[0] - v0[1] * ca[1], b0 = v0[1] * ca[0] + v0[0] * ca[1];
                        const float a1 = v0[2] * ca[2] - v0[3] * ca[3], b1 = v0[3] * ca[2] + v0[2] * ca[3];
                        const float a2 = v1[0] * cb[0] - v1[1] * cb[1], b2 = v1[1] * cb[0] + v1[0] * cb[1];
                        const float a3 = v1[2] * cb[2] - v1[3] * cb[3], b3 = v1[3] * cb[2] + v1[2] * cb[3];
                        bf16_t* o = dst + (size_t)row * ld + head * 64 + i0;
                        u32x2 wa, wb; wa.x = cvtpk(a0, a1); wa.y = cvtpk(a2, a3); wb.x = cvtpk(b0, b1); wb.y = cvtpk(b2, b3);
                        *(u32x2*)o = wa; *(u32x2*)(o + 32) = wb; }
            } else if (kind == 1) {
#pragma unroll
                for (int ai = 0; ai < 2; ++ai)
#pragma unroll
                    for (int m = 0; m < 4; ++m) { const int row = u.pm * 256 + ai * 128 + wr * 64 + m * 16 + fr; const float s = inv_rms[row] * scl;
                        const f32x4 v0 = acc[ai][bj][m][0] * s, v1 = acc[ai][bj][m][1] * s;
                        u32x4 w; w.x = cvtpk(v0[0], v0[1]); w.y = cvtpk(v0[2], v0[3]); w.z = cvtpk(v1[0], v1[1]); w.w = cvtpk(v1[2], v1[3]);
                        *(u32x4*)(dst + (size_t)row * ld + lp) = w; }
            } else if (kind == 2) {
                const f32x4 g0 = *(const f32x4*)(b_gate + lp), g1 = *(const f32x4*)(b_gate + lp + 4);
#pragma unroll
                for (int ai = 0; ai < 2; ++ai)
#pragma unroll
                    for (int m = 0; m < 4; ++m) { const int row = u.pm * 256 + ai * 128 + wr * 64 + m * 16 + fr; const float s = inv_rms[row];
                        const f32x4 v0 = acc[ai][bj][m][0] * s + g0, v1 = acc[ai][bj][m][1] * s + g1;
                        u32x4 w; w.x = cvtpk(sigmoidf_fast(v0[0]), sigmoidf_fast(v0[1])); w.y = cvtpk(sigmoidf_fast(v0[2]), sigmoidf_fast(v0[3]));
                        w.z = cvtpk(sigmoidf_fast(v1[0]), sigmoidf_fast(v1[1])); w.w = cvtpk(sigmoidf_fast(v1[2]), sigmoidf_fast(v1[3]));
                        *(u32x4*)(dst + (size_t)row * ld + lp) = w; }
            } else {
                if (pos0 == P_WI && fq == 0) {
#pragma unroll
                    for (int ai = 0; ai < 2; ++ai)
#pragma unroll
                        for (int m = 0; m < 4; ++m) { const int row = u.pm * 256 + ai * 128 + wr * 64 + m * 16 + fr; const float s = inv_rms[row] * IDX_SCALE;
                            *(f32x4*)(w_i + (size_t)row * 4) = acc[ai][bj][m][0] * s; }
                }
            }
        }
    }
};

struct EpiMerge {
    static constexpr bool PERM = true;
    const bf16_t* gates; bf16_t* merged;
    __device__ __forceinline__ void operator()(const f32x4 (&acc)[2][2][4][2], const pg8::Unit& u, int wr, int wc, int fr, int fq) const {
        const int br = u.kind;
#pragma unroll
        for (int ai = 0; ai < 2; ++ai)
#pragma unroll
            for (int m = 0; m < 4; ++m) { const int row = u.pm * 256 + ai * 128 + wr * 64 + m * 16 + fr;
#pragma unroll
                for (int bj = 0; bj < 2; ++bj) { const int col = u.pn * 256 + bj * 128 + wc * 32 + 8 * fq;
                    const u32x4 g = *(const u32x4*)(gates + (size_t)row * 3072 + br * 1024 + col);
                    f32x4 v0 = acc[ai][bj][m][0], v1 = acc[ai][bj][m][1];
                    v0[0] *= bf_lo(g.x); v0[1] *= bf_hi(g.x); v0[2] *= bf_lo(g.y); v0[3] *= bf_hi(g.y); v1[0] *= bf_lo(g.z); v1[1] *= bf_hi(g.z); v1[2] *= bf_lo(g.w); v1[3] *= bf_hi(g.w);
                    bf16_t* o = merged + (size_t)row * 1024 + col;
                    if (br > 0) { const u32x4 pv = *(const u32x4*)o;
                        v0[0] += bf_lo(pv.x); v0[1] += bf_hi(pv.x); v0[2] += bf_lo(pv.y); v0[3] += bf_hi(pv.y); v1[0] += bf_lo(pv.z); v1[1] += bf_hi(pv.z); v1[2] += bf_lo(pv.w); v1[3] += bf_hi(pv.w); }
                    u32x4 w; w.x = cvtpk(v0[0], v0[1]); w.y = cvtpk(v0[2], v0[3]); w.z = cvtpk(v1[0], v1[1]); w.w = cvtpk(v1[2], v1[3]);
                    *(u32x4*)o = w; } }
    }
};

template <bool WRITE_BF> struct EpiResid {
    static constexpr bool PERM = false;
    const float* base; float* out; bf16_t* outb; float* ssq;
    __device__ __forceinline__ void operator()(const f32x4 (&acc)[2][2][4][2], const pg8::Unit& u, int wr, int wc, int fr, int fq) const {
#pragma unroll
        for (int ai = 0; ai < 2; ++ai)
#pragma unroll
            for (int m = 0; m < 4; ++m) { const int row = u.pm * 256 + ai * 128 + wr * 64 + m * 16 + fr; float q = 0.f;
#pragma unroll
                for (int bj = 0; bj < 2; ++bj)
#pragma unroll
                    for (int n = 0; n < 2; ++n) { const size_t off = (size_t)row * DM + u.pn * 256 + bj * 128 + wc * 32 + n * 16 + 4 * fq;
                        const f32x4 o = *(const f32x4*)(base + off) + acc[ai][bj][m][n];
                        *(f32x4*)(out + off) = o; q += (o[0] * o[0] + o[1] * o[1]) + (o[2] * o[2] + o[3] * o[3]);
                        if (WRITE_BF) { u32x2 w; w.x = cvtpk(o[0], o[1]); w.y = cvtpk(o[2], o[3]); *(u32x2*)(outb + off) = w; } }
                q += __shfl_xor(q, 16); q += __shfl_xor(q, 32);
                if (fq == 0) ssq[(size_t)row * 16 + u.pn * 4 + wc] = q; }
    }
};

struct EpiMlpIn {
    static constexpr bool PERM = true;
    const float* ssq; bf16_t* hid;
    __device__ __forceinline__ void operator()(const f32x4 (&acc)[2][2][4][2], const pg8::Unit& u, int wr, int wc, int fr, int fq) const {
#pragma unroll
        for (int ai = 0; ai < 2; ++ai)
#pragma unroll
            for (int m = 0; m < 4; ++m) { const int row = u.pm * 256 + ai * 128 + wr * 64 + m * 16 + fr;
                const f32x4* sp = (const f32x4*)(ssq + (size_t)row * 16); const f32x4 s0 = sp[0], s1 = sp[1], s2 = sp[2], s3 = sp[3];
                const float tot = ((s0[0] + s0[1]) + (s0[2] + s0[3])) + ((s1[0] + s1[1]) + (s1[2] + s1[3])) + ((s2[0] + s2[1]) + (s2[2] + s2[3])) + ((s3[0] + s3[1]) + (s3[2] + s3[3]));
                const float s = 1.0f / sqrtf(tot * (1.0f / DM) + EPS);
#pragma unroll
                for (int bj = 0; bj < 2; ++bj) { f32x4 v0 = acc[ai][bj][m][0] * s, v1 = acc[ai][bj][m][1] * s;
#pragma unroll
                    for (int e = 0; e < 4; ++e) { const float a = fmaxf(v0[e], 0.f), b = fmaxf(v1[e], 0.f); v0[e] = a * a; v1[e] = b * b; }
                    u32x4 w; w.x = cvtpk(v0[0], v0[1]); w.y = cvtpk(v0[2], v0[3]); w.z = cvtpk(v1[0], v1[1]); w.w = cvtpk(v1[2], v1[3]);
                    *(u32x4*)(hid + (size_t)row * DFF + u.pn * 256 + bj * 128 + wc * 32 + 8 * fq) = w; } }
    }
};

#define XB_TMO      128
#define XB_XCNT(j)  (256  + 64 * (j))
#define XB_XSUB(j)  (1280 + 64 * (j))
#define XB_XGEN(j)  (2304 + 64 * (j))
#define XB_TOP      3328
#define XB_TOPGEN   3392
#define XCD_BAR_WORDS 3456
#define XB_SPIN_CAP (1u << 20)
__device__ __forceinline__ unsigned xb_ld(unsigned* p)              { return __hip_atomic_load(p, __ATOMIC_RELAXED, __HIP_MEMORY_SCOPE_AGENT); }
__device__ __forceinline__ unsigned xb_add(unsigned* p, unsigned v) { return __hip_atomic_fetch_add(p, v, __ATOMIC_RELAXED, __HIP_MEMORY_SCOPE_AGENT); }
__device__ __forceinline__ unsigned xb_xcc_id() { return (unsigned)__builtin_amdgcn_s_getreg((3 << 11) | 20) & 0xFu; }
#define XB_SPIN(cond, bar) do { unsigned _sp = 0; while (cond) { __builtin_amdgcn_s_sleep(1); \
    if ((++_sp & 255u) == 0u) { if (xb_ld(&(bar)[XB_TMO])) break; if (_sp > XB_SPIN_CAP) { atomicAdd(&(bar)[XB_TMO], 1u); break; } } } } while (0)
struct XcdBarrier { unsigned* bar; unsigned x; volatile LAS unsigned* st; };
__device__ __forceinline__ XcdBarrier xcd_barrier_post(unsigned* bar, volatile LAS unsigned* st) {
    XcdBarrier b; b.bar = bar; b.x = xb_xcc_id(); b.st = st;
    if (threadIdx.x == 0) (void)xb_add(&bar[XB_XCNT(b.x)], 1u);
    return b;
}
__device__ __forceinline__ void xcd_barrier_complete(unsigned* bar, unsigned x, unsigned& nloc, unsigned& nx) {
    const unsigned G = gridDim.x * gridDim.y * gridDim.z;
    unsigned sum, cnt, mine, sp = 0u;
    for (;;) {
        sum = 0u; cnt = 0u; mine = 0u;
#pragma unroll
        for (unsigned j = 0; j < 16; ++j) { const unsigned c = xb_ld(&bar[XB_XCNT(j)]); sum += c; cnt += (c > 0u) ? 1u : 0u; mine = (j == x) ? c : mine; }
        if (sum == G) break;
        __builtin_amdgcn_s_sleep(1);
        if ((++sp & 255u) == 0u) { if (xb_ld(&bar[XB_TMO])) break; if (sp > XB_SPIN_CAP) { atomicAdd(&bar[XB_TMO], 1u); break; } }
    }
    nloc = mine > 0u ? mine : 1u; nx = cnt > 0u ? cnt : 1u;
}
__device__ __forceinline__ void xcd_barrier(const XcdBarrier& b) {
    asm volatile("s_waitcnt vmcnt(0)" ::: "memory");
    __syncthreads();
    if (threadIdx.x == 0) {
        unsigned* bar = b.bar;
        __builtin_amdgcn_s_waitcnt(0);
        unsigned nloc = b.st[0], nx = b.st[1];
        if (nloc == 0u) { xcd_barrier_complete(bar, b.x, nloc, nx); b.st[0] = nloc; b.st[1] = nx; }
        const unsigned old = xb_add(&bar[XB_XSUB(b.x)], 1u);
        const unsigned gen = old / nloc;
        if (old + 1u == (gen + 1u) * nloc) {
            __builtin_amdgcn_fence(__ATOMIC_RELEASE, "agent");
            asm volatile("s_waitcnt vmcnt(0)" ::: "memory");
            const unsigned og = xb_add(&bar[XB_TOP], 1u);
            const unsigned tg = og / nx;
            if (og + 1u == (tg + 1u) * nx) xb_add(&bar[XB_TOPGEN], 1u);
            else XB_SPIN(xb_ld(&bar[XB_TOPGEN]) == tg, bar);
            __builtin_amdgcn_fence(__ATOMIC_ACQUIRE, "agent");
            xb_add(&bar[XB_XGEN(b.x)], 1u);
            asm volatile("s_waitcnt vmcnt(0)" ::: "memory");
        } else {
            XB_SPIN(xb_ld(&bar[XB_XGEN(b.x)]) == gen, bar);
            __builtin_amdgcn_fence(__ATOMIC_ACQUIRE, "agent");
            asm volatile("s_waitcnt vmcnt(0)" ::: "memory");
        }
    }
    __syncthreads();
}

struct Frame {
    LAS unsigned char* lds;
    volatile LAS unsigned* MISC;
    unsigned* ctl;
    int tid, lane, wave, vcu, G;
    unsigned char* ws;
    const float *x, *mem; const int* positions; const float *g_mix, *w_in, *b_gate, *sinks, *g_mem, *w_mem_kv, *w_proj_swa, *w_proj_dsa, *w_proj_mem, *w_out, *g_mlp, *w_mlp_in, *w_mlp_out, *g_final;
    float* out;
};
#define WSP(T_, off) ((T_*)(F.ws + (off)))

__device__ __forceinline__ int rope_src(int base, int lp) { return base + (lp & ~63) + ((lp & 1) ? 32 + ((lp & 63) >> 1) : ((lp & 63) >> 1)); }
__device__ __forceinline__ int win_src(int pos) {
    if (pos < P_KS) return rope_src(0, pos);
    if (pos < P_VS) return rope_src(512, pos - P_KS);
    if (pos < P_QD) return pos;
    if (pos < P_KD) return rope_src(768, pos - P_QD);
    if (pos < P_VD) return rope_src(1024, pos - P_KD);
    if (pos < P_QI) return pos;
    if (pos < P_KI) return rope_src(1152, pos - P_QI);
    if (pos < P_QM) return rope_src(1408, pos - P_KI);
    if (pos < P_GATE) return 1476 + (pos - P_QM);
    if (pos < P_WI) return 1732 + (pos - P_GATE);
    if (pos < P_END) return 1472 + (pos - P_WI);
    return -1;
}
template <bool MAP> __device__ __forceinline__ void p0_transpose_item(const float* W, int ldw, int k0, int n0, const float* gk, bf16_t* WT, int ldwt, LAS float* scr, int lane) {
    const int j = lane & 31; const int sc = MAP ? win_src(n0 + j) : n0 + j;
#pragma unroll 8
    for (int i = 0; i < 32; ++i) { const int kk = 2 * i + (lane >> 5); float v = sc >= 0 ? W[(size_t)(k0 + kk) * ldw + sc] : 0.f; if (gk) v *= gk[k0 + kk]; scr[kk * 33 + j] = v; }
    LDS_WAIT(); asm volatile("" ::: "memory");
    const int c = lane & 7;
#pragma unroll
    for (int jj = 0; jj < 4; ++jj) { const int n = (lane >> 3) + 8 * jj; const LAS float* s = scr + (8 * c) * 33 + n;
        u32x4 o; o.x = cvtpk(s[0 * 33], s[1 * 33]); o.y = cvtpk(s[2 * 33], s[3 * 33]); o.z = cvtpk(s[4 * 33], s[5 * 33]); o.w = cvtpk(s[6 * 33], s[7 * 33]);
        *(u32x4*)(WT + (size_t)(n0 + n) * ldwt + k0 + 8 * c) = o; }
    LDS_WAIT(); asm volatile("" ::: "memory");
}
__device__ __forceinline__ void row_to_bf16(const float* xrow, bf16_t* orow, float* inv, int lane) {
    const f32x4* xr = (const f32x4*)xrow + lane;
    f32x4 v[4]; float s = 0.f;
#pragma unroll
    for (int j = 0; j < 4; ++j) { v[j] = xr[64 * j]; s += (v[j][0] * v[j][0] + v[j][1] * v[j][1]) + (v[j][2] * v[j][2] + v[j][3] * v[j][3]); }
    s = wave_sum(s);
    if (lane == 0) *inv = 1.0f / sqrtf(s * (1.0f / DM) + EPS);
    u32x2* o8 = (u32x2*)orow + lane;
#pragma unroll
    for (int j = 0; j < 4; ++j) { u32x2 w; w.x = cvtpk(v[j][0], v[j][1]); w.y = cvtpk(v[j][2], v[j][3]); o8[64 * j] = w; }
}
__device__ __forceinline__ void p0_prologue(Frame& F) {
    LAS float* scr = (LAS float*)(F.lds + RING_OFF + F.wave * 16384);
    const int gw = F.vcu * NWAVES + F.wave, NGW = F.G * NWAVES;
    constexpr int I_IN = 16 * (NPOS / 32), I_MEM = 16 * 16, I_PS = 8 * 32, I_PD = 4 * 32, I_PM = 4 * 32, I_OUT = 16 * 32, I_1 = 16 * 128, I_2 = 64 * 32;
    constexpr int NITEMS = I_IN + I_MEM + I_PS + I_PD + I_PM + I_OUT + I_1 + I_2;
    for (int it = gw; it < NITEMS; it += NGW) {
        int r = it;
        if (r < I_IN) { const int nb = NPOS / 32; p0_transpose_item<true>(F.w_in, DIN, 64 * (r / nb), 32 * (r % nb), F.g_mix, WSP(bf16_t, WS_WIN), DM, scr, F.lane); continue; } r -= I_IN;
        if (r < I_MEM) { p0_transpose_item<false>(F.w_mem_kv, 512, 64 * (r / 16), 32 * (r % 16), F.g_mem, WSP(bf16_t, WS_WMEM), DM, scr, F.lane); continue; } r -= I_MEM;
        if (r < I_PS) { p0_transpose_item<false>(F.w_proj_swa, DM, 64 * (r / 32), 32 * (r % 32), nullptr, WSP(bf16_t, WS_WPROJ), DM, scr, F.lane); continue; } r -= I_PS;
        if (r < I_PD) { p0_transpose_item<false>(F.w_proj_dsa, DM, 64 * (r / 32), 32 * (r % 32), nullptr, WSP(bf16_t, WS_WPROJ) + 512, DM, scr, F.lane); continue; } r -= I_PD;
        if (r < I_PM) { p0_transpose_item<false>(F.w_proj_mem, DM, 64 * (r / 32), 32 * (r % 32), nullptr, WSP(bf16_t, WS_WPROJ) + 768, DM, scr, F.lane); continue; } r -= I_PM;
        if (r < I_OUT) { p0_transpose_item<false>(F.w_out, DM, 64 * (r / 32), 32 * (r % 32), nullptr, WSP(bf16_t, WS_WOUT), DM, scr, F.lane); continue; } r -= I_OUT;
        if (r < I_1) { p0_transpose_item<false>(F.w_mlp_in, DFF, 64 * (r / 128), 32 * (r % 128), F.g_mlp, WSP(bf16_t, WS_W1), DM, scr, F.lane); continue; } r -= I_1;
        p0_transpose_item<false>(F.w_mlp_out, DM, 64 * (r / 32), 32 * (r % 32), nullptr, WSP(bf16_t, WS_W2), DFF, scr, F.lane);
    }
    for (int m = gw; m < T; m += NGW) row_to_bf16(F.x + (size_t)m * DM, WSP(bf16_t, WS_XB) + (size_t)m * DM, WSP(float, WS_INVRMS0) + m, F.lane);
    for (int m = gw; m < MROWS; m += NGW) row_to_bf16(F.mem + (size_t)m * DM, WSP(bf16_t, WS_MEMB) + (size_t)m * DM, WSP(float, WS_INVRMSM) + m, F.lane);
    { const int gt = gw * 64 + F.lane, NGT = NGW * 64; const int i = gt & 31;
      const float invf = (float)exp2((double)(-i) * (13.287712379549449 / 32.0));
      float* cs = WSP(float, WS_CS);
      for (int idx = gt; idx < T * 32; idx += NGT) { const float ang = (float)F.positions[idx >> 5] * invf; float s, c; sincosf(ang, &s, &c); *(f32x2*)(cs + (size_t)idx * 2) = (f32x2){c, s}; } }
}

__device__ __forceinline__ void p7_final_norm(Frame& F) {
    const int gw = F.vcu * NWAVES + F.wave, NGW = F.G * NWAVES;
    const float* ssq = WSP(float, WS_SSQ2);
    f32x4 g[4];
#pragma unroll
    for (int j = 0; j < 4; ++j) g[j] = ((const f32x4*)F.g_final)[F.lane + 64 * j];
    for (int m = gw; m < T; m += NGW) {
        float p = F.lane < 16 ? ssq[(size_t)m * 16 + F.lane] : 0.f;
        p = wave_sum(p);
        const float s = 1.0f / sqrtf(p * (1.0f / DM) + EPS);
        f32x4* o = (f32x4*)(F.out + (size_t)m * DM) + F.lane;
#pragma unroll
        for (int j = 0; j < 4; ++j) { const f32x4 v = o[64 * j]; o[64 * j] = v * s * g[j]; }
    }
}

__device__ __forceinline__ int crow(int r, int hi) { return (r & 3) + 8 * (r >> 2) + 4 * hi; }
__device__ __forceinline__ float xor32f(float v) { return __shfl_xor(v, 32); }

template <int MODE> __device__ __forceinline__ void attn32(const bf16_t* Qp, int ldq, const bf16_t* Kp, int ldk, const bf16_t* Vp, int ldv, int jlo, int jhi, int qpos0, float sink_l2, bf16_t* Op, int ldo, int lane) {
    const int r32 = lane & 31, hi = lane >> 5;
    bf16x8 qf[4];
#pragma unroll
    for (int s = 0; s < 4; ++s) qf[s] = *(const bf16x8*)(Qp + (size_t)r32 * ldq + 16 * s + 8 * hi);
    float m = MODE == 1 ? sink_l2 : -INFINITY, l = MODE == 1 ? 1.0f : 0.0f;
    f32x16 o0 = {}, o1 = {};
    const int qp = qpos0 + r32;
    for (int j = jlo; j < jhi; ++j) {
        const bf16_t* kr = Kp + (size_t)(32 * j + r32) * ldk + 8 * hi;
        f32x16 sc = {};
#pragma unroll
        for (int s = 0; s < 4; ++s) { const bf16x8 kf = *(const bf16x8*)(kr + 16 * s); sc = __builtin_amdgcn_mfma_f32_32x32x16_bf16(kf, qf[s], sc, 0, 0, 0); }
        if (MODE == 1) { const int dq = qp - 32 * j - 4 * hi;
#pragma unroll
            for (int i = 0; i < 16; ++i) { const int dk = (i & 3) + 8 * (i >> 2); if (dk > dq || dq - dk >= 128) sc[i] = -INFINITY; }
        }
        float tm = sc[0];
#pragma unroll
        for (int i = 1; i < 16; ++i) tm = fmaxf(tm, sc[i]);
        tm = fmaxf(tm, xor32f(tm));
        const float mn = fmaxf(m, tm);
        const float alpha = (mn == -INFINITY) ? 1.0f : __builtin_amdgcn_exp2f(m - mn);
        const float msub = (mn == -INFINITY) ? 0.0f : mn;
        float rs = 0.f;
#pragma unroll
        for (int i = 0; i < 16; ++i) { sc[i] = __builtin_amdgcn_exp2f(sc[i] - msub); rs += sc[i]; }
        rs += xor32f(rs);
        l = l * alpha + rs; m = mn;
#pragma unroll
        for (int i = 0; i < 16; ++i) { o0[i] *= alpha; o1[i] *= alpha; }
        u32x4 pw[2];
#pragma unroll
        for (int s = 0; s < 2; ++s) { pw[s].x = cvtpk(sc[8 * s + 0], sc[8 * s + 1]); pw[s].y = cvtpk(sc[8 * s + 2], sc[8 * s + 3]); pw[s].z = cvtpk(sc[8 * s + 4], sc[8 * s + 5]); pw[s].w = cvtpk(sc[8 * s + 6], sc[8 * s + 7]); }
#pragma unroll
        for (int s = 0; s < 2; ++s) {
            bf16x8 a0, a1;
#pragma unroll
            for (int jj = 0; jj < 8; ++jj) { const bf16_t* vr = Vp + (size_t)(32 * j + 16 * s + 8 * (jj >> 2) + 4 * hi + (jj & 3)) * ldv + r32; a0[jj] = (short)vr[0]; a1[jj] = (short)vr[32]; }
            const bf16x8 pb = __builtin_bit_cast(bf16x8, pw[s]);
            o0 = __builtin_amdgcn_mfma_f32_32x32x16_bf16(a0, pb, o0, 0, 0, 0);
            o1 = __builtin_amdgcn_mfma_f32_32x32x16_bf16(a1, pb, o1, 0, 0, 0);
        }
    }
    const float rl = 1.0f / l;
    bf16_t* orow = Op + (size_t)r32 * ldo;
#pragma unroll
    for (int g = 0; g < 4; ++g) {
        u32x2 w0, w1; w0.x = cvtpk(o0[4 * g] * rl, o0[4 * g + 1] * rl); w0.y = cvtpk(o0[4 * g + 2] * rl, o0[4 * g + 3] * rl);
        w1.x = cvtpk(o1[4 * g] * rl, o1[4 * g + 1] * rl); w1.y = cvtpk(o1[4 * g + 2] * rl, o1[4 * g + 3] * rl);
        *(u32x2*)(orow + 8 * g + 4 * hi) = w0; *(u32x2*)(orow + 32 + 8 * g + 4 * hi) = w1;
    }
}

__device__ __forceinline__ void swa_item(Frame& F, int b, int qb) {
    const int h = F.wave, kvh = h >> 2;
    const float sink = F.sinks[h] * LOG2E;
    const bf16_t* Kp = WSP(const bf16_t, WS_KS) + (size_t)b * SEQ * 128 + kvh * 64;
    const bf16_t* Vp = WSP(const bf16_t, WS_VS) + (size_t)b * SEQ * 128 + kvh * 64;
    for (int sub = 0; sub < 4; ++sub) {
        const int q0 = qb * 128 + 32 * sub; const int jhi = q0 / 32 + 1; int jlo = jhi - 5; if (jlo < 0) jlo = 0;
        attn32<1>(WSP(const bf16_t, WS_QS) + ((size_t)b * SEQ + q0) * 512 + h * 64, 512, Kp, 128, Vp, 128, jlo, jhi, q0, sink, WSP(bf16_t, WS_OCAT) + ((size_t)b * SEQ + q0) * DM + h * 64, DM, F.lane);
    }
}
__device__ __forceinline__ void mem_item(Frame& F, int b, int qb) {
    const int h = F.wave & 3, half = F.wave >> 2;
    const bf16_t* Kp = WSP(const bf16_t, WS_MK) + (size_t)b * MEMLEN * 256 + h * 64;
    const bf16_t* Vp = WSP(const bf16_t, WS_MV) + (size_t)b * MEMLEN * 256 + h * 64;
    for (int sub = 0; sub < 2; ++sub) {
        const int q0 = qb * 128 + 64 * half + 32 * sub;
        attn32<0>(WSP(const bf16_t, WS_QM) + ((size_t)b * SEQ + q0) * 256 + h * 64, 256, Kp, 256, Vp, 256, 0, MEMLEN / 32, 0, 0.f, WSP(bf16_t, WS_OCAT) + ((size_t)b * SEQ + q0) * DM + 768 + h * 64, DM, F.lane);
    }
}


constexpr int DSA_CAP = 512;
constexpr int MAXLD = 1026;
constexpr int CKLD = 513, CILD = 514;
constexpr int DL_MAX = 0;
constexpr int DL_CKEY = 0;
constexpr int DL_CIDX = 65664;
constexpr int DL_VS = 0;
constexpr int DL_CNT = 98560;
constexpr int DL_HIST = 99584;
constexpr int DL_SEL = 132352;
typedef short v4i16_t __attribute__((ext_vector_type(4)));
__device__ __forceinline__ unsigned fkey(float f) { const unsigned u = __float_as_uint(f); return (u & 0x80000000u) ? ~u : (u | 0x80000000u); }
__device__ __forceinline__ float fkey_inv(unsigned k) { return __uint_as_float((k & 0x80000000u) ? (k & 0x7fffffffu) : ~k); }
__device__ __forceinline__ void glds16(const void* gsrc, unsigned lds_dst) { unsigned keep;
    asm volatile("s_mov_b32 %0, m0\n\ts_mov_b32 m0, %2\n\ts_nop 0\n\tglobal_load_lds_dwordx4 %1, off\n\ts_mov_b32 m0, %0" : "=&s"(keep) : "v"(gsrc), "s"(lds_dst) : "memory"); }

template <int NV, int ROUNDS> __device__ __forceinline__ unsigned radix_kth(const unsigned (&v)[NV], int count, LAS unsigned* hist, int k, int lane, int& k_out, int& ceq_out) {
    unsigned prefix = 0u; int ceq = 0;
#pragma unroll
    for (int r = ROUNDS - 1; r >= 0; --r) {
        const int shift = 8 * r;
        *(LAS u32x4*)(hist + 4 * lane) = (u32x4){0u, 0u, 0u, 0u};
        LDS_WAIT();
#pragma unroll
        for (int i = 0; i < NV; ++i) { const bool ok = (lane + 64 * i < count) && (r == ROUNDS - 1 || (v[i] >> (shift + 8)) == (prefix >> (shift + 8)));
            if (ok) __hip_atomic_fetch_add(hist + ((v[i] >> shift) & 255u), 1u, __ATOMIC_RELAXED, __HIP_MEMORY_SCOPE_WORKGROUP); }
        LDS_WAIT();
        const u32x4 h = *(const LAS u32x4*)(hist + 4 * lane);
        const unsigned s = (h.x + h.y) + (h.z + h.w);
        unsigned Tl = s;
#pragma unroll
        for (int o = 1; o < 64; o <<= 1) { const unsigned t = __shfl_down(Tl, o); if (lane + o < 64) Tl += t; }
        const unsigned long long bal = __ballot(Tl >= (unsigned)k);
        const int ls = bal ? 63 - __clzll(bal) : 0;
        const unsigned above = Tl - s, c3 = above + h.w, c2 = c3 + h.z, c1 = c2 + h.y;
        unsigned bin, kk, cb;
        if (c3 >= (unsigned)k) { bin = 3; kk = k - above; cb = h.w; } else if (c2 >= (unsigned)k) { bin = 2; kk = k - c3; cb = h.z; } else if (c1 >= (unsigned)k) { bin = 1; kk = k - c2; cb = h.y; } else { bin = 0; kk = k - c1; cb = h.x; }
        const unsigned digit = (unsigned)__builtin_amdgcn_readlane((int)(bin + 4u * lane), ls);
        k = __builtin_amdgcn_readlane((int)kk, ls); ceq = __builtin_amdgcn_readlane((int)cb, ls);
        prefix |= digit << shift;
    }
    k_out = k; ceq_out = ceq; return prefix;
}

__device__ __forceinline__ void dsa_item(Frame& F, int b, int t0) {
    const int lane = F.lane, wid = F.wave, r32 = lane & 31, hi = lane >> 5;
    LAS unsigned short* maxbuf = (LAS unsigned short*)(F.lds + DL_MAX);
    LAS unsigned* ckey = (LAS unsigned*)(F.lds + DL_CKEY);
    LAS unsigned short* cidx = (LAS unsigned short*)(F.lds + DL_CIDX);
    LAS unsigned* ccnt = (LAS unsigned*)(F.lds + DL_CNT);
    LAS unsigned* ctau = ccnt + 32;
    LAS unsigned* hist = (LAS unsigned*)(F.lds + DL_HIST) + wid * 1024;
    LAS unsigned short* sel = (LAS unsigned short*)(F.lds + DL_SEL);
    const size_t rowb = (size_t)b * SEQ;
    unsigned char* wsl = F.ws; asm volatile("" : "+s"(wsl));
#define WSL(T_, off) ((GAS T_*)(wsl + (off)))
    __syncthreads();
#ifndef REP_SEL
#define REP_SEL 1
#endif
#ifndef REP_GATHER
#define REP_GATHER 1
#endif
    for (int rep_ = 0; rep_ < REP_SEL; ++rep_) {
    if (rep_) __syncthreads();
    if (t0 >= TOPK) {
        const int nkt = t0 / 32 + 1, nmax = t0 + 32;
        int lg = 0; while ((1024 << lg) < nmax) ++lg;
        const int npl = 16 >> lg;
        bf16x8 qf[4][4]; float wq[4];
        { const GAS bf16_t* qrow = WSL(const bf16_t, WS_QI) + (rowb + t0 + r32) * 256 + 8 * hi;
#pragma unroll
          for (int h = 0; h < 4; ++h)
#pragma unroll
              for (int s = 0; s < 4; ++s) qf[h][s] = *(const GAS bf16x8*)(qrow + h * 64 + 16 * s);
          const f32x4 w4 = *(const GAS f32x4*)(WSL(const float, WS_WI) + (rowb + t0 + r32) * 4); wq[0] = w4[0]; wq[1] = w4[1]; wq[2] = w4[2]; wq[3] = w4[3]; }
        if (F.tid < 32) ccnt[F.tid] = 0u;
        const GAS bf16_t* kbase = WSL(const bf16_t, WS_KI) + (rowb + r32) * 64 + 8 * hi;
        float thrf = 0.f;
#ifndef X_PASS0
#define X_PASS0 0
#endif
#ifndef X_RADIX16
#define X_RADIX16 1
#endif
#ifndef X_EXACT
#define X_EXACT 1
#endif
        for (int pp = -X_PASS0; pp < 2; ++pp) { const int pass = pp < 0 ? 0 : pp;
            if (pass == 1) thrf = fkey_inv(ctau[r32] << 16);
            bf16x8 kn[4];
            if (wid < nkt) {
#pragma unroll
                for (int s = 0; s < 4; ++s) kn[s] = *(const GAS bf16x8*)(kbase + (size_t)(32 * wid) * 64 + 16 * s);
            }
            for (int j = wid; j < nkt; j += NWAVES) {
                bf16x8 kf[4];
#pragma unroll
                for (int s = 0; s < 4; ++s) kf[s] = kn[s];
                if (j + NWAVES < nkt) {
#pragma unroll
                    for (int s = 0; s < 4; ++s) kn[s] = *(const GAS bf16x8*)(kbase + (size_t)(32 * (j + NWAVES)) * 64 + 16 * s);
                }
                float sc[16];
                {
                    f32x16 da = {}, db = {};
#pragma unroll
                    for (int s = 0; s < 4; ++s) da = __builtin_amdgcn_mfma_f32_32x32x16_bf16(kf[s], qf[0][s], da, 0, 0, 0);
#pragma unroll
                    for (int s = 0; s < 4; ++s) db = __builtin_amdgcn_mfma_f32_32x32x16_bf16(kf[s], qf[1][s], db, 0, 0, 0);
#pragma unroll
                    for (int i = 0; i < 16; ++i) { const int di = __float_as_int(da[i]); sc[i] = __int_as_float(di > 0 ? di : 0) * wq[0]; }
                    da = (f32x16){};
#pragma unroll
                    for (int s = 0; s < 4; ++s) da = __builtin_amdgcn_mfma_f32_32x32x16_bf16(kf[s], qf[2][s], da, 0, 0, 0);
#pragma unroll
                    for (int i = 0; i < 16; ++i) { const int di = __float_as_int(db[i]); sc[i] = fmaf(__int_as_float(di > 0 ? di : 0), wq[1], sc[i]); }
                    db = (f32x16){};
#pragma unroll
                    for (int s = 0; s < 4; ++s) db = __builtin_amdgcn_mfma_f32_32x32x16_bf16(kf[s], qf[3][s], db, 0, 0, 0);
#pragma unroll
                    for (int i = 0; i < 16; ++i) { const int di = __float_as_int(da[i]); sc[i] = fmaf(__int_as_float(di > 0 ? di : 0), wq[2], sc[i]); }
#pragma unroll
                    for (int i = 0; i < 16; ++i) { const int di = __float_as_int(db[i]); sc[i] = fmaf(__int_as_float(di > 0 ? di : 0), wq[3], sc[i]); }
                }
                if (j == nkt - 1) { const int dlim = r32 - 4 * hi;
#pragma unroll
                    for (int i = 0; i < 16; ++i) if ((i & 3) + 8 * (i >> 2) > dlim) sc[i] = -INFINITY;
                }
                if (pass == 0) {
                    LAS unsigned short* mb = maxbuf + r32 * MAXLD + (j * 2 + hi) * npl;
                    if (lg == 0) {
#pragma unroll
                        for (int i = 0; i < 16; ++i) mb[i] = (unsigned short)(fkey(sc[i]) >> 16);
                    } else {
                        float m2[8];
#pragma unroll
                        for (int i = 0; i < 8; ++i) m2[i] = fmaxf(sc[2 * i], sc[2 * i + 1]);
                        if (lg == 1) {
#pragma unroll
                            for (int i = 0; i < 8; ++i) mb[i] = (unsigned short)(fkey(m2[i]) >> 16);
                        } else if (lg == 2) {
#pragma unroll
                            for (int i = 0; i < 4; ++i) mb[i] = (unsigned short)(fkey(fmaxf(m2[2 * i], m2[2 * i + 1])) >> 16);
                        } else {
                            mb[0] = (unsigned short)(fkey(fmaxf(fmaxf(m2[0], m2[1]), fmaxf(m2[2], m2[3]))) >> 16);
                            mb[1] = (unsigned short)(fkey(fmaxf(fmaxf(m2[4], m2[5]), fmaxf(m2[6], m2[7]))) >> 16);
                        }
                    }
                } else {
                    int cntl = 0;
#pragma unroll
                    for (int i = 0; i < 16; ++i) cntl += (sc[i] >= thrf) ? 1 : 0;
                    if (__ballot(cntl > 0)) {
                        unsigned slot = 0u;
                        if (cntl > 0) slot = __hip_atomic_fetch_add(ccnt + r32, (unsigned)cntl, __ATOMIC_RELAXED, __HIP_MEMORY_SCOPE_WORKGROUP);
                        LAS unsigned* ck = ckey + r32 * CKLD; LAS unsigned short* ci = cidx + r32 * CILD; const int ib = 32 * j + 4 * hi;
#pragma unroll
                        for (int i = 0; i < 16; ++i) {
                            if (sc[i] >= thrf) { const unsigned sl = slot < (unsigned)(DSA_CAP - 1) ? slot : (unsigned)(DSA_CAP - 1);
                                ck[sl] = fkey(sc[i]); ci[sl] = (unsigned short)(ib + ((i & 3) + 8 * (i >> 2))); ++slot; }
                        }
                    }
                }
            }
            __syncthreads();
            if (pp == 0) {
                const int G = nmax >> lg;
                {
                    unsigned v[4][16]; int pivot[4];
#pragma unroll
                    for (int jq = 0; jq < 4; ++jq) { const int q = wid * 4 + jq;
#pragma unroll
                        for (int i = 0; i < 16; ++i) { const int e = lane + 64 * i; v[jq][i] = e < G ? (unsigned)maxbuf[q * MAXLD + e] : 0u; } }
#pragma unroll
                    for (int jq = 0; jq < 4; ++jq) *(LAS u32x4*)(hist + jq * 256 + 4 * lane) = (u32x4){0u, 0u, 0u, 0u};
#pragma unroll
                    for (int jq = 0; jq < 4; ++jq) { unsigned mloc = v[jq][0];
#pragma unroll
                        for (int i = 1; i < 16; ++i) mloc = mloc > v[jq][i] ? mloc : v[jq][i];
                        int pv = __builtin_amdgcn_readlane((int)mloc, 0); const int p1 = __builtin_amdgcn_readlane((int)mloc, 21), p2 = __builtin_amdgcn_readlane((int)mloc, 42), p3 = __builtin_amdgcn_readlane((int)mloc, 63);
                        pv = pv > p1 ? pv : p1; pv = pv > p2 ? pv : p2; pv = pv > p3 ? pv : p3; pivot[jq] = pv; }
                    LDS_WAIT();
#pragma unroll
                    for (int jq = 0; jq < 4; ++jq)
#pragma unroll
                        for (int i = 0; i < 16; ++i) { if (lane + 64 * i < G) { int d = (pivot[jq] - (int)v[jq][i]) >> 1; d = d < 0 ? 0 : (d > 255 ? 255 : d);
                                __hip_atomic_fetch_add(hist + jq * 256 + d, 1u, __ATOMIC_RELAXED, __HIP_MEMORY_SCOPE_WORKGROUP); } }
                    LDS_WAIT();
                    u32x4 h[4]; unsigned sh[4], Pl[4];
#pragma unroll
                    for (int jq = 0; jq < 4; ++jq) { h[jq] = *(const LAS u32x4*)(hist + jq * 256 + 4 * lane); sh[jq] = (h[jq].x + h[jq].y) + (h[jq].z + h[jq].w); Pl[jq] = sh[jq]; }
#pragma unroll
                    for (int o = 1; o < 64; o <<= 1) {
#pragma unroll
                        for (int jq = 0; jq < 4; ++jq) { const unsigned t = __shfl_up(Pl[jq], o); if (lane >= o) Pl[jq] += t; } }
#pragma unroll
                    for (int jq = 0; jq < 4; ++jq) { const int q = wid * 4 + jq;
                        const unsigned long long bal = __ballot(Pl[jq] >= (unsigned)TOPK);
                        const int ls = bal ? __ffsll((long long)bal) - 1 : 63;
                        const unsigned below = Pl[jq] - sh[jq], c0 = below + h[jq].x, c1 = c0 + h[jq].y, c2 = c1 + h[jq].z;
                        const unsigned bin = c0 >= (unsigned)TOPK ? 0u : (c1 >= (unsigned)TOPK ? 1u : (c2 >= (unsigned)TOPK ? 2u : 3u));
                        const int jstar = bal ? __builtin_amdgcn_readlane((int)(bin + 4u * lane), ls) : 255;
                        unsigned tau;
                        if (jstar < 255) { const int tl = pivot[jq] - (2 * jstar + 1); tau = tl < 0 ? 0u : (unsigned)tl; }
                        else { int ko, ce; tau = radix_kth<16, 2>(v[jq], G, hist + jq * 256, TOPK, lane, ko, ce); }
                        if (lane == 0) ctau[q] = tau; }
                }
                __syncthreads();
            }
        }
        {
            unsigned kv[4][8], ix[4][8], dg[4][8]; int cq[4]; unsigned tau16[4];
#pragma unroll
            for (int jq = 0; jq < 4; ++jq) { const int q = wid * 4 + jq; int c = (int)ccnt[q]; if (c > DSA_CAP) c = DSA_CAP; cq[jq] = __builtin_amdgcn_readfirstlane(c); tau16[jq] = (unsigned)__builtin_amdgcn_readfirstlane((int)ctau[q]);
#pragma unroll
                for (int i = 0; i < 8; ++i) { const int e = lane + 64 * i; kv[jq][i] = e < c ? ckey[q * CKLD + e] : 0u; ix[jq][i] = e < c ? (unsigned)cidx[q * CILD + e] : 0xffffu; }
                *(LAS u32x4*)(hist + jq * 256 + 4 * lane) = (u32x4){0u, 0u, 0u, 0u}; }
            LDS_WAIT();
#pragma unroll
            for (int jq = 0; jq < 4; ++jq)
#pragma unroll
                for (int i = 0; i < 8; ++i) { const int d0 = (int)(kv[jq][i] >> 16) - (int)tau16[jq]; dg[jq][i] = (unsigned)(d0 < 0 ? 0 : (d0 > 255 ? 255 : d0));
                    if (lane + 64 * i < cq[jq]) __hip_atomic_fetch_add(hist + jq * 256 + dg[jq][i], 1u, __ATOMIC_RELAXED, __HIP_MEMORY_SCOPE_WORKGROUP); }
            LDS_WAIT();
            u32x4 h[4]; unsigned sh[4], Tl[4];
#pragma unroll
            for (int jq = 0; jq < 4; ++jq) { h[jq] = *(const LAS u32x4*)(hist + jq * 256 + 4 * lane); sh[jq] = (h[jq].x + h[jq].y) + (h[jq].z + h[jq].w); Tl[jq] = sh[jq]; }
#pragma unroll
            for (int o = 1; o < 64; o <<= 1) {
#pragma unroll
                for (int jq = 0; jq < 4; ++jq) { const unsigned t = __shfl_down(Tl[jq], o); if (lane + o < 64) Tl[jq] += t; } }
            unsigned jstar[4]; int kk[4], cb[4]; bool fast[4];
#pragma unroll
            for (int jq = 0; jq < 4; ++jq) {
                const unsigned long long bal = __ballot(Tl[jq] >= (unsigned)TOPK);
                const int ls = bal ? 63 - __clzll(bal) : 0;
                const unsigned above = Tl[jq] - sh[jq], c3 = above + h[jq].w, c2 = c3 + h[jq].z, c1 = c2 + h[jq].y;
                unsigned bin, kkv, cbv;
                if (c3 >= (unsigned)TOPK) { bin = 3; kkv = TOPK - above; cbv = h[jq].w; } else if (c2 >= (unsigned)TOPK) { bin = 2; kkv = TOPK - c3; cbv = h[jq].z; } else if (c1 >= (unsigned)TOPK) { bin = 1; kkv = TOPK - c2; cbv = h[jq].y; } else { bin = 0; kkv = TOPK - c1; cbv = h[jq].x; }
                jstar[jq] = (unsigned)__builtin_amdgcn_readlane((int)(bin + 4u * lane), ls);
                kk[jq] = __builtin_amdgcn_readlane((int)kkv, ls); cb[jq] = __builtin_amdgcn_readlane((int)cbv, ls);
                fast[jq] = jstar[jq] < 255u && cb[jq] <= 64;
            }
#pragma unroll
            for (int jq = 0; jq < 4; ++jq) { LAS unsigned* lk = hist + jq * 256; LAS unsigned* li = lk + 64; int base = 0;
                if (fast[jq]) {
#pragma unroll
                    for (int i = 0; i < 8; ++i) { const bool mt = (lane + 64 * i < cq[jq]) && dg[jq][i] == jstar[jq]; const unsigned long long mk = __ballot(mt);
                        if (mt) { const int slot = base + (int)__builtin_amdgcn_mbcnt_hi((unsigned)(mk >> 32), __builtin_amdgcn_mbcnt_lo((unsigned)mk, 0u)); lk[slot] = kv[jq][i]; li[slot] = ix[jq][i]; }
                        base += __popcll(mk); } } }
            LDS_WAIT();
            unsigned thr[4], ti[4];
#pragma unroll
            for (int jq = 0; jq < 4; ++jq) { thr[jq] = 0u; ti[jq] = 0xffffu;
                if (fast[jq]) { const LAS unsigned* lk = hist + jq * 256; const LAS unsigned* li = lk + 64;
                    const unsigned mkey = lane < cb[jq] ? lk[lane] : 0u, midx = lane < cb[jq] ? li[lane] : 0xffffu;
                    int rank = 0;
                    for (int t = 0; t < cb[jq]; ++t) { const unsigned xk = (unsigned)__builtin_amdgcn_readlane((int)mkey, t), xi = (unsigned)__builtin_amdgcn_readlane((int)midx, t);
                        rank += (xk > mkey || (xk == mkey && xi < midx)) ? 1 : 0; }
                    const unsigned long long b2 = __ballot(lane < cb[jq] && rank == kk[jq] - 1);
                    const int lt = b2 ? __ffsll((long long)b2) - 1 : 0;
                    thr[jq] = (unsigned)__builtin_amdgcn_readlane((int)mkey, lt); ti[jq] = (unsigned)__builtin_amdgcn_readlane((int)midx, lt);
                } else {
                    int k, ceq; thr[jq] = radix_kth<8, 4>(kv[jq], cq[jq], hist + jq * 256, TOPK, lane, k, ceq);
                    if (ceq > k) {
                        unsigned pi = 0u; int kq = k;
                        for (int bit = 15; bit >= 0; --bit) { const unsigned test = pi >> bit; int cnt = 0;
#pragma unroll
                            for (int i = 0; i < 8; ++i) cnt += __popcll(__ballot(kv[jq][i] == thr[jq] && (ix[jq][i] >> bit) == test));
                            if (cnt < kq) { kq -= cnt; pi |= (1u << bit); } }
                        ti[jq] = pi;
                    }
                } }
#pragma unroll
            for (int jq = 0; jq < 4; ++jq) { const int q = wid * 4 + jq; int base = 0;
#pragma unroll
                for (int i = 0; i < 8; ++i) { const bool sl = kv[jq][i] > thr[jq] || (kv[jq][i] == thr[jq] && ix[jq][i] <= ti[jq]); const unsigned long long mk = __ballot(sl);
                    if (sl) { const int pos = base + (int)__builtin_amdgcn_mbcnt_hi((unsigned)(mk >> 32), __builtin_amdgcn_mbcnt_lo((unsigned)mk, 0u)); if (pos < TOPK) sel[q * 256 + pos] = (unsigned short)ix[jq][i]; }
                    base += __popcll(mk); } }
            LDS_WAIT();
        }
    } else {
        for (int e = F.tid; e < 32 * 256; e += NWAVES * 64) sel[e] = (unsigned short)(e & 255);
    }
    }
    __syncthreads();
    const int c16 = lane & 15, g4 = lane >> 4;
    const GAS bf16_t* Kd = WSL(const bf16_t, WS_KD) + rowb * 64;
    const GAS bf16_t* Vd = WSL(const bf16_t, WS_VD) + rowb * 64;
    const unsigned vs_base = (unsigned)(uintptr_t)(F.lds + DL_VS) + (unsigned)wid * 12288u;
    const LAS unsigned char* vs_ptr = F.lds + DL_VS + wid * 12288;
    const int tr_off = (4 * g4 + (c16 >> 2)) * 128 + (c16 & 3) * 8;
    for (int rep_ = 0; rep_ < REP_GATHER; ++rep_)
    for (int jq = 0; jq < 4; ++jq) { const int q = wid * 4 + jq, t = t0 + q; const int nsel = t + 1 < TOPK ? t + 1 : TOPK;
        const LAS unsigned short* selq = sel + q * 256;
#define DSA_VDMA(u) do { _Pragma("unroll") for (int p_ = 0; p_ < 4; ++p_) { const int kidx_ = (int)selq[32 * (u) + 8 * p_ + (lane >> 3)]; \
            glds16((const void*)(Vd + (size_t)kidx_ * 64 + (lane & 7) * 8), (unsigned)__builtin_amdgcn_readfirstlane(vs_base + (unsigned)(((u) % 3) * 4096 + p_ * 1024))); } } while (0)
        asm volatile("s_waitcnt lgkmcnt(0)" ::: "memory");
        DSA_VDMA(0); DSA_VDMA(1); DSA_VDMA(2);
        bf16x8 qf[2];
        { const GAS bf16_t* qrow = WSL(const bf16_t, WS_QD) + (rowb + t) * 256 + (c16 & 3) * 64 + 8 * g4;
          qf[0] = *(const GAS bf16x8*)qrow; qf[1] = *(const GAS bf16x8*)(qrow + 32);
          if (c16 >= 4) { qf[0] = (bf16x8){0, 0, 0, 0, 0, 0, 0, 0}; qf[1] = qf[0]; } }
        bf16x8 kf[4][2], kn[4][2];
#define DSA_KLOAD(dst, ch_) do { _Pragma("unroll") for (int kb = 0; kb < 4; ++kb) { const int kidx = (int)selq[64 * (ch_) + 16 * kb + c16]; const GAS bf16_t* kr = Kd + (size_t)kidx * 64 + 8 * g4; dst[kb][0] = *(const GAS bf16x8*)kr; dst[kb][1] = *(const GAS bf16x8*)(kr + 32); } } while (0)
        DSA_KLOAD(kf, 0);
        float mrun = -INFINITY, l = 0.f;
        f32x4 O[4];
#pragma unroll
        for (int db = 0; db < 4; ++db) O[db] = (f32x4){0.f, 0.f, 0.f, 0.f};
#pragma unroll
        for (int ch = 0; ch < 4; ++ch) {
            if (ch + 1 < 4) DSA_KLOAD(kn, ch + 1);
            asm volatile("" ::: "memory");
            f32x4 S[4];
#pragma unroll
            for (int kb = 0; kb < 4; ++kb) { f32x4 a = {0.f, 0.f, 0.f, 0.f};
                a = __builtin_amdgcn_mfma_f32_16x16x32_bf16(kf[kb][0], qf[0], a, 0, 0, 0); a = __builtin_amdgcn_mfma_f32_16x16x32_bf16(kf[kb][1], qf[1], a, 0, 0, 0); S[kb] = a; }
            if (nsel < TOPK) { const int nlim = nsel - 4 * g4;
#pragma unroll
                for (int kb = 0; kb < 4; ++kb)
#pragma unroll
                    for (int r = 0; r < 4; ++r) if (64 * ch + 16 * kb + r >= nlim) S[kb][r] = -INFINITY;
            }
            float cm = fmaxf(fmaxf(S[0][0], S[0][1]), fmaxf(S[0][2], S[0][3]));
#pragma unroll
            for (int kb = 1; kb < 4; ++kb) cm = fmaxf(cm, fmaxf(fmaxf(S[kb][0], S[kb][1]), fmaxf(S[kb][2], S[kb][3])));
            cm = fmaxf(cm, __shfl_xor(cm, 16)); cm = fmaxf(cm, __shfl_xor(cm, 32));
            const float mn = fmaxf(mrun, cm);
            const float alpha = __builtin_amdgcn_exp2f(mrun - mn);
            mrun = mn;
            float ps = 0.f;
#pragma unroll
            for (int kb = 0; kb < 4; ++kb)
#pragma unroll
                for (int r = 0; r < 4; ++r) { S[kb][r] = __builtin_amdgcn_exp2f(S[kb][r] - mn); ps += S[kb][r]; }
            l = l * alpha + ps;
#pragma unroll
            for (int db = 0; db < 4; ++db) O[db] = O[db] * alpha;
#pragma unroll
            for (int u2 = 0; u2 < 2; ++u2) { const int u = 2 * ch + u2;
                u32x4 pw; pw.x = cvtpk(S[2 * u2][0], S[2 * u2][1]); pw.y = cvtpk(S[2 * u2][2], S[2 * u2][3]); pw.z = cvtpk(S[2 * u2 + 1][0], S[2 * u2 + 1][1]); pw.w = cvtpk(S[2 * u2 + 1][2], S[2 * u2 + 1][3]);
                const bf16x8 pb = __builtin_bit_cast(bf16x8, pw);
                if (u == 3) asm volatile("s_waitcnt vmcnt(12)" ::: "memory");
                else if (u == 5) asm volatile("s_waitcnt vmcnt(16)" ::: "memory");
                else if (u == 6) asm volatile("s_waitcnt vmcnt(12)" ::: "memory");
                else if (u == 7) asm volatile("s_waitcnt vmcnt(0)" ::: "memory");
                const LAS unsigned char* sp = vs_ptr + (u % 3) * 4096 + tr_off;
#pragma unroll
                for (int db = 0; db < 4; ++db) {
                    const v4i16_t lo = __builtin_amdgcn_ds_read_tr16_b64_v4i16((LAS v4i16_t*)(sp + db * 32));
                    const v4i16_t hv = __builtin_amdgcn_ds_read_tr16_b64_v4i16((LAS v4i16_t*)(sp + db * 32 + 2048));
                    const bf16x8 va = (bf16x8){lo[0], lo[1], lo[2], lo[3], hv[0], hv[1], hv[2], hv[3]};
                    O[db] = __builtin_amdgcn_mfma_f32_16x16x32_bf16(va, pb, O[db], 0, 0, 0);
                }
                if (u + 3 < 8) { asm volatile("s_waitcnt lgkmcnt(0)" ::: "memory"); DSA_VDMA(u + 3); }
            }
#pragma unroll
            for (int kb = 0; kb < 4; ++kb) { kf[kb][0] = kn[kb][0]; kf[kb][1] = kn[kb][1]; }
        }
        l += __shfl_xor(l, 16); l += __shfl_xor(l, 32);
#undef DSA_KLOAD
#undef DSA_VDMA
        if (c16 < 4) {
            const float rl = 1.0f / l;
            GAS bf16_t* orow = WSL(bf16_t, WS_OCAT) + (rowb + t) * DM + 512 + c16 * 64 + 4 * g4;
#pragma unroll
            for (int db = 0; db < 4; ++db) { u32x2 w; w.x = cvtpk(O[db][0] * rl, O[db][1] * rl); w.y = cvtpk(O[db][2] * rl, O[db][3] * rl); *(GAS u32x2*)(orow + 16 * db) = w; }
        }
    }
}
#undef WSL

__device__ __forceinline__ void p2_attention(Frame& F) {
    const int NIT = NB * (SEQ / 32);
#ifndef REP_DSA
#define REP_DSA 1
#endif
#ifndef REP_SWAMEM
#define REP_SWAMEM 1
#endif
    for (int rep = 0; rep < REP_DSA; ++rep)
    for (int r = 0; r < (NIT + F.G - 1) / F.G; ++r) {
        int b, tile;
        if (F.G == 256) { const int j = F.vcu & 63; b = F.vcu >> 6; tile = r == 0 ? j : (r == 1 ? 127 - j : (r == 2 ? 128 + j : 255 - j)); }
        else { const int it = r * F.G + F.vcu; if (it >= NIT) break; b = it / (SEQ / 32); tile = it % (SEQ / 32); }
        dsa_item(F, b, tile * 32);
    }
    for (int rep = 0; rep < REP_SWAMEM; ++rep) {
    for (int it = F.vcu; it < NB * (SEQ / 128); it += F.G) swa_item(F, it / (SEQ / 128), it % (SEQ / 128));
    for (int it = F.vcu; it < NB * (SEQ / 128); it += F.G) mem_item(F, it / (SEQ / 128), it % (SEQ / 128));
    }
}

#ifndef MK_N_LAUNCHES
#define MK_N_LAUNCHES 1
#endif
constexpr int N_PHASES = 8;
struct Args { const void* in[17]; float* out; unsigned char* ws; int ph_lo, ph_hi, li, pad; };

__global__ void __launch_bounds__(NWAVES * 64, 2) hybrid_fwd(Args args) {
    extern __shared__ __attribute__((aligned(16))) unsigned char lds[];
    Frame F;
    F.lds = (LAS unsigned char*)lds;
    F.MISC = (volatile LAS unsigned*)(F.lds + MISC_OFF);
    F.tid = threadIdx.x; F.lane = F.tid & 63; F.wave = __builtin_amdgcn_readfirstlane(F.tid >> 6);
    F.G = gridDim.x; { const int bx = blockIdx.x; F.vcu = (F.G % 8 == 0) ? (bx % 8) * (F.G / 8) + bx / 8 : bx; }
    F.ws = args.ws; F.ctl = (unsigned*)(args.ws + WS_CTL);
    F.x = (const float*)args.in[0]; F.mem = (const float*)args.in[1]; F.positions = (const int*)args.in[2]; F.g_mix = (const float*)args.in[3]; F.w_in = (const float*)args.in[4];
    F.b_gate = (const float*)args.in[5]; F.sinks = (const float*)args.in[6]; F.g_mem = (const float*)args.in[7]; F.w_mem_kv = (const float*)args.in[8]; F.w_proj_swa = (const float*)args.in[9];
    F.w_proj_dsa = (const float*)args.in[10]; F.w_proj_mem = (const float*)args.in[11]; F.w_out = (const float*)args.in[12]; F.g_mlp = (const float*)args.in[13]; F.w_mlp_in = (const float*)args.in[14];
    F.w_mlp_out = (const float*)args.in[15]; F.g_final = (const float*)args.in[16]; F.out = args.out;
    for (int u = F.tid; u < (LDS_BYTES - LDSCTL_OFF) / 4; u += NWAVES * 64) ((LAS unsigned*)(F.lds + LDSCTL_OFF))[u] = 0u;
    __syncthreads();
    XcdBarrier bar; bar.bar = F.ctl + CW_BAR + args.li * XCD_BAR_WORDS; bar.x = 0; bar.st = nullptr;
    if (args.ph_hi - args.ph_lo > 1) bar = xcd_barrier_post(F.ctl + CW_BAR + args.li * XCD_BAR_WORDS, F.MISC + 8);
    const int lo = args.ph_lo, hi = args.ph_hi;
#ifndef PHASE_MASK
#define PHASE_MASK 0xff
#endif
#define IN(k) (((PHASE_MASK >> (k)) & 1) && lo <= (k) && (k) < hi)
#define BOTH(k) (IN(k) && IN((k) + 1))
#define GRID_BAR() xcd_barrier(bar)
    const int bx = (int)blockIdx.x;

#ifndef REP_P0
#define REP_P0 1
#endif
    if (IN(0)) { for (int rp_ = 0; rp_ < REP_P0; ++rp_) p0_prologue(F); if (BOTH(0)) GRID_BAR(); }

#ifndef REP_GEMM
#define REP_GEMM 1
#endif
    if (IN(1)) for (int rg_ = 0; rg_ < REP_GEMM; ++rg_) {
        SchedInProj S; S.nM = T / 256; S.nN = NPOS / 256; S.nwg = S.nM * S.nN; S.G = F.G; S.c = bx;
        S.Ab = (const char*)WSP(bf16_t, WS_XB); S.Bb = (const char*)WSP(bf16_t, WS_WIN); S.Am = (const char*)WSP(bf16_t, WS_MEMB); S.Bm = (const char*)WSP(bf16_t, WS_WMEM);
        EpiInProj E; E.inv_rms = WSP(float, WS_INVRMS0); E.inv_rms_mem = WSP(float, WS_INVRMSM); E.cs = WSP(float, WS_CS); E.b_gate = F.b_gate;
        E.q_s = WSP(bf16_t, WS_QS); E.k_s = WSP(bf16_t, WS_KS); E.v_s = WSP(bf16_t, WS_VS); E.q_d = WSP(bf16_t, WS_QD); E.k_d = WSP(bf16_t, WS_KD); E.v_d = WSP(bf16_t, WS_VD);
        E.q_i = WSP(bf16_t, WS_QI); E.k_i = WSP(bf16_t, WS_KI); E.q_m = WSP(bf16_t, WS_QM); E.gates = WSP(bf16_t, WS_GATES); E.mk = WSP(bf16_t, WS_MK); E.mv = WSP(bf16_t, WS_MV); E.w_i = WSP(float, WS_WI);
        pg8::gemm_phase<EpiInProj, SchedInProj, true>(F.lds + RING_OFF, DM, DM, S, E);
        if (BOTH(1) && rg_ == REP_GEMM - 1) GRID_BAR();
    }

    if (IN(2)) { p2_attention(F); if (BOTH(2)) GRID_BAR(); }

    if (IN(3)) {
        SchedMerge S; S.G = F.G; S.c = bx; S.Ab = (const char*)WSP(bf16_t, WS_OCAT); S.Bb = (const char*)WSP(bf16_t, WS_WPROJ);
        EpiMerge E; E.gates = WSP(bf16_t, WS_GATES); E.merged = WSP(bf16_t, WS_MERGED);
        pg8::gemm_phase<EpiMerge, SchedMerge, true>(F.lds + RING_OFF, DM, DM, S, E);
        if (BOTH(3)) GRID_BAR();
    }

    if (IN(4)) {
        SchedGrid S; S.nM = T / 256; S.nN = DM / 256; S.nwg = S.nM * S.nN; S.G = F.G; S.c = bx; S.nt = DM / 64;
        S.Ab = (const char*)WSP(bf16_t, WS_MERGED); S.Bb = (const char*)WSP(bf16_t, WS_WOUT); S.tA = (size_t)256 * DM * 2; S.tB = (size_t)256 * DM * 2;
        EpiResid<true> E; E.base = F.x; E.out = F.out; E.outb = WSP(bf16_t, WS_XB); E.ssq = WSP(float, WS_SSQ1);
        pg8::gemm_phase<EpiResid<true>, SchedGrid, true>(F.lds + RING_OFF, DM, DM, S, E);
        if (BOTH(4)) GRID_BAR();
    }

    if (IN(5)) for (int rg_ = 0; rg_ < REP_GEMM; ++rg_) {
        SchedGrid S; S.nM = T / 256; S.nN = DFF / 256; S.nwg = S.nM * S.nN; S.G = F.G; S.c = bx; S.nt = DM / 64;
        S.Ab = (const char*)WSP(bf16_t, WS_XB); S.Bb = (const char*)WSP(bf16_t, WS_W1); S.tA = (size_t)256 * DM * 2; S.tB = (size_t)256 * DM * 2;
        EpiMlpIn E; E.ssq = WSP(float, WS_SSQ1); E.hid = WSP(bf16_t, WS_HID);
        pg8::gemm_phase<EpiMlpIn, SchedGrid, true>(F.lds + RING_OFF, DM, DM, S, E);
        if (BOTH(5) && rg_ == REP_GEMM - 1) GRID_BAR();
    }

    if (IN(6)) {
        SchedGrid S; S.nM = T / 256; S.nN = DM / 256; S.nwg = S.nM * S.nN; S.G = F.G; S.c = bx; S.nt = DFF / 64;
        S.Ab = (const char*)WSP(bf16_t, WS_HID); S.Bb = (const char*)WSP(bf16_t, WS_W2); S.tA = (size_t)256 * DFF * 2; S.tB = (size_t)256 * DFF * 2;
        EpiResid<false> E; E.base = F.out; E.out = F.out; E.outb = nullptr; E.ssq = WSP(float, WS_SSQ2);
        pg8::gemm_phase<EpiResid<false>, SchedGrid, true>(F.lds + RING_OFF, DFF, DFF, S, E);
        if (BOTH(6)) GRID_BAR();
    }

    if (IN(7)) p7_final_norm(F);
#undef IN
#undef BOTH
#undef GRID_BAR
}

extern "C" void kernel_launch(void* const* d_in, const int* in_sizes, int n_in, void* d_out, int out_size, void* d_ws, size_t ws_size, hipStream_t stream) {
    static int grid = 0;
    if (grid == 0) {
        if (n_in != 17 || in_sizes[0] != T * DM || out_size != T * DM || ws_size < WS_END) { fprintf(stderr, "kernel_launch: unexpected shapes (n_in %d, in0 %d, out %d, ws %zu < %zu); nothing launched\n", n_in, n_in > 0 ? in_sizes[0] : -1, out_size, ws_size, (size_t)WS_END); grid = -1; return; }
        int dev = 0, cus = 0, per_cu = 0;
        if (hipGetDevice(&dev) != hipSuccess || hipDeviceGetAttribute(&cus, hipDeviceAttributeMultiprocessorCount, dev) != hipSuccess) { grid = -1; return; }
        if (hipFuncSetAttribute((const void*)hybrid_fwd, hipFuncAttributeMaxDynamicSharedMemorySize, LDS_BYTES) != hipSuccess) { fprintf(stderr, "kernel_launch: hipFuncSetAttribute failed\n"); grid = -1; return; }
        if (hipOccupancyMaxActiveBlocksPerMultiprocessor(&per_cu, (const void*)hybrid_fwd, NWAVES * 64, LDS_BYTES) != hipSuccess || per_cu < 1) { fprintf(stderr, "kernel_launch: occupancy query reports %d workgroups per CU; nothing launched\n", per_cu); (void)hipGetLastError(); grid = -1; return; }
        (void)hipGetLastError();
        grid = cus;
    }
    if (grid < 0) return;
    if (hipMemsetAsync((char*)d_ws + WS_CTL, 0, CTL_ZERO_BYTES, stream) != hipSuccess) return;
    Args a{};
    for (int i = 0; i < 17; ++i) a.in[i] = d_in[i];
    a.out = (float*)d_out; a.ws = (unsigned char*)d_ws;
    if (MK_N_LAUNCHES == 1) { a.ph_lo = 0; a.ph_hi = N_PHASES; a.li = 0; hipLaunchKernelGGL(hybrid_fwd, dim3(grid), dim3(NWAVES * 64), LDS_BYTES, stream, a); }
    else { for (int p = 0; p < N_PHASES; ++p) { a.ph_lo = p; a.ph_hi = p + 1; a.li = 0; hipLaunchKernelGGL(hybrid_fwd, dim3(grid), dim3(NWAVES * 64), LDS_BYTES, stream, a); } }
}
```

```cpp
#include <hip/hip_runtime.h>
#include <cstdio>
#include <cstdint>

#define LAS __attribute__((address_space(3)))
#define GAS __attribute__((address_space(1)))
typedef unsigned short bf16_t;
typedef short bf16x8 __attribute__((ext_vector_type(8)));
typedef float f32x2 __attribute__((ext_vector_type(2)));
typedef float f32x4 __attribute__((ext_vector_type(4)));
typedef float f32x16 __attribute__((ext_vector_type(16)));
typedef unsigned u32x2 __attribute__((ext_vector_type(2)));
typedef unsigned u32x4 __attribute__((ext_vector_type(4)));
typedef __bf16 bf16x2_t __attribute__((ext_vector_type(2)));

constexpr int NB = 4, SEQ = 8192, T = NB * SEQ, DM = 1024, DFF = 4096, DIN = 4804, NPOS = 4864, MEMLEN = 256, MROWS = NB * MEMLEN;
constexpr float EPS = 1e-6f;
constexpr float LOG2E = 1.4426950408889634f;
constexpr float QSCALE = 0.125f * LOG2E;
constexpr float IDX_SCALE = 0.0625f;
constexpr int TOPK = 256;
constexpr int P_QS = 0, P_KS = 512, P_VS = 640, P_QD = 768, P_KD = 1024, P_VD = 1088, P_QI = 1152, P_KI = 1408, P_QM = 1472, P_GATE = 1728, P_WI = 4800, P_END = 4804;

constexpr size_t MiB = 1u << 20;
constexpr size_t WS_CTL = 0, CTL_ZERO_BYTES = 1 * MiB;
constexpr size_t WS_WIN = 1 * MiB, WS_WMEM = 11 * MiB, WS_WPROJ = 12 * MiB, WS_WOUT = 14 * MiB, WS_W1 = 16 * MiB, WS_W2 = 24 * MiB;
constexpr size_t WS_INVRMS0 = 32 * MiB, WS_INVRMSM = 32 * MiB + 128 * 1024, WS_WI = 32 * MiB + 256 * 1024;
constexpr size_t WS_SSQ1 = 33 * MiB, WS_SSQ2 = 35 * MiB, WS_CS = 37 * MiB, WS_MEMB = 45 * MiB, WS_MK = 47 * MiB, WS_MV = 47 * MiB + 512 * 1024;
constexpr size_t WS_XB = 48 * MiB;
constexpr size_t WS_OCAT = 112 * MiB;
constexpr size_t WS_QS = 176 * MiB, WS_KS = 208 * MiB, WS_VS = 216 * MiB, WS_QD = 224 * MiB, WS_KD = 240 * MiB, WS_VD = 244 * MiB, WS_QI = 248 * MiB, WS_KI = 264 * MiB, WS_QM = 268 * MiB;
constexpr size_t WS_GATES = 284 * MiB;
constexpr size_t WS_MERGED = 176 * MiB;
constexpr size_t WS_HID = 176 * MiB;
constexpr size_t WS_END = 476 * MiB;
static_assert(WS_WIN + (size_t)NPOS * DM * 2 <= WS_WMEM && WS_GATES + (size_t)T * 3072 * 2 <= WS_END && WS_HID + (size_t)T * DFF * 2 <= WS_END, "d_ws map");
constexpr int CW_TMO = 0, CW_CODE = 1, CW_BAR = 4096;

constexpr int RING_OFF = 0, RING_BYTES = 131072;
constexpr int LDS_BYTES = 163840;
constexpr int LDSCTL_OFF = LDS_BYTES - 512, MISC_OFF = LDSCTL_OFF + 320;
constexpr int NWAVES = 8;

#define LDS_WAIT() asm volatile("s_waitcnt lgkmcnt(0)" ::: "memory")
#define VM_WAIT() asm volatile("s_waitcnt vmcnt(0)" ::: "memory")
#define RLX_AGENT __ATOMIC_RELAXED, __HIP_MEMORY_SCOPE_AGENT

__device__ __forceinline__ unsigned cvtpk(float lo, float hi) { f32x2 v = {lo, hi}; bf16x2_t b = __builtin_convertvector(v, bf16x2_t); return __builtin_bit_cast(unsigned, b); }
__device__ __forceinline__ float bf_lo(unsigned w) { return __uint_as_float(w << 16); }
__device__ __forceinline__ float bf_hi(unsigned w) { return __uint_as_float(w & 0xffff0000u); }
__device__ __forceinline__ float wave_sum(float v) {
#pragma unroll
    for (int o = 1; o < 64; o <<= 1) v += __shfl_xor(v, o);
    return v;
}
__device__ __forceinline__ float wave_max(float v) {
#pragma unroll
    for (int o = 1; o < 64; o <<= 1) v = fmaxf(v, __shfl_xor(v, o));
    return v;
}

namespace pg8 {
constexpr int BM = 256, BK = 64, HALF = 128, HTB = HALF * BK * 2  , STAGE_BYTES = 8 * HTB, NXCD = 8, WGM = 8;
__host__ __device__ __forceinline__ int lds_byte(int r, int c) { const int st = (r >> 4) * 2 + (c >> 5), rr = r & 15, cc = c & 31, ob = rr * 64 + cc * 2; return st * 1024 + (ob ^ (((ob >> 9) & 1) << 5)); }
__host__ __device__ __forceinline__ void stage_rc(int b, int& R, int& C) { const int st = b / 1024, sb = b % 1024, swz = sb ^ (((sb >> 9) & 1) << 5); R = (st >> 1) * 16 + swz / 64; C = (st & 1) * 32 + (swz % 64) / 2; }
__host__ __device__ __forceinline__ int perm32(int rho) { const int n = rho >> 4, i = rho & 15; return 8 * (i >> 2) + 4 * n + (i & 3); }

struct Unit { int pm, pn, kind, nt; const char* A; const char* B; };

__device__ __forceinline__ void map_tile(int L, int nM, int nN, int& pm, int& pn) {
    const int nwg = nM * nN;
    int wgid = L; { const int q = nwg / NXCD, r = nwg % NXCD, xcd = wgid % NXCD, off = wgid / NXCD; wgid = (xcd < r ? xcd * (q + 1) : r * (q + 1) + (xcd - r) * q) + off; }
    const int nig = WGM * nN, gid = wgid / nig, fm = gid * WGM, gsz = (nM - fm) < WGM ? (nM - fm) : WGM;
    pm = fm + ((wgid % nig) % gsz); pn = (wgid % nig) / gsz;
}

template <class Epi, class Sched, bool ALIGN_EPI>
__device__ __forceinline__ void gemm_phase(LAS unsigned char* lds, const int lda, const int ldb, const Sched& S, const Epi& E) {
    const int tid = threadIdx.x, wid = __builtin_amdgcn_readfirstlane(tid >> 6), lane = tid & 63, wr = wid >> 2, wc = wid & 3, fr = lane & 15, fq = lane >> 4;
    unsigned voffA[2], voffB[2];
#pragma unroll
    for (int i = 0; i < 2; ++i) { int R, C; stage_rc(tid * 16 + i * 8192, R, C); const int Rb = Epi::PERM ? ((R & ~31) + perm32(R & 31)) : R;
        voffA[i] = (unsigned)(R * lda + C) * 2u; voffB[i] = (unsigned)(Rb * ldb + C) * 2u; }
    const size_t kstep = (size_t)(BK * 2);
    const size_t hstepA = (size_t)HALF * lda * 2, hstepB = (size_t)HALF * ldb * 2;
    const unsigned ldsw = (unsigned)wid * 1024u;
    const int aoff = lds_byte(wr * 64 + fr, fq * 8), boff = lds_byte(wc * 32 + fr, fq * 8);
#define PG8_SA(b, h) (((b) * 2 + (h)) * HTB)
#define PG8_SB(b, h) ((4 + (b) * 2 + (h)) * HTB)
#define PG8_STAGE(bufoff, gbase, voff) do { _Pragma("unroll") for (int _i = 0; _i < 2; ++_i) \
        __builtin_amdgcn_global_load_lds((const unsigned*)((const char*)(gbase) + (voff)[_i]), (LAS unsigned*)(lds + (bufoff) + ldsw + _i * 8192), 16, 0, 0); } while (0)
#define PG8_LDA(dst, b, h) do { _Pragma("unroll") for (int m = 0; m < 4; ++m) _Pragma("unroll") for (int k = 0; k < 2; ++k) dst[m][k] = *(const LAS bf16x8*)(lds + PG8_SA(b, h) + aoff + m * 2048 + k * 1024); } while (0)
#define PG8_LDB(dst, b, h) do { _Pragma("unroll") for (int n = 0; n < 2; ++n) _Pragma("unroll") for (int k = 0; k < 2; ++k) dst[n][k] = *(const LAS bf16x8*)(lds + PG8_SB(b, h) + boff + n * 2048 + k * 1024); } while (0)
#define PG8_MMA(ai, bj, At, Bt) do { __builtin_amdgcn_s_setprio(1); _Pragma("unroll") for (int m = 0; m < 4; ++m) _Pragma("unroll") for (int n = 0; n < 2; ++n) _Pragma("unroll") for (int k = 0; k < 2; ++k) \
        acc[ai][bj][m][n] = __builtin_amdgcn_mfma_f32_16x16x32_bf16(Bt[n][k], At[m][k], acc[ai][bj][m][n], 0, 0, 0); __builtin_amdgcn_s_setprio(0); } while (0)
#define PG8_WAIT_V(n) asm volatile("s_waitcnt vmcnt(" #n ")" ::: "memory")
#define PG8_WAIT_L(n) asm volatile("s_waitcnt lgkmcnt(" #n ")" ::: "memory")
#define PG8_BAR __builtin_amdgcn_s_barrier()
#define PG8_SCHED __builtin_amdgcn_sched_barrier(0)
    Unit cur, nxt; int ui = 0;
    if (!S.next(0, cur)) return;
    f32x4 acc[2][2][4][2];
#pragma unroll
    for (int a = 0; a < 2; ++a)
#pragma unroll
        for (int b = 0; b < 2; ++b)
#pragma unroll
            for (int m = 0; m < 4; ++m)
#pragma unroll
                for (int n = 0; n < 2; ++n) acc[a][b][m][n] = (f32x4){0.f, 0.f, 0.f, 0.f};
    bf16x8 At[4][2], B0[2][2], B1[2][2];
    const char* cA = cur.A; const char* cB = cur.B;
    PG8_STAGE(PG8_SB(0, 0), cB, voffB); PG8_STAGE(PG8_SB(0, 1), cB + hstepB, voffB); PG8_STAGE(PG8_SA(0, 0), cA, voffA); PG8_STAGE(PG8_SA(0, 1), cA + hstepA, voffA);
    if (wr == 1) PG8_BAR;
    PG8_WAIT_V(2); PG8_BAR;
    PG8_STAGE(PG8_SB(1, 0), cB + kstep, voffB); PG8_STAGE(PG8_SA(1, 0), cA + kstep, voffA); PG8_STAGE(PG8_SB(1, 1), cB + hstepB + kstep, voffB);
    PG8_WAIT_V(6); PG8_BAR;
    for (;;) {
        const bool has_next = S.next(ui + 1, nxt);
        const char* nA = has_next ? nxt.A : cA; const char* nB = has_next ? nxt.B : cB;
        const int nt = cur.nt;
        for (int t = 0; t < nt; t += 2) {
            const bool last = (t == nt - 2);
            const char* a1 = cA + (size_t)(t + 1) * kstep;
            const char* a2 = last ? nA : cA + (size_t)(t + 2) * kstep; const char* b2 = last ? nB : cB + (size_t)(t + 2) * kstep;
            const char* a3 = a2 + kstep; const char* b3 = b2 + kstep;
            PG8_LDB(B0, 0, 0); PG8_LDB(B1, 0, 1); PG8_SCHED; PG8_LDA(At, 0, 0); PG8_STAGE(PG8_SA(1, 1), a1 + hstepA, voffA);
            PG8_WAIT_V(8); PG8_WAIT_L(0); PG8_BAR; PG8_MMA(0, 0, At, B0); PG8_MMA(0, 1, At, B1); PG8_BAR; PG8_SCHED;
            PG8_LDA(At, 0, 1); PG8_STAGE(PG8_SB(0, 0), b2, voffB); PG8_STAGE(PG8_SB(0, 1), b2 + hstepB, voffB); PG8_STAGE(PG8_SA(0, 0), a2, voffA);
            PG8_WAIT_V(8); PG8_WAIT_L(0); PG8_BAR; PG8_MMA(1, 0, At, B0); PG8_MMA(1, 1, At, B1); PG8_BAR; PG8_SCHED;
            PG8_LDB(B0, 1, 0); PG8_LDB(B1, 1, 1); PG8_SCHED; PG8_LDA(At, 1, 0); PG8_STAGE(PG8_SA(0, 1), a2 + hstepA, voffA);
            PG8_WAIT_V(8); PG8_WAIT_L(0); PG8_BAR; PG8_MMA(0, 0, At, B0); PG8_MMA(0, 1, At, B1); PG8_BAR; PG8_SCHED;
            PG8_LDA(At, 1, 1); PG8_STAGE(PG8_SB(1, 0), b3, voffB); PG8_STAGE(PG8_SB(1, 1), b3 + hstepB, voffB); PG8_STAGE(PG8_SA(1, 0), a3, voffA);
            PG8_WAIT_V(8); PG8_WAIT_L(0); PG8_BAR; PG8_MMA(1, 0, At, B0); PG8_MMA(1, 1, At, B1); PG8_BAR; PG8_SCHED;
        }
        if constexpr (ALIGN_EPI) { if (wr == 0) PG8_BAR; }
        E(acc, cur, wr, wc, fr, fq);
        if (!has_next) break;
#pragma unroll
        for (int a = 0; a < 2; ++a)
#pragma unroll
            for (int b = 0; b < 2; ++b)
#pragma unroll
                for (int m = 0; m < 4; ++m)
#pragma unroll
                    for (int n = 0; n < 2; ++n) acc[a][b][m][n] = (f32x4){0.f, 0.f, 0.f, 0.f};
        cur = nxt; cA = nA; cB = nB; ++ui;
        if constexpr (ALIGN_EPI) { if (wr == 1) PG8_BAR; }
    }
    PG8_WAIT_V(0);
    if constexpr (!ALIGN_EPI) { if (wr == 0) PG8_BAR; }
    PG8_BAR;
#undef PG8_SA
#undef PG8_SB
#undef PG8_STAGE
#undef PG8_LDA
#undef PG8_LDB
#undef PG8_MMA
#undef PG8_WAIT_V
#undef PG8_WAIT_L
#undef PG8_BAR
#undef PG8_SCHED
}
}

struct SchedGrid {
    int nM, nN, nwg, G, c, nt; const char* Ab; const char* Bb; size_t tA, tB;
    __device__ __forceinline__ bool next(int i, pg8::Unit& u) const {
        const long L = (long)i * G + c; if (L >= nwg) return false;
        pg8::map_tile((int)L, nM, nN, u.pm, u.pn); u.kind = 0; u.nt = nt; u.A = Ab + (size_t)u.pm * tA; u.B = Bb + (size_t)u.pn * tB; return true;
    }
};
struct SchedInProj {
    int nM, nN, nwg, G, c; const char* Ab; const char* Bb; const char* Am; const char* Bm;
    __device__ __forceinline__ bool next(int i, pg8::Unit& u) const {
        const long L = (long)i * G + c; if (L >= nwg + 8) return false;
        u.nt = DM / 64;
        if (L < nwg) { pg8::map_tile((int)L, nM, nN, u.pm, u.pn); u.kind = 0; u.A = Ab + (size_t)u.pm * (256 * DM * 2); u.B = Bb + (size_t)u.pn * (256 * DM * 2); }
        else { const int e = (int)(L - nwg); u.pm = e >> 1; u.pn = e & 1; u.kind = 1; u.A = Am + (size_t)u.pm * (256 * DM * 2); u.B = Bm + (size_t)u.pn * (256 * DM * 2); }
        return true;
    }
};
struct SchedMerge {
    int G, c; const char* Ab; const char* Bb;
    __device__ __forceinline__ bool next(int i, pg8::Unit& u) const {
        const int round = i / 3, br = i - 3 * round; const long L = (long)round * G + c; if (L >= 512) return false;
        pg8::map_tile((int)L, 128, 4, u.pm, u.pn); u.kind = br; u.nt = br == 0 ? 8 : 4;
        const int koff = br == 0 ? 0 : (br == 1 ? 512 : 768);
        u.A = Ab + (size_t)u.pm * (256 * DM * 2) + koff * 2; u.B = Bb + (size_t)u.pn * (256 * DM * 2) + koff * 2; return true;
    }
};

__device__ __forceinline__ float sigmoidf_fast(float x) { return __builtin_amdgcn_rcpf(1.0f + __builtin_amdgcn_exp2f(-x * LOG2E)); }

struct EpiInProj {
    static constexpr bool PERM = true;
    const float* inv_rms; const float* inv_rms_mem; const float* cs; const float* b_gate;
    bf16_t *q_s, *k_s, *v_s, *q_d, *k_d, *v_d, *q_i, *k_i, *q_m, *gates, *mk, *mv; float* w_i;
    __device__ __forceinline__ void operator()(const f32x4 (&acc)[2][2][4][2], const pg8::Unit& u, int wr, int wc, int fr, int fq) const {
        if (u.kind == 1) {
            bf16_t* dst = u.pn == 0 ? mk : mv;
#pragma unroll
            for (int ai = 0; ai < 2; ++ai)
#pragma unroll
                for (int m = 0; m < 4; ++m) { const int row = u.pm * 256 + ai * 128 + wr * 64 + m * 16 + fr; const float s = inv_rms_mem[row];
#pragma unroll
                    for (int bj = 0; bj < 2; ++bj) { const f32x4 v0 = acc[ai][bj][m][0] * s, v1 = acc[ai][bj][m][1] * s;
                        u32x4 w; w.x = cvtpk(v0[0], v0[1]); w.y = cvtpk(v0[2], v0[3]); w.z = cvtpk(v1[0], v1[1]); w.w = cvtpk(v1[2], v1[3]);
                        *(u32x4*)(dst + (size_t)row * 256 + bj * 128 + wc * 32 + 8 * fq) = w; } }
            return;
        }
#pragma unroll
        for (int bj = 0; bj < 2; ++bj) {
            const int pos0 = u.pn * 256 + bj * 128 + wc * 32;
            const int p = pos0 + 8 * fq;
            int kind; bf16_t* dst; int ld, sec0; float scl = 1.f;
            if (pos0 < P_KS)        { kind = 0; dst = q_s; ld = 512; sec0 = P_QS; scl = QSCALE; }
            else if (pos0 < P_VS)   { kind = 0; dst = k_s; ld = 128; sec0 = P_KS; }
            else if (pos0 < P_QD)   { kind = 1; dst = v_s; ld = 128; sec0 = P_VS; }
            else if (pos0 < P_KD)   { kind = 0; dst = q_d; ld = 256; sec0 = P_QD; scl = QSCALE; }
            else if (pos0 < P_VD)   { kind = 0; dst = k_d; ld = 64;  sec0 = P_KD; }
            else if (pos0 < P_QI)   { kind = 1; dst = v_d; ld = 64;  sec0 = P_VD; }
            else if (pos0 < P_KI)   { kind = 0; dst = q_i; ld = 256; sec0 = P_QI; }
            else if (pos0 < P_QM)   { kind = 0; dst = k_i; ld = 64;  sec0 = P_KI; }
            else if (pos0 < P_GATE) { kind = 1; dst = q_m; ld = 256; sec0 = P_QM; scl = QSCALE; }
            else if (pos0 < P_WI)   { kind = 2; dst = gates; ld = 3072; sec0 = P_GATE; }
            else                    { kind = 3; dst = nullptr; ld = 0; sec0 = P_WI; }
            const int lp = p - sec0;
            if (kind == 0) {
                const int head = lp >> 6, i0 = (lp & 63) >> 1;
#pragma unroll
                for (int ai = 0; ai < 2; ++ai)
#pragma unroll
                    for (int m = 0; m < 4; ++m) { const int row = u.pm * 256 + ai * 128 + wr * 64 + m * 16 + fr; const float s = inv_rms[row] * scl;
                        const f32x4 v0 = acc[ai][bj][m][0] * s, v1 = acc[ai][bj][m][1] * s;
                        const f32x4 ca = *(const f32x4*)(cs + (size_t)row * 64 + 2 * i0), cb = *(const f32x4*)(cs + (size_t)row * 64 + 2 * i0 + 4);
                        const float a0 = v0[0] * ca[0] - v0[1] * ca[1], b0 = v0[1] * ca[0] + v0[0] * ca[1];
                        const float a1 = v0[2] * ca[2] - v0[3] * ca[3], b1 = v0[3] * ca[2] + v0[2] * ca[3];
                        const float a2 = v1[0] * cb[0] - v1[1] * cb[1], b2 = v1[1] * cb[0] + v1[0] * cb[1];
                        const float a3 = v1[2] * cb[2] - v1[3] * cb[3], b3 = v1[3] * cb[2] + v1[2] * cb[3];
                        bf16_t* o = dst + (size_t)row * ld + head * 64 + i0;
                        u32x2 wa, wb; wa.x = cvtpk(a0, a1); wa.y = cvtpk(a2, a3); wb.x = cvtpk(b0, b1); wb.y = cvtpk(b2, b3);
                        *(u32x2*)o = wa; *(u32x2*)(o + 32) = wb; }
            } else if (kind == 1) {
#pragma unroll
                for (int ai = 0; ai < 2; ++ai)
#pragma unroll
                    for (int m = 0; m < 4; ++m) { const int row = u.pm * 256 + ai * 128 + wr * 64 + m * 16 + fr; const float s = inv_rms[row] * scl;
                        const f32x4 v0 = acc[ai][bj][m][0] * s, v1 = acc[ai][bj][m][1] * s;
                        u32x4 w; w.x = cvtpk(v0[0], v0[1]); w.y = cvtpk(v0[2], v0[3]); w.z = cvtpk(v1[0], v1[1]); w.w = cvtpk(v1[2], v1[3]);
                        *(u32x4*)(dst + (size_t)row * ld + lp) = w; }
            } else if (kind == 2) {
                const f32x4 g0 = *(const f32x4*)(b_gate + lp), g1 = *(const f32x4*)(b_gate + lp + 4);
#pragma unroll
                for (int ai = 0; ai < 2; ++ai)
#pragma unroll
                    for (int m = 0; m < 4; ++m) { const int row = u.pm * 256 + ai * 128 + wr * 64 + m * 16 + fr; const float s = inv_rms[row];
                        const f32x4 v0 = acc[ai][bj][m][0] * s + g0, v1 = acc[ai][bj][m][1] * s + g1;
                        u32x4 w; w.x = cvtpk(sigmoidf_fast(v0[0]), sigmoidf_fast(v0[1])); w.y = cvtpk(sigmoidf_fast(v0[2]), sigmoidf_fast(v0[3]));
                        w.z = cvtpk(sigmoidf_fast(v1[0]), sigmoidf_fast(v1[1])); w.w = cvtpk(sigmoidf_fast(v1[2]), sigmoidf_fast(v1[3]));
                        *(u32x4*)(dst + (size_t)row * ld + lp) = w; }
            } else {
                if (pos0 == P_WI && fq == 0) {
#pragma unroll
                    for (int ai = 0; ai < 2; ++ai)
#pragma unroll
                        for (int m = 0; m < 4; ++m) { const int row = u.pm * 256 + ai * 128 + wr * 64 + m * 16 + fr; const float s = inv_rms[row] * IDX_SCALE;
                            *(f32x4*)(w_i + (size_t)row * 4) = acc[ai][bj][m][0] * s; }
                }
            }
        }
    }
};

struct EpiMerge {
    static constexpr bool PERM = true;
    const bf16_t* gates; bf16_t* merged;
    __device__ __forceinline__ void operator()(const f32x4 (&acc)[2][2][4][2], const pg8::Unit& u, int wr, int wc, int fr, int fq) const {
        const int br = u.kind;
#pragma unroll
        for (int ai = 0; ai < 2; ++ai)
#pragma unroll
            for (int m = 0; m < 4; ++m) { const int row = u.pm * 256 + ai * 128 + wr * 64 + m * 16 + fr;
#pragma unroll
                for (int bj = 0; bj < 2; ++bj) { const int col = u.pn * 256 + bj * 128 + wc * 32 + 8 * fq;
                    const u32x4 g = *(const u32x4*)(gates + (size_t)row * 3072 + br * 1024 + col);
                    f32x4 v0 = acc[ai][bj][m][0], v1 = acc[ai][bj][m][1];
                    v0[0] *= bf_lo(g.x); v0[1] *= bf_hi(g.x); v0[2] *= bf_lo(g.y); v0[3] *= bf_hi(g.y); v1[0] *= bf_lo(g.z); v1[1] *= bf_hi(g.z); v1[2] *= bf_lo(g.w); v1[3] *= bf_hi(g.w);
                    bf16_t* o = merged + (size_t)row * 1024 + col;
                    if (br > 0) { const u32x4 pv = *(const u32x4*)o;
                        v0[0] += bf_lo(pv.x); v0[1] += bf_hi(pv.x); v0[2] += bf_lo(pv.y); v0[3] += bf_hi(pv.y); v1[0] += bf_lo(pv.z); v1[1] += bf_hi(pv.z); v1[2] += bf_lo(pv.w); v1[3] += bf_hi(pv.w); }
                    u32x4 w; w.x = cvtpk(v0[0], v0[1]); w.y = cvtpk(v0[2], v0[3]); w.z = cvtpk(v1[0], v1[1]); w.w = cvtpk(v1[2], v1[3]);
                    *(u32x4*)o = w; } }
    }
};

template <bool WRITE_BF> struct EpiResid {
    static constexpr bool PERM = false;
    const float* base; float* out; bf16_t* outb; float* ssq;
    __device__ __forceinline__ void operator()(const f32x4 (&acc)[2][2][4][2], const pg8::Unit& u, int wr, int wc, int fr, int fq) const {
#pragma unroll
        for (int ai = 0; ai < 2; ++ai)
#pragma unroll
            for (int m = 0; m < 4; ++m) { const int row = u.pm * 256 + ai * 128 + wr * 64 + m * 16 + fr; float q = 0.f;
#pragma unroll
                for (int bj = 0; bj < 2; ++bj)
#pragma unroll
                    for (int n = 0; n < 2; ++n) { const size_t off = (size_t)row * DM + u.pn * 256 + bj * 128 + wc * 32 + n * 16 + 4 * fq;
                        const f32x4 o = *(const f32x4*)(base + off) + acc[ai][bj][m][n];
                        *(f32x4*)(out + off) = o; q += (o[0] * o[0] + o[1] * o[1]) + (o[2] * o[2] + o[3] * o[3]);
                        if (WRITE_BF) { u32x2 w; w.x = cvtpk(o[0], o[1]); w.y = cvtpk(o[2], o[3]); *(u32x2*)(outb + off) = w; } }
                q += __shfl_xor(q, 16); q += __shfl_xor(q, 32);
                if (fq == 0) ssq[(size_t)row * 16 + u.pn * 4 + wc] = q; }
    }
};

struct EpiMlpIn {
    static constexpr bool PERM = true;
    const float* ssq; bf16_t* hid;
    __device__ __forceinline__ void operator()(const f32x4 (&acc)[2][2][4][2], const pg8::Unit& u, int wr, int wc, int fr, int fq) const {
#pragma unroll
        for (int ai = 0; ai < 2; ++ai)
#pragma unroll
            for (int m = 0; m < 4; ++m) { const int row = u.pm * 256 + ai * 128 + wr * 64 + m * 16 + fr;
                const f32x4* sp = (const f32x4*)(ssq + (size_t)row * 16); const f32x4 s0 = sp[0], s1 = sp[1], s2 = sp[2], s3 = sp[3];
                const float tot = ((s0[0] + s0[1]) + (s0[2] + s0[3])) + ((s1[0] + s1[1]) + (s1[2] + s1[3])) + ((s2[0] + s2[1]) + (s2[2] + s2[3])) + ((s3[0] + s3[1]) + (s3[2] + s3[3]));
                const float s = 1.0f / sqrtf(tot * (1.0f / DM) + EPS);
#pragma unroll
                for (int bj = 0; bj < 2; ++bj) { f32x4 v0 = acc[ai][bj][m][0] * s, v1 = acc[ai][bj][m][1] * s;
#pragma unroll
                    for (int e = 0; e < 4; ++e) { const float a = fmaxf(v0[e], 0.f), b = fmaxf(v1[e], 0.f); v0[e] = a * a; v1[e] = b * b; }
                    u32x4 w; w.x = cvtpk(v0[0], v0[1]); w.y = cvtpk(v0[2], v0[3]); w.z = cvtpk(v1[0], v1[1]); w.w = cvtpk(v1[2], v1[3]);
                    *(u32x4*)(hid + (size_t)row * DFF + u.pn * 256 + bj * 128 + wc * 32 + 8 * fq) = w; } }
    }
};

#define XB_TMO      128
#define XB_XCNT(j)  (256  + 64 * (j))
#define XB_XSUB(j)  (1280 + 64 * (j))
#define XB_XGEN(j)  (2304 + 64 * (j))
#define XB_TOP      3328
#define XB_TOPGEN   3392
#define XCD_BAR_WORDS 3456
#define XB_SPIN_CAP (1u << 20)
__device__ __forceinline__ unsigned xb_ld(unsigned* p)              { return __hip_atomic_load(p, __ATOMIC_RELAXED, __HIP_MEMORY_SCOPE_AGENT); }
__device__ __forceinline__ unsigned xb_add(unsigned* p, unsigned v) { return __hip_atomic_fetch_add(p, v, __ATOMIC_RELAXED, __HIP_MEMORY_SCOPE_AGENT); }
__device__ __forceinline__ unsigned xb_xcc_id() { return (unsigned)__builtin_amdgcn_s_getreg((3 << 11) | 20) & 0xFu; }
#define XB_SPIN(cond, bar) do { unsigned _sp = 0; while (cond) { __builtin_amdgcn_s_sleep(1); \
    if ((++_sp & 255u) == 0u) { if (xb_ld(&(bar)[XB_TMO])) break; if (_sp > XB_SPIN_CAP) { atomicAdd(&(bar)[XB_TMO], 1u); break; } } } } while (0)
struct XcdBarrier { unsigned* bar; unsigned x; volatile LAS unsigned* st; };
__device__ __forceinline__ XcdBarrier xcd_barrier_post(unsigned* bar, volatile LAS unsigned* st) {
    XcdBarrier b; b.bar = bar; b.x = xb_xcc_id(); b.st = st;
    if (threadIdx.x == 0) (void)xb_add(&bar[XB_XCNT(b.x)], 1u);
    return b;
}
__device__ __forceinline__ void xcd_barrier_complete(unsigned* bar, unsigned x, unsigned& nloc, unsigned& nx) {
    const unsigned G = gridDim.x * gridDim.y * gridDim.z;
    unsigned sum, cnt, mine, sp = 0u;
    for (;;) {
        sum = 0u; cnt = 0u; mine = 0u;
#pragma unroll
        for (unsigned j = 0; j < 16; ++j) { const unsigned c = xb_ld(&bar[XB_XCNT(j)]); sum += c; cnt += (c > 0u) ? 1u : 0u; mine = (j == x) ? c : mine; }
        if (sum == G) break;
        __builtin_amdgcn_s_sleep(1);
        if ((++sp & 255u) == 0u) { if (xb_ld(&bar[XB_TMO])) break; if (sp > XB_SPIN_CAP) { atomicAdd(&bar[XB_TMO], 1u); break; } }
    }
    nloc = mine > 0u ? mine : 1u; nx = cnt > 0u ? cnt : 1u;
}
__device__ __forceinline__ void xcd_barrier(const XcdBarrier& b) {
    asm volatile("s_waitcnt vmcnt(0)" ::: "memory");
    __syncthreads();
    if (threadIdx.x == 0) {
        unsigned* bar = b.bar;
        __builtin_amdgcn_s_waitcnt(0);
        unsigned nloc = b.st[0], nx = b.st[1];
        if (nloc == 0u) { xcd_barrier_complete(bar, b.x, nloc, nx); b.st[0] = nloc; b.st[1] = nx; }
        const unsigned old = xb_add(&bar[XB_XSUB(b.x)], 1u);
        const unsigned gen = old / nloc;
        if (old + 1u == (gen + 1u) * nloc) {
            __builtin_amdgcn_fence(__ATOMIC_RELEASE, "agent");
            asm volatile("s_waitcnt vmcnt(0)" ::: "memory");
            const unsigned og = xb_add(&bar[XB_TOP], 1u);
            const unsigned tg = og / nx;
            if (og + 1u == (tg + 1u) * nx) xb_add(&bar[XB_TOPGEN], 1u);
            else XB_SPIN(xb_ld(&bar[XB_TOPGEN]) == tg, bar);
            __builtin_amdgcn_fence(__ATOMIC_ACQUIRE, "agent");
            xb_add(&bar[XB_XGEN(b.x)], 1u);
            asm volatile("s_waitcnt vmcnt(0)" ::: "memory");
        } else {
            XB_SPIN(xb_ld(&bar[XB_XGEN(b.x)]) == gen, bar);
            __builtin_amdgcn_fence(__ATOMIC_ACQUIRE, "agent");
            asm volatile("s_waitcnt vmcnt(0)" ::: "memory");
        }
    }
    __syncthreads();
}

struct Frame {
    LAS unsigned char* lds;
    volatile LAS unsigned* MISC;
    unsigned* ctl;
    int tid, lane, wave, vcu, G;
    unsigned char* ws;
    const float *x, *mem; const int* positions; const float *g_mix, *w_in, *b_gate, *sinks, *g_mem, *w_mem_kv, *w_proj_swa, *w_proj_dsa, *w_proj_mem, *w_out, *g_mlp, *w_mlp_in, *w_mlp_out, *g_final;
    float* out;
};
#define WSP(T_, off) ((T_*)(F.ws + (off)))

__device__ __forceinline__ int rope_src(int base, int lp) { return base + (lp & ~63) + ((lp & 1) ? 32 + ((lp & 63) >> 1) : ((lp & 63) >> 1)); }
__device__ __forceinline__ int win_src(int pos) {
    if (pos < P_KS) return rope_src(0, pos);
    if (pos < P_VS) return rope_src(512, pos - P_KS);
    if (pos < P_QD) return pos;
    if (pos < P_KD) return rope_src(768, pos - P_QD);
    if (pos < P_VD) return rope_src(1024, pos - P_KD);
    if (pos < P_QI) return pos;
    if (pos < P_KI) return rope_src(1152, pos - P_QI);
    if (pos < P_QM) return rope_src(1408, pos - P_KI);
    if (pos < P_GATE) return 1476 + (pos - P_QM);
    if (pos < P_WI) return 1732 + (pos - P_GATE);
    if (pos < P_END) return 1472 + (pos - P_WI);
    return -1;
}
template <bool MAP> __device__ __forceinline__ void p0_transpose_item(const float* W, int ldw, int k0, int n0, const float* gk, bf16_t* WT, int ldwt, LAS float* scr, int lane) {
    const int j = lane & 31; const int sc = MAP ? win_src(n0 + j) : n0 + j;
#pragma unroll 8
    for (int i = 0; i < 32; ++i) { const int kk = 2 * i + (lane >> 5); float v = sc >= 0 ? W[(size_t)(k0 + kk) * ldw + sc] : 0.f; if (gk) v *= gk[k0 + kk]; scr[kk * 33 + j] = v; }
    LDS_WAIT(); asm volatile("" ::: "memory");
    const int c = lane & 7;
#pragma unroll
    for (int jj = 0; jj < 4; ++jj) { const int n = (lane >> 3) + 8 * jj; const LAS float* s = scr + (8 * c) * 33 + n;
        u32x4 o; o.x = cvtpk(s[0 * 33], s[1 * 33]); o.y = cvtpk(s[2 * 33], s[3 * 33]); o.z = cvtpk(s[4 * 33], s[5 * 33]); o.w = cvtpk(s[6 * 33], s[7 * 33]);
        *(u32x4*)(WT + (size_t)(n0 + n) * ldwt + k0 + 8 * c) = o; }
    LDS_WAIT(); asm volatile("" ::: "memory");
}
__device__ __forceinline__ void row_to_bf16(const float* xrow, bf16_t* orow, float* inv, int lane) {
    const f32x4* xr = (const f32x4*)xrow + lane;
    f32x4 v[4]; float s = 0.f;
#pragma unroll
    for (int j = 0; j < 4; ++j) { v[j] = xr[64 * j]; s += (v[j][0] * v[j][0] + v[j][1] * v[j][1]) + (v[j][2] * v[j][2] + v[j][3] * v[j][3]); }
    s = wave_sum(s);
    if (lane == 0) *inv = 1.0f / sqrtf(s * (1.0f / DM) + EPS);
    u32x2* o8 = (u32x2*)orow + lane;
#pragma unroll
    for (int j = 0; j < 4; ++j) { u32x2 w; w.x = cvtpk(v[j][0], v[j][1]); w.y = cvtpk(v[j][2], v[j][3]); o8[64 * j] = w; }
}
__device__ __forceinline__ void p0_prologue(Frame& F) {
    LAS float* scr = (LAS float*)(F.lds + RING_OFF + F.wave * 16384);
    const int gw = F.vcu * NWAVES + F.wave, NGW = F.G * NWAVES;
    constexpr int I_IN = 16 * (NPOS / 32), I_MEM = 16 * 16, I_PS = 8 * 32, I_PD = 4 * 32, I_PM = 4 * 32, I_OUT = 16 * 32, I_1 = 16 * 128, I_2 = 64 * 32;
    constexpr int NITEMS = I_IN + I_MEM + I_PS + I_PD + I_PM + I_OUT + I_1 + I_2;
    for (int it = gw; it < NITEMS; it += NGW) {
        int r = it;
        if (r < I_IN) { const int nb = NPOS / 32; p0_transpose_item<true>(F.w_in, DIN, 64 * (r / nb), 32 * (r % nb), F.g_mix, WSP(bf16_t, WS_WIN), DM, scr, F.lane); continue; } r -= I_IN;
        if (r < I_MEM) { p0_transpose_item<false>(F.w_mem_kv, 512, 64 * (r / 16), 32 * (r % 16), F.g_mem, WSP(bf16_t, WS_WMEM), DM, scr, F.lane); continue; } r -= I_MEM;
        if (r < I_PS) { p0_transpose_item<false>(F.w_proj_swa, DM, 64 * (r / 32), 32 * (r % 32), nullptr, WSP(bf16_t, WS_WPROJ), DM, scr, F.lane); continue; } r -= I_PS;
        if (r < I_PD) { p0_transpose_item<false>(F.w_proj_dsa, DM, 64 * (r / 32), 32 * (r % 32), nullptr, WSP(bf16_t, WS_WPROJ) + 512, DM, scr, F.lane); continue; } r -= I_PD;
        if (r < I_PM) { p0_transpose_item<false>(F.w_proj_mem, DM, 64 * (r / 32), 32 * (r % 32), nullptr, WSP(bf16_t, WS_WPROJ) + 768, DM, scr, F.lane); continue; } r -= I_PM;
        if (r < I_OUT) { p0_transpose_item<false>(F.w_out, DM, 64 * (r / 32), 32 * (r % 32), nullptr, WSP(bf16_t, WS_WOUT), DM, scr, F.lane); continue; } r -= I_OUT;
        if (r < I_1) { p0_transpose_item<false>(F.w_mlp_in, DFF, 64 * (r / 128), 32 * (r % 128), F.g_mlp, WSP(bf16_t, WS_W1), DM, scr, F.lane); continue; } r -= I_1;
        p0_transpose_item<false>(F.w_mlp_out, DM, 64 * (r / 32), 32 * (r % 32), nullptr, WSP(bf16_t, WS_W2), DFF, scr, F.lane);
    }
    for (int m = gw; m < T; m += NGW) row_to_bf16(F.x + (size_t)m * DM, WSP(bf16_t, WS_XB) + (size_t)m * DM, WSP(float, WS_INVRMS0) + m, F.lane);
    for (int m = gw; m < MROWS; m += NGW) row_to_bf16(F.mem + (size_t)m * DM, WSP(bf16_t, WS_MEMB) + (size_t)m * DM, WSP(float, WS_INVRMSM) + m, F.lane);
    { const int gt = gw * 64 + F.lane, NGT = NGW * 64; const int i = gt & 31;
      const float invf = (float)exp2((double)(-i) * (13.287712379549449 / 32.0));
      float* cs = WSP(float, WS_CS);
      for (int idx = gt; idx < T * 32; idx += NGT) { const float ang = (float)F.positions[idx >> 5] * invf; float s, c; sincosf(ang, &s, &c); *(f32x2*)(cs + (size_t)idx * 2) = (f32x2){c, s}; } }
}

__device__ __forceinline__ void p7_final_norm(Frame& F) {
    const int gw = F.vcu * NWAVES + F.wave, NGW = F.G * NWAVES;
    const float* ssq = WSP(float, WS_SSQ2);
    f32x4 g[4];
#pragma unroll
    for (int j = 0; j < 4; ++j) g[j] = ((const f32x4*)F.g_final)[F.lane + 64 * j];
    for (int m = gw; m < T; m += NGW) {
        float p = F.lane < 16 ? ssq[(size_t)m * 16 + F.lane] : 0.f;
        p = wave_sum(p);
        const float s = 1.0f / sqrtf(p * (1.0f / DM) + EPS);
        f32x4* o = (f32x4*)(F.out + (size_t)m * DM) + F.lane;
#pragma unroll
        for (int j = 0; j < 4; ++j) { const f32x4 v = o[64 * j]; o[64 * j] = v * s * g[j]; }
    }
}

typedef short v4i16_t __attribute__((ext_vector_type(4)));
__device__ __forceinline__ int crow(int r, int hi) { return (r & 3) + 8 * (r >> 2) + 4 * hi; }
__device__ __forceinline__ void glds16(const void* gsrc, unsigned lds_dst) { unsigned keep;
    asm volatile("s_mov_b32 %0, m0\n\ts_mov_b32 m0, %2\n\ts_nop 0\n\tglobal_load_lds_dwordx4 %1, off\n\ts_mov_b32 m0, %0" : "=&s"(keep) : "v"(gsrc), "s"(lds_dst) : "memory"); }
constexpr int DL_VS = 0;

template <int MODE> __device__ __forceinline__ void attn16(const GAS bf16_t* Qp, int ldq, const GAS bf16_t* Kp, int ldk, const GAS bf16_t* Vp, int ldv, int nsteps, int dq0, float sink_l2, GAS bf16_t* Op, int ldo,
                                                           unsigned vs_base, const LAS unsigned char* vs_ptr, int lane) {
    const int c16 = lane & 15, g4 = lane >> 4;
    const int tr_off = (4 * g4 + (c16 >> 2)) * 128 + (c16 & 3) * 8;
    const int drow = lane >> 3, dch = (lane & 7) * 8;
#define A16_VDMA(u_, slot_) do { _Pragma("unroll") for (int p_ = 0; p_ < 4; ++p_) glds16((const void*)(Vp + (size_t)(32 * (u_) + 8 * p_ + drow) * ldv + dch), (unsigned)__builtin_amdgcn_readfirstlane(vs_base + (unsigned)((slot_) + p_ * 1024))); } while (0)
#define A16_KLOAD(dst, u_) do { _Pragma("unroll") for (int kb = 0; kb < 2; ++kb) { const GAS bf16_t* kr = Kp + (size_t)(32 * (u_) + 16 * kb + c16) * ldk + 8 * g4; dst[kb][0] = *(const GAS bf16x8*)kr; dst[kb][1] = *(const GAS bf16x8*)(kr + 32); } } while (0)
    asm volatile("s_waitcnt lgkmcnt(0)" ::: "memory");
    if (0 < nsteps) A16_VDMA(0, 0);
    if (1 < nsteps) A16_VDMA(1, 4096);
    if (2 < nsteps) A16_VDMA(2, 8192);
    bf16x8 qf[2][2];
#pragma unroll
    for (int qb = 0; qb < 2; ++qb)
#pragma unroll
        for (int ks = 0; ks < 2; ++ks) qf[qb][ks] = *(const GAS bf16x8*)(Qp + (size_t)(16 * qb + c16) * ldq + 32 * ks + 8 * g4);
    bf16x8 kf[2][2], kn[2][2];
    A16_KLOAD(kf, 0);
    float m[2], l[2];
    m[0] = m[1] = MODE == 1 ? sink_l2 : -INFINITY; l[0] = l[1] = (MODE == 1 && g4 == 0) ? 1.0f : 0.0f;
    f32x4 O[2][4];
#pragma unroll
    for (int qb = 0; qb < 2; ++qb)
#pragma unroll
        for (int db = 0; db < 4; ++db) O[qb][db] = (f32x4){0.f, 0.f, 0.f, 0.f};
    int slot = 0;
    for (int u = 0; u < nsteps; ++u) {
        if (u + 1 < nsteps) A16_KLOAD(kn, u + 1);
        asm volatile("" ::: "memory");
        f32x4 S[2][2];
#pragma unroll
        for (int qb = 0; qb < 2; ++qb)
#pragma unroll
            for (int kb = 0; kb < 2; ++kb) { f32x4 a = {0.f, 0.f, 0.f, 0.f};
                a = __builtin_amdgcn_mfma_f32_16x16x32_bf16(kf[kb][0], qf[qb][0], a, 0, 0, 0); a = __builtin_amdgcn_mfma_f32_16x16x32_bf16(kf[kb][1], qf[qb][1], a, 0, 0, 0); S[qb][kb] = a; }
        if (MODE == 1) { const int dbase = dq0 + c16 - 4 * g4 - 32 * u;
#pragma unroll
            for (int qb = 0; qb < 2; ++qb)
#pragma unroll
                for (int kb = 0; kb < 2; ++kb)
#pragma unroll
                    for (int r = 0; r < 4; ++r) { const int d = dbase + (16 * qb - 16 * kb - r); if (d < 0 || d >= 128) S[qb][kb][r] = -INFINITY; } }
        bf16x8 pb[2];
#pragma unroll
        for (int qb = 0; qb < 2; ++qb) {
            float cm = fmaxf(fmaxf(fmaxf(S[qb][0][0], S[qb][0][1]), fmaxf(S[qb][0][2], S[qb][0][3])), fmaxf(fmaxf(S[qb][1][0], S[qb][1][1]), fmaxf(S[qb][1][2], S[qb][1][3])));
            cm = fmaxf(cm, __shfl_xor(cm, 16)); cm = fmaxf(cm, __shfl_xor(cm, 32));
            const float mn = fmaxf(m[qb], cm);
            const float msub = mn == -INFINITY ? 0.f : mn;
            const float alpha = __builtin_amdgcn_exp2f(m[qb] - msub);
            m[qb] = mn;
            float ps = 0.f;
#pragma unroll
            for (int kb = 0; kb < 2; ++kb)
#pragma unroll
                for (int r = 0; r < 4; ++r) { S[qb][kb][r] = __builtin_amdgcn_exp2f(S[qb][kb][r] - msub); ps += S[qb][kb][r]; }
            l[qb] = l[qb] * alpha + ps;
#pragma unroll
            for (int db = 0; db < 4; ++db) O[qb][db] = O[qb][db] * alpha;
            u32x4 pw; pw.x = cvtpk(S[qb][0][0], S[qb][0][1]); pw.y = cvtpk(S[qb][0][2], S[qb][0][3]); pw.z = cvtpk(S[qb][1][0], S[qb][1][1]); pw.w = cvtpk(S[qb][1][2], S[qb][1][3]);
            pb[qb] = __builtin_bit_cast(bf16x8, pw);
        }
        if (u + 1 >= nsteps) asm volatile("s_waitcnt vmcnt(0)" ::: "memory");
        const LAS unsigned char* sp = vs_ptr + slot + tr_off;
#pragma unroll
        for (int db = 0; db < 4; ++db) {
            const v4i16_t lo = __builtin_amdgcn_ds_read_tr16_b64_v4i16((LAS v4i16_t*)(sp + db * 32));
            const v4i16_t hv = __builtin_amdgcn_ds_read_tr16_b64_v4i16((LAS v4i16_t*)(sp + db * 32 + 2048));
            const bf16x8 va = (bf16x8){lo[0], lo[1], lo[2], lo[3], hv[0], hv[1], hv[2], hv[3]};
            O[0][db] = __builtin_amdgcn_mfma_f32_16x16x32_bf16(va, pb[0], O[0][db], 0, 0, 0);
            O[1][db] = __builtin_amdgcn_mfma_f32_16x16x32_bf16(va, pb[1], O[1][db], 0, 0, 0);
        }
        if (u + 3 < nsteps) { asm volatile("s_waitcnt lgkmcnt(0)" ::: "memory"); A16_VDMA(u + 3, slot); }
        slot = slot == 8192 ? 0 : slot + 4096;
#pragma unroll
        for (int kb = 0; kb < 2; ++kb) { kf[kb][0] = kn[kb][0]; kf[kb][1] = kn[kb][1]; }
    }
#undef A16_VDMA
#undef A16_KLOAD
#pragma unroll
    for (int qb = 0; qb < 2; ++qb) { float lt = l[qb]; lt += __shfl_xor(lt, 16); lt += __shfl_xor(lt, 32); const float rl = 1.0f / lt;
        GAS bf16_t* orow = Op + (size_t)(16 * qb + c16) * ldo + 4 * g4;
#pragma unroll
        for (int db = 0; db < 4; ++db) { u32x2 w; w.x = cvtpk(O[qb][db][0] * rl, O[qb][db][1] * rl); w.y = cvtpk(O[qb][db][2] * rl, O[qb][db][3] * rl); *(GAS u32x2*)(orow + 16 * db) = w; } }
}

__device__ __forceinline__ void swa_item(Frame& F, int b, int qb) {
    const int h = F.wave, kvh = h >> 2;
    unsigned char* wsl = F.ws; asm volatile("" : "+s"(wsl));
    const float sink = F.sinks[h] * LOG2E;
    const unsigned vs_base = (unsigned)(uintptr_t)(F.lds + DL_VS) + (unsigned)F.wave * 12288u;
    const LAS unsigned char* vs_ptr = F.lds + DL_VS + F.wave * 12288;
    const GAS bf16_t* Kb = (const GAS bf16_t*)(wsl + WS_KS) + (size_t)b * SEQ * 128 + kvh * 64;
    const GAS bf16_t* Vb = (const GAS bf16_t*)(wsl + WS_VS) + (size_t)b * SEQ * 128 + kvh * 64;
    for (int sub = 0; sub < 4; ++sub) {
        const int q0 = qb * 128 + 32 * sub; const int k0 = q0 >= 128 ? q0 - 128 : 0; const int nsteps = (q0 + 32 - k0) / 32;
        attn16<1>((const GAS bf16_t*)(wsl + WS_QS) + ((size_t)b * SEQ + q0) * 512 + h * 64, 512, Kb + (size_t)k0 * 128, 128, Vb + (size_t)k0 * 128, 128, nsteps, q0 - k0, sink,
                  (GAS bf16_t*)(wsl + WS_OCAT) + ((size_t)b * SEQ + q0) * DM + h * 64, DM, vs_base, vs_ptr, F.lane);
    }
}
__device__ __forceinline__ void mem_item(Frame& F, int b, int qb) {
    const int h = F.wave & 3, half = F.wave >> 2;
    unsigned char* wsl = F.ws; asm volatile("" : "+s"(wsl));
    const unsigned vs_base = (unsigned)(uintptr_t)(F.lds + DL_VS) + (unsigned)F.wave * 12288u;
    const LAS unsigned char* vs_ptr = F.lds + DL_VS + F.wave * 12288;
    const GAS bf16_t* Kb = (const GAS bf16_t*)(wsl + WS_MK) + (size_t)b * MEMLEN * 256 + h * 64;
    const GAS bf16_t* Vb = (const GAS bf16_t*)(wsl + WS_MV) + (size_t)b * MEMLEN * 256 + h * 64;
    for (int sub = 0; sub < 2; ++sub) {
        const int q0 = qb * 128 + 64 * half + 32 * sub;
        attn16<0>((const GAS bf16_t*)(wsl + WS_QM) + ((size_t)b * SEQ + q0) * 256 + h * 64, 256, Kb, 256, Vb, 256, MEMLEN / 32, 0, 0.f,
                  (GAS bf16_t*)(wsl + WS_OCAT) + ((size_t)b * SEQ + q0) * DM + 768 + h * 64, DM, vs_base, vs_ptr, F.lane);
    }
}


constexpr int DSA_CAP = 512;
constexpr int MAXLD = 1026;
constexpr int CKLD = 513, CILD = 514;
constexpr int DL_MAX = 0;
constexpr int DL_CKEY = 0;
constexpr int DL_CIDX = 65664;
constexpr int DL_CNT = 98560;
constexpr int DL_HIST = 99584;
constexpr int DL_SEL = 132352;
__device__ __forceinline__ unsigned fkey(float f) { const unsigned u = __float_as_uint(f); return (u & 0x80000000u) ? ~u : (u | 0x80000000u); }
__device__ __forceinline__ float fkey_inv(unsigned k) { return __uint_as_float((k & 0x80000000u) ? (k & 0x7fffffffu) : ~k); }

template <int NV, int ROUNDS> __device__ __forceinline__ unsigned radix_kth(const unsigned (&v)[NV], int count, LAS unsigned* hist, int k, int lane, int& k_out, int& ceq_out) {
    unsigned prefix = 0u; int ceq = 0;
#pragma unroll
    for (int r = ROUNDS - 1; r >= 0; --r) {
        const int shift = 8 * r;
        *(LAS u32x4*)(hist + 4 * lane) = (u32x4){0u, 0u, 0u, 0u};
        LDS_WAIT();
#pragma unroll
        for (int i = 0; i < NV; ++i) { const bool ok = (lane + 64 * i < count) && (r == ROUNDS - 1 || (v[i] >> (shift + 8)) == (prefix >> (shift + 8)));
            if (ok) __hip_atomic_fetch_add(hist + ((v[i] >> shift) & 255u), 1u, __ATOMIC_RELAXED, __HIP_MEMORY_SCOPE_WORKGROUP); }
        LDS_WAIT();
        const u32x4 h = *(const LAS u32x4*)(hist + 4 * lane);
        const unsigned s = (h.x + h.y) + (h.z + h.w);
        unsigned Tl = s;
#pragma unroll
        for (int o = 1; o < 64; o <<= 1) { const unsigned t = __shfl_down(Tl, o); if (lane + o < 64) Tl += t; }
        const unsigned long long bal = __ballot(Tl >= (unsigned)k);
        const int ls = bal ? 63 - __clzll(bal) : 0;
        const unsigned above = Tl - s, c3 = above + h.w, c2 = c3 + h.z, c1 = c2 + h.y;
        unsigned bin, kk, cb;
        if (c3 >= (unsigned)k) { bin = 3; kk = k - above; cb = h.w; } else if (c2 >= (unsigned)k) { bin = 2; kk = k - c3; cb = h.z; } else if (c1 >= (unsigned)k) { bin = 1; kk = k - c2; cb = h.y; } else { bin = 0; kk = k - c1; cb = h.x; }
        const unsigned digit = (unsigned)__builtin_amdgcn_readlane((int)(bin + 4u * lane), ls);
        k = __builtin_amdgcn_readlane((int)kk, ls); ceq = __builtin_amdgcn_readlane((int)cb, ls);
        prefix |= digit << shift;
    }
    k_out = k; ceq_out = ceq; return prefix;
}

__device__ __forceinline__ void dsa_item(Frame& F, int b, int t0) {
    const int lane = F.lane, wid = F.wave, r32 = lane & 31, hi = lane >> 5;
    LAS unsigned short* maxbuf = (LAS unsigned short*)(F.lds + DL_MAX);
    LAS unsigned* ckey = (LAS unsigned*)(F.lds + DL_CKEY);
    LAS unsigned short* cidx = (LAS unsigned short*)(F.lds + DL_CIDX);
    LAS unsigned* ccnt = (LAS unsigned*)(F.lds + DL_CNT);
    LAS unsigned* ctau = ccnt + 32;
    LAS unsigned* hist = (LAS unsigned*)(F.lds + DL_HIST) + wid * 1024;
    LAS unsigned short* sel = (LAS unsigned short*)(F.lds + DL_SEL);
    const size_t rowb = (size_t)b * SEQ;
    unsigned char* wsl = F.ws; asm volatile("" : "+s"(wsl));
#define WSL(T_, off) ((GAS T_*)(wsl + (off)))
    __syncthreads();
#ifndef REP_SEL
#define REP_SEL 1
#endif
#ifndef REP_GATHER
#define REP_GATHER 1
#endif
    for (int rep_ = 0; rep_ < REP_SEL; ++rep_) {
    if (rep_) __syncthreads();
    if (t0 >= TOPK) {
        const int nkt = t0 / 32 + 1, nmax = t0 + 32;
        int lg = 0; while ((1024 << lg) < nmax) ++lg;
        const int npl = 16 >> lg;
        bf16x8 qf[4][4]; float wq[4];
        { const GAS bf16_t* qrow = WSL(const bf16_t, WS_QI) + (rowb + t0 + r32) * 256 + 8 * hi;
#pragma unroll
          for (int h = 0; h < 4; ++h)
#pragma unroll
              for (int s = 0; s < 4; ++s) qf[h][s] = *(const GAS bf16x8*)(qrow + h * 64 + 16 * s);
          const f32x4 w4 = *(const GAS f32x4*)(WSL(const float, WS_WI) + (rowb + t0 + r32) * 4); wq[0] = w4[0]; wq[1] = w4[1]; wq[2] = w4[2]; wq[3] = w4[3]; }
        if (F.tid < 32) ccnt[F.tid] = 0u;
        const GAS bf16_t* kbase = WSL(const bf16_t, WS_KI) + (rowb + r32) * 64 + 8 * hi;
        float thrf = 0.f;
#ifndef X_PASS0
#define X_PASS0 0
#endif
#ifndef X_RADIX16
#define X_RADIX16 1
#endif
#ifndef X_EXACT
#define X_EXACT 1
#endif
        for (int pp = -X_PASS0; pp < 2; ++pp) { const int pass = pp < 0 ? 0 : pp;
            if (pass == 1) thrf = fkey_inv(ctau[r32] << 16);
            bf16x8 kn[4];
            if (wid < nkt) {
#pragma unroll
                for (int s = 0; s < 4; ++s) kn[s] = *(const GAS bf16x8*)(kbase + (size_t)(32 * wid) * 64 + 16 * s);
            }
            for (int j = wid; j < nkt; j += NWAVES) {
                bf16x8 kf[4];
#pragma unroll
                for (int s = 0; s < 4; ++s) kf[s] = kn[s];
                if (j + NWAVES < nkt) {
#pragma unroll
                    for (int s = 0; s < 4; ++s) kn[s] = *(const GAS bf16x8*)(kbase + (size_t)(32 * (j + NWAVES)) * 64 + 16 * s);
                }
                float sc[16];
                {
                    f32x16 da = {}, db = {};
#pragma unroll
                    for (int s = 0; s < 4; ++s) da = __builtin_amdgcn_mfma_f32_32x32x16_bf16(kf[s], qf[0][s], da, 0, 0, 0);
#pragma unroll
                    for (int s = 0; s < 4; ++s) db = __builtin_amdgcn_mfma_f32_32x32x16_bf16(kf[s], qf[1][s], db, 0, 0, 0);
#pragma unroll
                    for (int i = 0; i < 16; ++i) { const int di = __float_as_int(da[i]); sc[i] = __int_as_float(di > 0 ? di : 0) * wq[0]; }
                    da = (f32x16){};
#pragma unroll
                    for (int s = 0; s < 4; ++s) da = __builtin_amdgcn_mfma_f32_32x32x16_bf16(kf[s], qf[2][s], da, 0, 0, 0);
#pragma unroll
                    for (int i = 0; i < 16; ++i) { const int di = __float_as_int(db[i]); sc[i] = fmaf(__int_as_float(di > 0 ? di : 0), wq[1], sc[i]); }
                    db = (f32x16){};
#pragma unroll
                    for (int s = 0; s < 4; ++s) db = __builtin_amdgcn_mfma_f32_32x32x16_bf16(kf[s], qf[3][s], db, 0, 0, 0);
#pragma unroll
                    for (int i = 0; i < 16; ++i) { const int di = __float_as_int(da[i]); sc[i] = fmaf(__int_as_float(di > 0 ? di : 0), wq[2], sc[i]); }
#pragma unroll
                    for (int i = 0; i < 16; ++i) { const int di = __float_as_int(db[i]); sc[i] = fmaf(__int_as_float(di > 0 ? di : 0), wq[3], sc[i]); }
                }
                if (j == nkt - 1) { const int dlim = r32 - 4 * hi;
#pragma unroll
                    for (int i = 0; i < 16; ++i) if ((i & 3) + 8 * (i >> 2) > dlim) sc[i] = -INFINITY;
                }
                if (pass == 0) {
                    LAS unsigned short* mb = maxbuf + r32 * MAXLD + (j * 2 + hi) * npl;
                    if (lg == 0) {
#pragma unroll
                        for (int i = 0; i < 16; ++i) mb[i] = (unsigned short)(fkey(sc[i]) >> 16);
                    } else {
                        float m2[8];
#pragma unroll
                        for (int i = 0; i < 8; ++i) m2[i] = fmaxf(sc[2 * i], sc[2 * i + 1]);
                        if (lg == 1) {
#pragma unroll
                            for (int i = 0; i < 8; ++i) mb[i] = (unsigned short)(fkey(m2[i]) >> 16);
                        } else if (lg == 2) {
#pragma unroll
                            for (int i = 0; i < 4; ++i) mb[i] = (unsigned short)(fkey(fmaxf(m2[2 * i], m2[2 * i + 1])) >> 16);
                        } else {
                            mb[0] = (unsigned short)(fkey(fmaxf(fmaxf(m2[0], m2[1]), fmaxf(m2[2], m2[3]))) >> 16);
                            mb[1] = (unsigned short)(fkey(fmaxf(fmaxf(m2[4], m2[5]), fmaxf(m2[6], m2[7]))) >> 16);
                        }
                    }
                } else {
                    int cntl = 0;
#pragma unroll
                    for (int i = 0; i < 16; ++i) cntl += (sc[i] >= thrf) ? 1 : 0;
                    if (__ballot(cntl > 0)) {
                        unsigned slot = 0u;
                        if (cntl > 0) slot = __hip_atomic_fetch_add(ccnt + r32, (unsigned)cntl, __ATOMIC_RELAXED, __HIP_MEMORY_SCOPE_WORKGROUP);
                        LAS unsigned* ck = ckey + r32 * CKLD; LAS unsigned short* ci = cidx + r32 * CILD; const int ib = 32 * j + 4 * hi;
#pragma unroll
                        for (int i = 0; i < 16; ++i) {
                            if (sc[i] >= thrf) { const unsigned sl = slot < (unsigned)(DSA_CAP - 1) ? slot : (unsigned)(DSA_CAP - 1);
                                ck[sl] = fkey(sc[i]); ci[sl] = (unsigned short)(ib + ((i & 3) + 8 * (i >> 2))); ++slot; }
                        }
                    }
                }
            }
            __syncthreads();
            if (pp == 0) {
                const int G = nmax >> lg;
                {
                    unsigned v[4][16]; int pivot[4];
#pragma unroll
                    for (int jq = 0; jq < 4; ++jq) { const int q = wid * 4 + jq;
#pragma unroll
                        for (int i = 0; i < 16; ++i) { const int e = lane + 64 * i; v[jq][i] = e < G ? (unsigned)maxbuf[q * MAXLD + e] : 0u; } }
#pragma unroll
                    for (int jq = 0; jq < 4; ++jq) *(LAS u32x4*)(hist + jq * 256 + 4 * lane) = (u32x4){0u, 0u, 0u, 0u};
#pragma unroll
                    for (int jq = 0; jq < 4; ++jq) { unsigned mloc = v[jq][0];
#pragma unroll
                        for (int i = 1; i < 16; ++i) mloc = mloc > v[jq][i] ? mloc : v[jq][i];
                        int pv = __builtin_amdgcn_readlane((int)mloc, 0); const int p1 = __builtin_amdgcn_readlane((int)mloc, 21), p2 = __builtin_amdgcn_readlane((int)mloc, 42), p3 = __builtin_amdgcn_readlane((int)mloc, 63);
                        pv = pv > p1 ? pv : p1; pv = pv > p2 ? pv : p2; pv = pv > p3 ? pv : p3; pivot[jq] = pv; }
                    LDS_WAIT();
#pragma unroll
                    for (int jq = 0; jq < 4; ++jq)
#pragma unroll
                        for (int i = 0; i < 16; ++i) { if (lane + 64 * i < G) { int d = (pivot[jq] - (int)v[jq][i]) >> 1; d = d < 0 ? 0 : (d > 255 ? 255 : d);
                                __hip_atomic_fetch_add(hist + jq * 256 + d, 1u, __ATOMIC_RELAXED, __HIP_MEMORY_SCOPE_WORKGROUP); } }
                    LDS_WAIT();
                    u32x4 h[4]; unsigned sh[4], Pl[4];
#pragma unroll
                    for (int jq = 0; jq < 4; ++jq) { h[jq] = *(const LAS u32x4*)(hist + jq * 256 + 4 * lane); sh[jq] = (h[jq].x + h[jq].y) + (h[jq].z + h[jq].w); Pl[jq] = sh[jq]; }
#pragma unroll
                    for (int o = 1; o < 64; o <<= 1) {
#pragma unroll
                        for (int jq = 0; jq < 4; ++jq) { const unsigned t = __shfl_up(Pl[jq], o); if (lane >= o) Pl[jq] += t; } }
#pragma unroll
                    for (int jq = 0; jq < 4; ++jq) { const int q = wid * 4 + jq;
                        const unsigned long long bal = __ballot(Pl[jq] >= (unsigned)TOPK);
                        const int ls = bal ? __ffsll((long long)bal) - 1 : 63;
                        const unsigned below = Pl[jq] - sh[jq], c0 = below + h[jq].x, c1 = c0 + h[jq].y, c2 = c1 + h[jq].z;
                        const unsigned bin = c0 >= (unsigned)TOPK ? 0u : (c1 >= (unsigned)TOPK ? 1u : (c2 >= (unsigned)TOPK ? 2u : 3u));
                        const int jstar = bal ? __builtin_amdgcn_readlane((int)(bin + 4u * lane), ls) : 255;
                        unsigned tau;
                        if (jstar < 255) { const int tl = pivot[jq] - (2 * jstar + 1); tau = tl < 0 ? 0u : (unsigned)tl; }
                        else { int ko, ce; tau = radix_kth<16, 2>(v[jq], G, hist + jq * 256, TOPK, lane, ko, ce); }
                        if (lane == 0) ctau[q] = tau; }
                }
                __syncthreads();
            }
        }
        {
            unsigned kv[4][8], ix[4][8], dg[4][8]; int cq[4]; unsigned tau16[4];
#pragma unroll
            for (int jq = 0; jq < 4; ++jq) { const int q = wid * 4 + jq; int c = (int)ccnt[q]; if (c > DSA_CAP) c = DSA_CAP; cq[jq] = __builtin_amdgcn_readfirstlane(c); tau16[jq] = (unsigned)__builtin_amdgcn_readfirstlane((int)ctau[q]);
#pragma unroll
                for (int i = 0; i < 8; ++i) { const int e = lane + 64 * i; kv[jq][i] = e < c ? ckey[q * CKLD + e] : 0u; ix[jq][i] = e < c ? (unsigned)cidx[q * CILD + e] : 0xffffu; }
                *(LAS u32x4*)(hist + jq * 256 + 4 * lane) = (u32x4){0u, 0u, 0u, 0u}; }
            LDS_WAIT();
#pragma unroll
            for (int jq = 0; jq < 4; ++jq)
#pragma unroll
                for (int i = 0; i < 8; ++i) { const int d0 = (int)(kv[jq][i] >> 16) - (int)tau16[jq]; dg[jq][i] = (unsigned)(d0 < 0 ? 0 : (d0 > 255 ? 255 : d0));
                    if (lane + 64 * i < cq[jq]) __hip_atomic_fetch_add(hist + jq * 256 + dg[jq][i], 1u, __ATOMIC_RELAXED, __HIP_MEMORY_SCOPE_WORKGROUP); }
            LDS_WAIT();
            u32x4 h[4]; unsigned sh[4], Tl[4];
#pragma unroll
            for (int jq = 0; jq < 4; ++jq) { h[jq] = *(const LAS u32x4*)(hist + jq * 256 + 4 * lane); sh[jq] = (h[jq].x + h[jq].y) + (h[jq].z + h[jq].w); Tl[jq] = sh[jq]; }
#pragma unroll
            for (int o = 1; o < 64; o <<= 1) {
#pragma unroll
                for (int jq = 0; jq < 4; ++jq) { const unsigned t = __shfl_down(Tl[jq], o); if (lane + o < 64) Tl[jq] += t; } }
            unsigned jstar[4]; int kk[4], cb[4]; bool fast[4];
#pragma unroll
            for (int jq = 0; jq < 4; ++jq) {
                const unsigned long long bal = __ballot(Tl[jq] >= (unsigned)TOPK);
                const int ls = bal ? 63 - __clzll(bal) : 0;
                const unsigned above = Tl[jq] - sh[jq], c3 = above + h[jq].w, c2 = c3 + h[jq].z, c1 = c2 + h[jq].y;
                unsigned bin, kkv, cbv;
                if (c3 >= (unsigned)TOPK) { bin = 3; kkv = TOPK - above; cbv = h[jq].w; } else if (c2 >= (unsigned)TOPK) { bin = 2; kkv = TOPK - c3; cbv = h[jq].z; } else if (c1 >= (unsigned)TOPK) { bin = 1; kkv = TOPK - c2; cbv = h[jq].y; } else { bin = 0; kkv = TOPK - c1; cbv = h[jq].x; }
                jstar[jq] = (unsigned)__builtin_amdgcn_readlane((int)(bin + 4u * lane), ls);
                kk[jq] = __builtin_amdgcn_readlane((int)kkv, ls); cb[jq] = __builtin_amdgcn_readlane((int)cbv, ls);
                fast[jq] = jstar[jq] < 255u && cb[jq] <= 64;
            }
#pragma unroll
            for (int jq = 0; jq < 4; ++jq) { LAS unsigned* lk = hist + jq * 256; LAS unsigned* li = lk + 64; int base = 0;
                if (fast[jq]) {
#pragma unroll
                    for (int i = 0; i < 8; ++i) { const bool mt = (lane + 64 * i < cq[jq]) && dg[jq][i] == jstar[jq]; const unsigned long long mk = __ballot(mt);
                        if (mt) { const int slot = base + (int)__builtin_amdgcn_mbcnt_hi((unsigned)(mk >> 32), __builtin_amdgcn_mbcnt_lo((unsigned)mk, 0u)); lk[slot] = kv[jq][i]; li[slot] = ix[jq][i]; }
                        base += __popcll(mk); } } }
            LDS_WAIT();
            unsigned thr[4], ti[4];
#pragma unroll
            for (int jq = 0; jq < 4; ++jq) { thr[jq] = 0u; ti[jq] = 0xffffu;
                if (fast[jq]) { const LAS unsigned* lk = hist + jq * 256; const LAS unsigned* li = lk + 64;
                    const unsigned mkey = lane < cb[jq] ? lk[lane] : 0u, midx = lane < cb[jq] ? li[lane] : 0xffffu;
                    int rank = 0;
                    for (int t = 0; t < cb[jq]; ++t) { const unsigned xk = (unsigned)__builtin_amdgcn_readlane((int)mkey, t), xi = (unsigned)__builtin_amdgcn_readlane((int)midx, t);
                        rank += (xk > mkey || (xk == mkey && xi < midx)) ? 1 : 0; }
                    const unsigned long long b2 = __ballot(lane < cb[jq] && rank == kk[jq] - 1);
                    const int lt = b2 ? __ffsll((long long)b2) - 1 : 0;
                    thr[jq] = (unsigned)__builtin_amdgcn_readlane((int)mkey, lt); ti[jq] = (unsigned)__builtin_amdgcn_readlane((int)midx, lt);
                } else {
                    int k, ceq; thr[jq] = radix_kth<8, 4>(kv[jq], cq[jq], hist + jq * 256, TOPK, lane, k, ceq);
                    if (ceq > k) {
                        unsigned pi = 0u; int kq = k;
                        for (int bit = 15; bit >= 0; --bit) { const unsigned test = pi >> bit; int cnt = 0;
#pragma unroll
                            for (int i = 0; i < 8; ++i) cnt += __popcll(__ballot(kv[jq][i] == thr[jq] && (ix[jq][i] >> bit) == test));
                            if (cnt < kq) { kq -= cnt; pi |= (1u << bit); } }
                        ti[jq] = pi;
                    }
                } }
#pragma unroll
            for (int jq = 0; jq < 4; ++jq) { const int q = wid * 4 + jq; int base = 0;
#pragma unroll
                for (int i = 0; i < 8; ++i) { const bool sl = kv[jq][i] > thr[jq] || (kv[jq][i] == thr[jq] && ix[jq][i] <= ti[jq]); const unsigned long long mk = __ballot(sl);
                    if (sl) { const int pos = base + (int)__builtin_amdgcn_mbcnt_hi((unsigned)(mk >> 32), __builtin_amdgcn_mbcnt_lo((unsigned)mk, 0u)); if (pos < TOPK) sel[q * 256 + pos] = (unsigned short)ix[jq][i]; }
                    base += __popcll(mk); } }
            LDS_WAIT();
        }
    } else {
        for (int e = F.tid; e < 32 * 256; e += NWAVES * 64) sel[e] = (unsigned short)(e & 255);
    }
    }
    __syncthreads();
    const int c16 = lane & 15, g4 = lane >> 4;
    const GAS bf16_t* Kd = WSL(const bf16_t, WS_KD) + rowb * 64;
    const GAS bf16_t* Vd = WSL(const bf16_t, WS_VD) + rowb * 64;
    const unsigned vs_base = (unsigned)(uintptr_t)(F.lds + DL_VS) + (unsigned)wid * 12288u;
    const LAS unsigned char* vs_ptr = F.lds + DL_VS + wid * 12288;
    const int tr_off = (4 * g4 + (c16 >> 2)) * 128 + (c16 & 3) * 8;
    for (int rep_ = 0; rep_ < REP_GATHER; ++rep_)
    for (int jq = 0; jq < 4; ++jq) { const int q = wid * 4 + jq, t = t0 + q; const int nsel = t + 1 < TOPK ? t + 1 : TOPK;
        const LAS unsigned short* selq = sel + q * 256;
#define DSA_VDMA(u) do { _Pragma("unroll") for (int p_ = 0; p_ < 4; ++p_) { const int kidx_ = (int)selq[32 * (u) + 8 * p_ + (lane >> 3)]; \
            glds16((const void*)(Vd + (size_t)kidx_ * 64 + (lane & 7) * 8), (unsigned)__builtin_amdgcn_readfirstlane(vs_base + (unsigned)(((u) % 3) * 4096 + p_ * 1024))); } } while (0)
        asm volatile("s_waitcnt lgkmcnt(0)" ::: "memory");
        DSA_VDMA(0); DSA_VDMA(1); DSA_VDMA(2);
        bf16x8 qf[2];
        { const GAS bf16_t* qrow = WSL(const bf16_t, WS_QD) + (rowb + t) * 256 + (c16 & 3) * 64 + 8 * g4;
          qf[0] = *(const GAS bf16x8*)qrow; qf[1] = *(const GAS bf16x8*)(qrow + 32);
          if (c16 >= 4) { qf[0] = (bf16x8){0, 0, 0, 0, 0, 0, 0, 0}; qf[1] = qf[0]; } }
        bf16x8 kf[4][2], kn[4][2];
#define DSA_KLOAD(dst, ch_) do { _Pragma("unroll") for (int kb = 0; kb < 4; ++kb) { const int kidx = (int)selq[64 * (ch_) + 16 * kb + c16]; const GAS bf16_t* kr = Kd + (size_t)kidx * 64 + 8 * g4; dst[kb][0] = *(const GAS bf16x8*)kr; dst[kb][1] = *(const GAS bf16x8*)(kr + 32); } } while (0)
        DSA_KLOAD(kf, 0);
        float mrun = -INFINITY, l = 0.f;
        f32x4 O[4];
#pragma unroll
        for (int db = 0; db < 4; ++db) O[db] = (f32x4){0.f, 0.f, 0.f, 0.f};
#pragma unroll
        for (int ch = 0; ch < 4; ++ch) {
            if (ch + 1 < 4) DSA_KLOAD(kn, ch + 1);
            asm volatile("" ::: "memory");
            f32x4 S[4];
#pragma unroll
            for (int kb = 0; kb < 4; ++kb) { f32x4 a = {0.f, 0.f, 0.f, 0.f};
                a = __builtin_amdgcn_mfma_f32_16x16x32_bf16(kf[kb][0], qf[0], a, 0, 0, 0); a = __builtin_amdgcn_mfma_f32_16x16x32_bf16(kf[kb][1], qf[1], a, 0, 0, 0); S[kb] = a; }
            if (nsel < TOPK) { const int nlim = nsel - 4 * g4;
#pragma unroll
                for (int kb = 0; kb < 4; ++kb)
#pragma unroll
                    for (int r = 0; r < 4; ++r) if (64 * ch + 16 * kb + r >= nlim) S[kb][r] = -INFINITY;
            }
            float cm = fmaxf(fmaxf(S[0][0], S[0][1]), fmaxf(S[0][2], S[0][3]));
#pragma unroll
            for (int kb = 1; kb < 4; ++kb) cm = fmaxf(cm, fmaxf(fmaxf(S[kb][0], S[kb][1]), fmaxf(S[kb][2], S[kb][3])));
            cm = fmaxf(cm, __shfl_xor(cm, 16)); cm = fmaxf(cm, __shfl_xor(cm, 32));
            const float mn = fmaxf(mrun, cm);
            const float alpha = __builtin_amdgcn_exp2f(mrun - mn);
            mrun = mn;
            float ps = 0.f;
#pragma unroll
            for (int kb = 0; kb < 4; ++kb)
#pragma unroll
                for (int r = 0; r < 4; ++r) { S[kb][r] = __builtin_amdgcn_exp2f(S[kb][r] - mn); ps += S[kb][r]; }
            l = l * alpha + ps;
#pragma unroll
            for (int db = 0; db < 4; ++db) O[db] = O[db] * alpha;
#pragma unroll
            for (int u2 = 0; u2 < 2; ++u2) { const int u = 2 * ch + u2;
                u32x4 pw; pw.x = cvtpk(S[2 * u2][0], S[2 * u2][1]); pw.y = cvtpk(S[2 * u2][2], S[2 * u2][3]); pw.z = cvtpk(S[2 * u2 + 1][0], S[2 * u2 + 1][1]); pw.w = cvtpk(S[2 * u2 + 1][2], S[2 * u2 + 1][3]);
                const bf16x8 pb = __builtin_bit_cast(bf16x8, pw);
                if (u == 3) asm volatile("s_waitcnt vmcnt(12)" ::: "memory");
                else if (u == 5) asm volatile("s_waitcnt vmcnt(16)" ::: "memory");
                else if (u == 6) asm volatile("s_waitcnt vmcnt(12)" ::: "memory");
                else if (u == 7) asm volatile("s_waitcnt vmcnt(0)" ::: "memory");
                const LAS unsigned char* sp = vs_ptr + (u % 3) * 4096 + tr_off;
#pragma unroll
                for (int db = 0; db < 4; ++db) {
                    const v4i16_t lo = __builtin_amdgcn_ds_read_tr16_b64_v4i16((LAS v4i16_t*)(sp + db * 32));
                    const v4i16_t hv = __builtin_amdgcn_ds_read_tr16_b64_v4i16((LAS v4i16_t*)(sp + db * 32 + 2048));
                    const bf16x8 va = (bf16x8){lo[0], lo[1], lo[2], lo[3], hv[0], hv[1], hv[2], hv[3]};
                    O[db] = __builtin_amdgcn_mfma_f32_16x16x32_bf16(va, pb, O[db], 0, 0, 0);
                }
                if (u + 3 < 8) { asm volatile("s_waitcnt lgkmcnt(0)" ::: "memory"); DSA_VDMA(u + 3); }
            }
#pragma unroll
            for (int kb = 0; kb < 4; ++kb) { kf[kb][0] = kn[kb][0]; kf[kb][1] = kn[kb][1]; }
        }
        l += __shfl_xor(l, 16); l += __shfl_xor(l, 32);
#undef DSA_KLOAD
#undef DSA_VDMA
        if (c16 < 4) {
            const float rl = 1.0f / l;
            GAS bf16_t* orow = WSL(bf16_t, WS_OCAT) + (rowb + t) * DM + 512 + c16 * 64 + 4 * g4;
#pragma unroll
            for (int db = 0; db < 4; ++db) { u32x2 w; w.x = cvtpk(O[db][0] * rl, O[db][1] * rl); w.y = cvtpk(O[db][2] * rl, O[db][3] * rl); *(GAS u32x2*)(orow + 16 * db) = w; }
        }
    }
}
#undef WSL

__device__ __forceinline__ void p2_attention(Frame& F) {
    const int NIT = NB * (SEQ / 32);
#ifndef REP_DSA
#define REP_DSA 1
#endif
#ifndef REP_SWAMEM
#define REP_SWAMEM 1
#endif
    for (int rep = 0; rep < REP_DSA; ++rep)
    for (int r = 0; r < (NIT + F.G - 1) / F.G; ++r) {
        int b, tile;
        if (F.G == 256) { const int j = F.vcu & 63; b = F.vcu >> 6; tile = r == 0 ? j : (r == 1 ? 127 - j : (r == 2 ? 128 + j : 255 - j)); }
        else { const int it = r * F.G + F.vcu; if (it >= NIT) break; b = it / (SEQ / 32); tile = it % (SEQ / 32); }
        dsa_item(F, b, tile * 32);
    }
    __syncthreads();
    for (int rep = 0; rep < REP_SWAMEM; ++rep) {
    for (int it = F.vcu; it < NB * (SEQ / 128); it += F.G) swa_item(F, it / (SEQ / 128), it % (SEQ / 128));
    for (int it = F.vcu; it < NB * (SEQ / 128); it += F.G) mem_item(F, it / (SEQ / 128), it % (SEQ / 128));
    }
}

#ifndef MK_N_LAUNCHES
#define MK_N_LAUNCHES 1
#endif
constexpr int N_PHASES = 8;
struct Args { const void* in[17]; float* out; unsigned char* ws; int ph_lo, ph_hi, li, pad; };

__global__ void __launch_bounds__(NWAVES * 64, 2) hybrid_fwd(Args args) {
    extern __shared__ __attribute__((aligned(16))) unsigned char lds[];
    Frame F;
    F.lds = (LAS unsigned char*)lds;
    F.MISC = (volatile LAS unsigned*)(F.lds + MISC_OFF);
    F.tid = threadIdx.x; F.lane = F.tid & 63; F.wave = __builtin_amdgcn_readfirstlane(F.tid >> 6);
    F.G = gridDim.x; { const int bx = blockIdx.x; F.vcu = (F.G % 8 == 0) ? (bx % 8) * (F.G / 8) + bx / 8 : bx; }
    F.ws = args.ws; F.ctl = (unsigned*)(args.ws + WS_CTL);
    F.x = (const float*)args.in[0]; F.mem = (const float*)args.in[1]; F.positions = (const int*)args.in[2]; F.g_mix = (const float*)args.in[3]; F.w_in = (const float*)args.in[4];
    F.b_gate = (const float*)args.in[5]; F.sinks = (const float*)args.in[6]; F.g_mem = (const float*)args.in[7]; F.w_mem_kv = (const float*)args.in[8]; F.w_proj_swa = (const float*)args.in[9];
    F.w_proj_dsa = (const float*)args.in[10]; F.w_proj_mem = (const float*)args.in[11]; F.w_out = (const float*)args.in[12]; F.g_mlp = (const float*)args.in[13]; F.w_mlp_in = (const float*)args.in[14];
    F.w_mlp_out = (const float*)args.in[15]; F.g_final = (const float*)args.in[16]; F.out = args.out;
    for (int u = F.tid; u < (LDS_BYTES - LDSCTL_OFF) / 4; u += NWAVES * 64) ((LAS unsigned*)(F.lds + LDSCTL_OFF))[u] = 0u;
    __syncthreads();
    XcdBarrier bar; bar.bar = F.ctl + CW_BAR + args.li * XCD_BAR_WORDS; bar.x = 0; bar.st = nullptr;
    if (args.ph_hi - args.ph_lo > 1) bar = xcd_barrier_post(F.ctl + CW_BAR + args.li * XCD_BAR_WORDS, F.MISC + 8);
    const int lo = args.ph_lo, hi = args.ph_hi;
#ifndef PHASE_MASK
#define PHASE_MASK 0xff
#endif
#define IN(k) (((PHASE_MASK >> (k)) & 1) && lo <= (k) && (k) < hi)
#define BOTH(k) (IN(k) && IN((k) + 1))
#define GRID_BAR() xcd_barrier(bar)
    const int bx = (int)blockIdx.x;

#ifndef REP_P0
#define REP_P0 1
#endif
    if (IN(0)) { for (int rp_ = 0; rp_ < REP_P0; ++rp_) p0_prologue(F); if (BOTH(0)) GRID_BAR(); }

#ifndef REP_GEMM
#define REP_GEMM 1
#endif
    if (IN(1)) for (int rg_ = 0; rg_ < REP_GEMM; ++rg_) {
        SchedInProj S; S.nM = T / 256; S.nN = NPOS / 256; S.nwg = S.nM * S.nN; S.G = F.G; S.c = bx;
        S.Ab = (const char*)WSP(bf16_t, WS_XB); S.Bb = (const char*)WSP(bf16_t, WS_WIN); S.Am = (const char*)WSP(bf16_t, WS_MEMB); S.Bm = (const char*)WSP(bf16_t, WS_WMEM);
        EpiInProj E; E.inv_rms = WSP(float, WS_INVRMS0); E.inv_rms_mem = WSP(float, WS_INVRMSM); E.cs = WSP(float, WS_CS); E.b_gate = F.b_gate;
        E.q_s = WSP(bf16_t, WS_QS); E.k_s = WSP(bf16_t, WS_KS); E.v_s = WSP(bf16_t, WS_VS); E.q_d = WSP(bf16_t, WS_QD); E.k_d = WSP(bf16_t, WS_KD); E.v_d = WSP(bf16_t, WS_VD);
        E.q_i = WSP(bf16_t, WS_QI); E.k_i = WSP(bf16_t, WS_KI); E.q_m = WSP(bf16_t, WS_QM); E.gates = WSP(bf16_t, WS_GATES); E.mk = WSP(bf16_t, WS_MK); E.mv = WSP(bf16_t, WS_MV); E.w_i = WSP(float, WS_WI);
        pg8::gemm_phase<EpiInProj, SchedInProj, true>(F.lds + RING_OFF, DM, DM, S, E);
        if (BOTH(1) && rg_ == REP_GEMM - 1) GRID_BAR();
    }

    if (IN(2)) { p2_attention(F); if (BOTH(2)) GRID_BAR(); }

    if (IN(3)) {
        SchedMerge S; S.G = F.G; S.c = bx; S.Ab = (const char*)WSP(bf16_t, WS_OCAT); S.Bb = (const char*)WSP(bf16_t, WS_WPROJ);
        EpiMerge E; E.gates = WSP(bf16_t, WS_GATES); E.merged = WSP(bf16_t, WS_MERGED);
        pg8::gemm_phase<EpiMerge, SchedMerge, true>(F.lds + RING_OFF, DM, DM, S, E);
        if (BOTH(3)) GRID_BAR();
    }

    if (IN(4)) {
        SchedGrid S; S.nM = T / 256; S.nN = DM / 256; S.nwg = S.nM * S.nN; S.G = F.G; S.c = bx; S.nt = DM / 64;
        S.Ab = (const char*)WSP(bf16_t, WS_MERGED); S.Bb = (const char*)WSP(bf16_t, WS_WOUT); S.tA = (size_t)256 * DM * 2; S.tB = (size_t)256 * DM * 2;
        EpiResid<true> E; E.base = F.x; E.out = F.out; E.outb = WSP(bf16_t, WS_XB); E.ssq = WSP(float, WS_SSQ1);
        pg8::gemm_phase<EpiResid<true>, SchedGrid, true>(F.lds + RING_OFF, DM, DM, S, E);
        if (BOTH(4)) GRID_BAR();
    }

    if (IN(5)) for (int rg_ = 0; rg_ < REP_GEMM; ++rg_) {
        SchedGrid S; S.nM = T / 256; S.nN = DFF / 256; S.nwg = S.nM * S.nN; S.G = F.G; S.c = bx; S.nt = DM / 64;
        S.Ab = (const char*)WSP(bf16_t, WS_XB); S.Bb = (const char*)WSP(bf16_t, WS_W1); S.tA = (size_t)256 * DM * 2; S.tB = (size_t)256 * DM * 2;
        EpiMlpIn E; E.ssq = WSP(float, WS_SSQ1); E.hid = WSP(bf16_t, WS_HID);
        pg8::gemm_phase<EpiMlpIn, SchedGrid, true>(F.lds + RING_OFF, DM, DM, S, E);
        if (BOTH(5) && rg_ == REP_GEMM - 1) GRID_BAR();
    }

    if (IN(6)) {
        SchedGrid S; S.nM = T / 256; S.nN = DM / 256; S.nwg = S.nM * S.nN; S.G = F.G; S.c = bx; S.nt = DFF / 64;
        S.Ab = (const char*)WSP(bf16_t, WS_HID); S.Bb = (const char*)WSP(bf16_t, WS_W2); S.tA = (size_t)256 * DFF * 2; S.tB = (size_t)256 * DFF * 2;
        EpiResid<false> E; E.base = F.out; E.out = F.out; E.outb = nullptr; E.ssq = WSP(float, WS_SSQ2);
        pg8::gemm_phase<EpiResid<false>, SchedGrid, true>(F.lds + RING_OFF, DFF, DFF, S, E);
        if (BOTH(6)) GRID_BAR();
    }

    if (IN(7)) p7_final_norm(F);
#undef IN
#undef BOTH
#undef GRID_BAR
}

extern "C" void kernel_launch(void* const* d_in, const int* in_sizes, int n_in, void* d_out, int out_size, void* d_ws, size_t ws_size, hipStream_t stream) {
    static int grid = 0;
    if (grid == 0) {
        if (n_in != 17 || in_sizes[0] != T * DM || out_size != T * DM || ws_size < WS_END) { fprintf(stderr, "kernel_launch: unexpected shapes (n_in %d, in0 %d, out %d, ws %zu < %zu); nothing launched\n", n_in, n_in > 0 ? in_sizes[0] : -1, out_size, ws_size, (size_t)WS_END); grid = -1; return; }
        int dev = 0, cus = 0, per_cu = 0;
        if (hipGetDevice(&dev) != hipSuccess || hipDeviceGetAttribute(&cus, hipDeviceAttributeMultiprocessorCount, dev) != hipSuccess) { grid = -1; return; }
        if (hipFuncSetAttribute((const void*)hybrid_fwd, hipFuncAttributeMaxDynamicSharedMemorySize, LDS_BYTES) != hipSuccess) { fprintf(stderr, "kernel_launch: hipFuncSetAttribute failed\n"); grid = -1; return; }
        if (hipOccupancyMaxActiveBlocksPerMultiprocessor(&per_cu, (const void*)hybrid_fwd, NWAVES * 64, LDS_BYTES) != hipSuccess || per_cu < 1) { fprintf(stderr, "kernel_launch: occupancy query reports %d workgroups per CU; nothing launched\n", per_cu); (void)hipGetLastError(); grid = -1; return; }
        (void)hipGetLastError();
        grid = cus;
    }
    if (grid < 0) return;
    if (hipMemsetAsync((char*)d_ws + WS_CTL, 0, CTL_ZERO_BYTES, stream) != hipSuccess) return;
    Args a{};
    for (int i = 0; i < 17; ++i) a.in[i] = d_in[i];
    a.out = (float*)d_out; a.ws = (unsigned char*)d_ws;
    if (MK_N_LAUNCHES == 1) { a.ph_lo = 0; a.ph_hi = N_PHASES; a.li = 0; hipLaunchKernelGGL(hybrid_fwd, dim3(grid), dim3(NWAVES * 64), LDS_BYTES, stream, a); }
    else { for (int p = 0; p < N_PHASES; ++p) { a.ph_lo = p; a.ph_hi = p + 1; a.li = 0; hipLaunchKernelGGL(hybrid_fwd, dim3(grid), dim3(NWAVES * 64), LDS_BYTES, stream, a); } }
}
```
